# Optimizing an MI355X kernel written in HIP

```python
import math
import jax, jax.numpy as jnp
from jax import lax
import numpy as np

D_MODEL = 1024
BATCH = 2
SEQ = 8192
DEPTH = 1
DEC_BATCH = 128
DEC_SEQ = 4
PAST_LEN = 2048
PAGE_SIZE = 128

R_HEADS = 8
R_HD = 64
R_WIDTH = R_HEADS * R_HD
LORA_W = 64
LORA_A = 64
SHIFT_COLS = 3 * R_WIDTH + LORA_W + LORA_A
GN_EPS = 64e-5
A_GROUPS = ((128, 1), (512, 4), (2048, 16))
N_GROUPS = 3
A_HEADS = 4
A_HD = 128
A_QKV_W = N_GROUPS * A_HEADS * A_HD
A_WIDTH = A_HEADS * A_HD
N_IN = SHIFT_COLS + R_WIDTH + 3 * A_QKV_W + A_WIDTH + 2 * D_MODEL
ALPHA = (2 * DEPTH) ** 0.25
BETA = (8 * DEPTH) ** -0.25
LN_EPS = 1e-5
NEG = -1e30

kernel_name = "rwkv7_dilated_attn_hybrid_step"

F32 = jnp.float32


def _split(t, sizes):
    return jnp.split(t, [int(s) for s in np.cumsum(sizes)[:-1]], axis=-1)


def layer_norm(x, g, b):
    xf = x.astype(F32)
    mu = jnp.mean(xf, -1, keepdims=True)
    var = jnp.mean(jnp.square(xf - mu), -1, keepdims=True)
    return ((xf - mu) * lax.rsqrt(var + LN_EPS) * g.astype(F32) + b.astype(F32)).astype(x.dtype)


def rwkv_mix(zs, z_gate, wkv0, w0, w_w2, a0, w_a2, k_k, k_a, r_k, lnx_g, lnx_b):
    B, T, _ = zs.shape
    r, k, v, wd, ad = _split(zs.astype(F32), [R_WIDTH, R_WIDTH, R_WIDTH, LORA_W, LORA_A])
    w = -jax.nn.softplus(-(w0.astype(F32) + jnp.tanh(wd) @ w_w2.astype(F32))) - 0.5
    decay = jnp.exp(-jnp.exp(w))
    a = jax.nn.sigmoid(a0.astype(F32) + ad @ w_a2.astype(F32))
    kk = (k * k_k.astype(F32)).reshape(B, T, R_HEADS, R_HD)
    kk = kk / jnp.maximum(jnp.linalg.norm(kk, axis=-1, keepdims=True), 1e-12)
    k = k * (1.0 + (a - 1.0) * k_a.astype(F32))
    hs = lambda t: t.reshape(B, T, R_HEADS, R_HD)
    r, decay, k, v, a = hs(r), hs(decay), hs(k), hs(v), hs(a)
    xs = tuple(jnp.moveaxis(t, 1, 0) for t in (r, decay, k, v, kk, a))

    def step(S, inp):
        r_t, w_t, k_t, v_t, kk_t, a_t = inp
        sa = jnp.einsum('bhvk,bhk->bhv', S, -kk_t)
        S = (S * w_t[:, :, None, :] + sa[..., None] * (kk_t * a_t)[:, :, None, :]
             + v_t[..., None] * k_t[:, :, None, :])
        return S, jnp.einsum('bhvk,bhk->bhv', S, r_t)

    S_fin, o = lax.scan(step, wkv0.astype(F32), xs)
    o = jnp.moveaxis(o, 0, 1)
    mu = jnp.mean(o, -1, keepdims=True)
    var = jnp.mean(jnp.square(o - mu), -1, keepdims=True)
    o = ((o - mu) * lax.rsqrt(var + GN_EPS)).reshape(B, T, R_WIDTH) * lnx_g.astype(F32) + lnx_b.astype(F32)
    bonus = (jnp.sum(r * k * r_k.astype(F32), -1, keepdims=True) * v).reshape(B, T, R_WIDTH)
    y = (o + bonus) * jax.nn.silu(z_gate.astype(F32))
    return y.astype(zs.dtype), S_fin.astype(wkv0.dtype)


def dilated_attn_prompt(q, k, v, d, span):
    B, S, H, E = q.shape
    L = -(-S // d)
    nb = -(-L // span)
    Lp = nb * span
    pad = Lp * d - S

    def to_blocks(t):
        t = jnp.pad(t, ((0, 0), (0, pad), (0, 0), (0, 0)))
        t = jnp.swapaxes(t.reshape(B, Lp, d, H, E), 1, 2)
        return t.reshape(B, d, nb, span, H, E)

    def with_prev(t):
        prev = jnp.pad(t[:, :, :-1], ((0, 0), (0, 0), (1, 0), (0, 0), (0, 0), (0, 0)))
        return jnp.concatenate([prev, t], axis=3)

    qb = to_blocks(q)
    kc, vc = with_prev(to_blocks(k)), with_prev(to_blocks(v))
    s = jnp.einsum('bdnqhe,bdnkhe->bdnhqk', qb, kc).astype(F32) * (1.0 / math.sqrt(E))
    i = jnp.arange(span)[:, None]
    j = jnp.arange(2 * span)[None, :]
    dist = span + i - j
    valid = (dist >= 0) & (dist <= span)
    first = (jnp.arange(nb)[:, None, None] == 0) & (j[None] < span)
    valid = valid[None] & ~first
    s = jnp.where(valid[None, None, :, None], s, NEG)
    m = jnp.max(s, -1, keepdims=True)
    p = jnp.exp(s - m)
    l = jnp.sum(p, -1)
    o = jnp.einsum('bdnhqk,bdnkhe->bdnqhe', p, vc.astype(F32))
    o = o / jnp.swapaxes(l, 3, 4)[..., None]
    lse = jnp.swapaxes(m[..., 0] + jnp.log(l), 3, 4)

    def from_blocks(t):
        rest = t.shape[4:]
        t = jnp.swapaxes(t.reshape((B, d, Lp) + rest), 1, 2)
        return t.reshape((B, Lp * d) + rest)[:, :S]

    return from_blocks(o), from_blocks(lse)


def dilated_attn_cached(q, k, v, buf, d, span):
    B, T, H, E = q.shape
    Wb = buf.shape[1]
    kall = jnp.concatenate([buf[:, :, 0].astype(k.dtype), k], axis=1)
    vall = jnp.concatenate([buf[:, :, 1].astype(v.dtype), v], axis=1)
    idx = Wb + jnp.arange(T)[:, None] - jnp.arange(span + 1)[None, :] * d
    valid = idx >= 0
    idxc = jnp.maximum(idx, 0)
    kg = jnp.take(kall, idxc, axis=1)
    vg = jnp.take(vall, idxc, axis=1)
    s = jnp.einsum('bthe,btjhe->bthj', q, kg).astype(F32) * (1.0 / math.sqrt(E))
    s = jnp.where(valid[None, :, None, :], s, NEG)
    m = jnp.max(s, -1, keepdims=True)
    p = jnp.exp(s - m)
    l = jnp.sum(p, -1)
    o = jnp.einsum('bthj,btjhe->bthe', p, vg.astype(F32)) / l[..., None]
    return o, m[..., 0] + jnp.log(l)


def layer(x, shift_prev, wkv0, kv_bufs, w_in, b_gate, mu_shift, w0, w_w2, a0, w_a2, k_k, k_a, r_k,
          lnx_g, lnx_b, w_oa, w_ob, w_out, ln_g, ln_b):
    B, T, _ = x.shape
    h = x @ w_in
    zs, z_r, q, k, v, z_a, g_r, g_a = _split(
        h, [SHIFT_COLS, R_WIDTH, A_QKV_W, A_QKV_W, A_QKV_W, A_WIDTH, D_MODEL, D_MODEL])
    prev = jnp.concatenate([shift_prev[:, None].astype(zs.dtype), zs[:, :-1]], axis=1)
    zs_mixed = zs + mu_shift * (prev - zs)
    y_r, wkv_new = rwkv_mix(zs_mixed, z_r, wkv0, w0, w_w2, a0, w_a2, k_k, k_a, r_k, lnx_g, lnx_b)
    q = q.reshape(B, T, N_GROUPS, A_HEADS, A_HD)
    k = k.reshape(B, T, N_GROUPS, A_HEADS, A_HD)
    v = v.reshape(B, T, N_GROUPS, A_HEADS, A_HD)
    outs, lses, new_kv = [], [], []
    for g, (win, dil) in enumerate(A_GROUPS):
        span = win // dil
        qg, kg, vg = q[:, :, g], k[:, :, g], v[:, :, g]
        if kv_bufs is None:
            o, lse = dilated_attn_prompt(qg, kg, vg, dil, span)
            keep = min(win, T)
            new_kv.append(jnp.stack([kg[:, T - keep:], vg[:, T - keep:]], axis=2))
        else:
            o, lse = dilated_attn_cached(qg, kg, vg, kv_bufs[g], dil, span)
            new_kv.append(jnp.stack([kg, vg], axis=2))
        outs.append(o)
        lses.append(lse)
    wts = jax.nn.softmax(jnp.stack(lses, 0), axis=0)
    o = jnp.einsum('gbth,gbthe->bthe', wts, jnp.stack(outs, 0))
    y_a = (o.reshape(B, T, A_WIDTH) * jax.nn.silu(z_a.astype(F32))).astype(x.dtype)
    gate_r = jax.nn.sigmoid(g_r + b_gate[:D_MODEL])
    gate_a = jax.nn.sigmoid(g_a + b_gate[D_MODEL:])
    mix = gate_r * (y_r @ w_oa) + gate_a * (y_a @ w_ob)
    y = layer_norm(ALPHA * x + mix @ w_out, ln_g, ln_b)
    return y, new_kv, wkv_new, zs[:, -1]


def setup_inputs(seed: int = 0) -> dict:
    key = jax.random.key(seed)
    ks = jax.random.split(key, 32)
    n = lambda i, shape: jax.random.normal(ks[i], shape, F32)
    L = DEPTH
    col_scale = np.ones((N_IN,), np.float32)
    col_scale[2 * R_WIDTH:3 * R_WIDTH] = BETA
    v0 = SHIFT_COLS + R_WIDTH + 2 * A_QKV_W
    col_scale[v0:v0 + A_QKV_W] = BETA
    wb = [min(w, PAST_LEN) for (w, _) in A_GROUPS]
    return {
        "x_prompt": n(0, (BATCH, SEQ, D_MODEL)),
        "x_sample": n(1, (DEC_BATCH, DEC_SEQ, D_MODEL)),
        "cache_kv_g1": n(2, (L, DEC_BATCH, wb[0], 2, A_HEADS, A_HD)),
        "cache_kv_g2": n(3, (L, DEC_BATCH, wb[1], 2, A_HEADS, A_HD)),
        "cache_kv_g3": n(4, (L, DEC_BATCH, wb[2], 2, A_HEADS, A_HD)),
        "state_rwkv_wkv": 0.5 * n(5, (L, DEC_BATCH, R_HEADS, R_HD, R_HD)),
        "state_rwkv_shift": n(6, (L, DEC_BATCH, SHIFT_COLS)),
        "w_in": n(7, (L, D_MODEL, N_IN)) * (D_MODEL ** -0.5) * jnp.asarray(col_scale),
        "b_gate": 0.1 * n(8, (L, 2 * D_MODEL)),
        "mu_shift": jax.random.uniform(ks[9], (L, SHIFT_COLS), F32),
        "w0": jax.random.uniform(ks[10], (L, R_WIDTH), F32, -3.0, 1.0),
        "w_w2": n(11, (L, LORA_W, R_WIDTH)) * (LORA_W ** -0.5),
        "a0": 0.5 * n(12, (L, R_WIDTH)),
        "w_a2": n(13, (L, LORA_A, R_WIDTH)) * (LORA_A ** -0.5),
        "k_k": 0.85 + 0.05 * n(14, (L, R_WIDTH)),
        "k_a": 1.0 + 0.05 * n(15, (L, R_WIDTH)),
        "r_k": 0.1 * n(16, (L, R_HEADS, R_HD)),
        "lnx_g": 1.0 + 0.05 * n(17, (L, R_WIDTH)),
        "lnx_b": 0.02 * n(18, (L, R_WIDTH)),
        "w_oa": n(19, (L, R_WIDTH, D_MODEL)) * (R_WIDTH ** -0.5),
        "w_ob": n(20, (L, A_WIDTH, D_MODEL)) * (A_WIDTH ** -0.5),
        "w_out": n(21, (L, D_MODEL, D_MODEL)) * (D_MODEL ** -0.5) * BETA,
        "ln_g": 1.0 + 0.05 * n(22, (L, D_MODEL)),
        "ln_b": 0.02 * n(23, (L, D_MODEL)),
    }


def reference(x_prompt, x_sample, cache_kv_g1, cache_kv_g2, cache_kv_g3, state_rwkv_wkv, state_rwkv_shift,
              w_in, b_gate, mu_shift, w0, w_w2, a0, w_a2, k_k, k_a, r_k, lnx_g, lnx_b,
              w_oa, w_ob, w_out, ln_g, ln_b):
    xp, xs = x_prompt, x_sample
    Bp = xp.shape[0]
    kv1p, kv1s, kv2p, kv2s, kv3p, kv3s = [], [], [], [], [], []
    wkvp, wkvs, shp, shs = [], [], [], []
    for l in range(DEPTH):
        wts = (w_in[l], b_gate[l], mu_shift[l], w0[l], w_w2[l], a0[l], w_a2[l], k_k[l], k_a[l], r_k[l],
               lnx_g[l], lnx_b[l], w_oa[l], w_ob[l], w_out[l], ln_g[l], ln_b[l])
        shift0 = jnp.zeros((Bp, SHIFT_COLS), xp.dtype)
        wkv0 = jnp.zeros((Bp, R_HEADS, R_HD, R_HD), state_rwkv_wkv.dtype)
        xp, kv_p, s_p, sh_p = layer(xp, shift0, wkv0, None, *wts)
        xs, kv_s, s_s, sh_s = layer(xs, state_rwkv_shift[l], state_rwkv_wkv[l],
                                    (cache_kv_g1[l], cache_kv_g2[l], cache_kv_g3[l]), *wts)
        kv1p.append(kv_p[0]); kv2p.append(kv_p[1]); kv3p.append(kv_p[2])
        kv1s.append(kv_s[0]); kv2s.append(kv_s[1]); kv3s.append(kv_s[2])
        wkvp.append(s_p); wkvs.append(s_s); shp.append(sh_p); shs.append(sh_s)
    return (xp, xs, jnp.stack(kv1p), jnp.stack(kv1s), jnp.stack(kv2p), jnp.stack(kv2s),
            jnp.stack(kv3p), jnp.stack(kv3s), jnp.stack(wkvp), jnp.stack(wkvs), jnp.stack(shp), jnp.stack(shs))
```

```cpp
#include <hip/hip_runtime.h>
#include <cstdio>
#include <cstdint>
namespace pg8 {
#define PG8_LAS __attribute__((address_space(3)))
typedef unsigned short bf16_t;
typedef short bf16x8 __attribute__((ext_vector_type(8)));
typedef float f32x4 __attribute__((ext_vector_type(4)));
typedef unsigned u32x4 __attribute__((ext_vector_type(4)));
constexpr int BM = 256, BK = 64, HALF = 128, HTB = HALF * BK * 2  , STAGE_BYTES = 8 * HTB, NXCD = 8, WGM = 8;

__host__ __device__ __forceinline__ int lds_byte(int r, int c) { const int st = (r >> 4) * 2 + (c >> 5), rr = r & 15, cc = c & 31, ob = rr * 64 + cc * 2; return st * 1024 + (ob ^ (((ob >> 9) & 1) << 5)); }
__host__ __device__ __forceinline__ void stage_rc(int b, int& R, int& C) { const int st = b / 1024, sb = b % 1024, swz = sb ^ (((sb >> 9) & 1) << 5); R = (st >> 1) * 16 + swz / 64; C = (st & 1) * 32 + (swz % 64) / 2; }
__host__ __device__ __forceinline__ int perm32(int rho) { const int n = rho >> 4, i = rho & 15; return 8 * (i >> 2) + 4 * n + (i & 3); }

struct Unit { int pm, pn; };
struct Gemm { const bf16_t* A; const bf16_t* Bt; int M, N, K; };

struct StaticOrder {
    int nM, nN, nwg, G, c;
    __host__ __device__ void init(int M, int N, int G_, int c_) { nM = M / BM; nN = N / BM; nwg = nM * nN; G = G_; c = c_; }
    __host__ __device__ bool next(int i, Unit& u) const {
        const long L = (long)i * G + c; if (L >= nwg) return false;
        int wgid = (int)L; { const int q = nwg / NXCD, r = nwg % NXCD, xcd = wgid % NXCD, off = wgid / NXCD; wgid = (xcd < r ? xcd * (q + 1) : r * (q + 1) + (xcd - r) * q) + off; }
        const int nig = WGM * nN, gid = wgid / nig, fm = gid * WGM, gsz = (nM - fm) < WGM ? (nM - fm) : WGM;
        u.pm = fm + ((wgid % nig) % gsz); u.pn = (wgid % nig) / gsz; return true;
    }
    __device__ __forceinline__ void a_ready(const Unit&) const {}
    __device__ __forceinline__ void done(const Unit&) const {}
};

__device__ __forceinline__ unsigned cvt_pk_bf16(float lo, float hi) { unsigned r; asm volatile("v_cvt_pk_bf16_f32 %0, %1, %2" : "=v"(r) : "v"(lo), "v"(hi)); return r; }
typedef float f32x2 __attribute__((ext_vector_type(2)));
__device__ __forceinline__ f32x2 gelu_pk(f32x2 v) {
    const f32x2 av = __builtin_elementwise_abs(v), d = av * 0.2316418882f + 1.0f;
    f32x2 t; t.x = __builtin_amdgcn_rcpf(d.x); t.y = __builtin_amdgcn_rcpf(d.y);
    f32x2 q = t * 0.5307027145f + (-0.7265760135f); q = q * t + 0.7107068705f; q = q * t + (-0.142248368f); q = q * t + 0.127414796f; q = q * t;
    const f32x2 s = (v * v) * (-0.72134752044f);
    f32x2 e; e.x = __builtin_amdgcn_exp2f(s.x); e.y = __builtin_amdgcn_exp2f(s.y);
    const f32x2 m = v * (q * e), r = v - m;
    f32x2 o; o.x = v.x < 0.f ? m.x : r.x; o.y = v.y < 0.f ? m.y : r.y; return o;
}

template <int ACT  > struct EpiBf16 {
    static constexpr bool PERM = true, AFTER_DRAIN = false; static_assert(ACT == 0 || ACT == 1, "EpiBf16: ACT is 0 (none) or 1 (gelu_pk)");
    bf16_t* O; int ldc; const float* bias; int split_cols; size_t split_stride; float scale0;
    __device__ __forceinline__ void operator()(const f32x4 (&acc)[2][2][4][2], const Unit& u, int wr, int wc, int fr, int fq) const {
        const int row0 = u.pm * BM + wr * 64 + fr; int colt = u.pn * BM; bf16_t* base = O;
        float sc = 1.f; if (split_cols) { const int t = colt / split_cols; base += (size_t)t * split_stride; colt -= t * split_cols; if (t == 0) sc = scale0; }
        const int col0 = colt + wc * 32 + 8 * fq, bcol0 = u.pn * BM + wc * 32 + 8 * fq;
        f32x4 bv[2][2];
#pragma unroll
        for (int bj = 0; bj < 2; ++bj)
#pragma unroll
            for (int n = 0; n < 2; ++n) bv[bj][n] = bias ? *(const f32x4*)(bias + bcol0 + bj * HALF + 4 * n) : (f32x4){0.f, 0.f, 0.f, 0.f};
#pragma unroll
        for (int ai = 0; ai < 2; ++ai)
#pragma unroll
            for (int m = 0; m < 4; ++m) { bf16_t* rowp = base + (size_t)(row0 + ai * HALF + m * 16) * ldc + col0;
#pragma unroll
                for (int bj = 0; bj < 2; ++bj) { f32x4 v0 = acc[ai][bj][m][0] + bv[bj][0], v1 = acc[ai][bj][m][1] + bv[bj][1];
                    if (ACT == 1) { f32x2 a = gelu_pk((f32x2){v0[0], v0[1]}), b = gelu_pk((f32x2){v0[2], v0[3]}), c = gelu_pk((f32x2){v1[0], v1[1]}), d = gelu_pk((f32x2){v1[2], v1[3]});
                        v0 = (f32x4){a.x, a.y, b.x, b.y}; v1 = (f32x4){c.x, c.y, d.x, d.y}; }
                    v0 = v0 * sc; v1 = v1 * sc; u32x4 w; w.x = cvt_pk_bf16(v0[0], v0[1]); w.y = cvt_pk_bf16(v0[2], v0[3]); w.z = cvt_pk_bf16(v1[0], v1[1]); w.w = cvt_pk_bf16(v1[2], v1[3]);
                    *(u32x4*)(rowp + bj * HALF) = w; } }
    }
};

struct PanelStats {
    unsigned* xbuf;
    unsigned* cnt;
    unsigned* tmo;
    int ntn; float eps;
    unsigned code;
    __device__ __forceinline__ bool run(const f32x4 (&v)[2][2][4][2], const Unit& u, int wr, int wc, int fr, int fq, PG8_LAS unsigned char* lds, int wid, int lane) const {
        typedef float f32x2v __attribute__((ext_vector_type(2)));
        PG8_LAS f32x2v* P = (PG8_LAS f32x2v*)lds;
        PG8_LAS f32x2v* S = (PG8_LAS f32x2v*)(lds + 8192);
        PG8_LAS unsigned* flag = (PG8_LAS unsigned*)(lds + 8192 + 2048);
#pragma unroll
        for (int ai = 0; ai < 2; ++ai)
#pragma unroll
            for (int m = 0; m < 4; ++m) {
                float s = 0.f;
#pragma unroll
                for (int bj = 0; bj < 2; ++bj)
#pragma unroll
                    for (int n = 0; n < 2; ++n) { const f32x4 x = v[ai][bj][m][n]; s += (x[0] + x[1]) + (x[2] + x[3]); }
                s += __shfl_xor(s, 16); s += __shfl_xor(s, 32);
                const float mw = s * (1.0f / 64.0f); float q = 0.f;
#pragma unroll
                for (int bj = 0; bj < 2; ++bj)
#pragma unroll
                    for (int n = 0; n < 2; ++n) { const f32x4 d = v[ai][bj][m][n] - mw; q += (d[0] * d[0] + d[1] * d[1]) + (d[2] * d[2] + d[3] * d[3]); }
                q += __shfl_xor(q, 16); q += __shfl_xor(q, 32);
                if (fq == 0) P[(ai * HALF + wr * 64 + m * 16 + fr) * 4 + wc] = (f32x2v){mw, q};
            }
        asm volatile("s_waitcnt lgkmcnt(0)" ::: "memory"); __builtin_amdgcn_s_barrier(); asm volatile("" ::: "memory");
#if defined(BROKEN_EXCHANGE_NO_WAIT)
#warning BROKEN CONTROL BUILD: the row-statistics exchange does not wait; results are wrong by design
        if (blockIdx.x >= 64) { const long long t0_ = clock64(); while (clock64() - t0_ < 60000) __builtin_amdgcn_s_sleep(8); }
#endif
        const int row = wid * 32 + (lane & 31);
        if (lane < 32) {
            const f32x2v a = P[row * 4 + 0], b = P[row * 4 + 1], c = P[row * 4 + 2], d = P[row * 4 + 3];
            const float mt = (a.x + b.x + c.x + d.x) * 0.25f;
            const float da = a.x - mt, db = b.x - mt, dc = c.x - mt, dd = d.x - mt;
            const float m2 = (a.y + b.y) + (c.y + d.y) + 64.0f * ((da * da + db * db) + (dc * dc + dd * dd));
            unsigned long long* slot = (unsigned long long*)xbuf + ((size_t)(u.pm * BM + row) * 4 + u.pn);
            __hip_atomic_store(slot, ((unsigned long long)__float_as_uint(m2) << 32) | __float_as_uint(mt), __ATOMIC_RELAXED, __HIP_MEMORY_SCOPE_AGENT);
        }
        asm volatile("s_waitcnt vmcnt(0)" ::: "memory");
        if (lane == 0) __hip_atomic_fetch_add(cnt + 64 * u.pm, 1u, __ATOMIC_RELAXED, __HIP_MEMORY_SCOPE_AGENT);
        if (wid == 0) {
            bool dead = false; const unsigned long long t0 = __builtin_amdgcn_s_memrealtime(); const unsigned want = 8u * (unsigned)ntn;
            for (;;) {
#if defined(BROKEN_EXCHANGE_NO_WAIT)
                break;
#endif
                if ((unsigned)__builtin_amdgcn_readfirstlane(__hip_atomic_load(cnt + 64 * u.pm, __ATOMIC_RELAXED, __HIP_MEMORY_SCOPE_AGENT)) >= want) break;
                if (__builtin_amdgcn_s_memrealtime() - t0 > 2000000ull) {
                    if (lane == 0) { unsigned expect = 0u; __hip_atomic_compare_exchange_strong(tmo + 1, &expect, code | (unsigned)(u.pm & 0xff), __ATOMIC_RELAXED, __ATOMIC_RELAXED, __HIP_MEMORY_SCOPE_AGENT);
                                     __hip_atomic_store(tmo, 1u, __ATOMIC_RELAXED, __HIP_MEMORY_SCOPE_AGENT); }
                    dead = true; break; }
                __builtin_amdgcn_s_sleep(2);
            }
            __builtin_amdgcn_fence(__ATOMIC_ACQUIRE, "agent");
            if (lane == 0) flag[0] = dead ? 1u : 0u;
        }
        asm volatile("s_waitcnt vmcnt(0) lgkmcnt(0)" ::: "memory"); __builtin_amdgcn_s_barrier(); asm volatile("" ::: "memory");
        const bool bad = flag[0] != 0u;
        if (lane < 32) {
            const unsigned long long* slot = (const unsigned long long*)xbuf + (size_t)(u.pm * BM + row) * 4; float mt[4], m2[4]; float ms = 0.f;
#pragma unroll
            for (int t = 0; t < 4; ++t) { if (t < ntn) { const unsigned long long w = __hip_atomic_load(slot + t, __ATOMIC_RELAXED, __HIP_MEMORY_SCOPE_AGENT); mt[t] = __uint_as_float((unsigned)w); m2[t] = __uint_as_float((unsigned)(w >> 32)); } else { mt[t] = 0.f; m2[t] = 0.f; } ms += mt[t]; }
            const float mean = ms / (float)ntn; float q = 0.f;
#pragma unroll
            for (int t = 0; t < 4; ++t) if (t < ntn) { const float dm = mt[t] - mean; q += m2[t] + 256.0f * dm * dm; }
            S[row] = (f32x2v){mean, 1.0f / sqrtf(q / (256.0f * (float)ntn) + eps)};
        }
        asm volatile("s_waitcnt lgkmcnt(0)" ::: "memory"); __builtin_amdgcn_s_barrier(); asm volatile("" ::: "memory");
        return bad;
    }
};
struct EpiLnRes {
    static constexpr bool PERM = false, AFTER_DRAIN = true;
    const float* base; float* out; int ldc; const float* bias; PanelStats st; unsigned poison;
    __device__ __forceinline__ void fused(f32x4 (&acc)[2][2][4][2], const Unit& u, int wr, int wc, int fr, int fq, PG8_LAS unsigned char* lds, int wid, int lane) const {
        typedef float f32x2v __attribute__((ext_vector_type(2)));
        const PG8_LAS f32x2v* S = (const PG8_LAS f32x2v*)(lds + 8192);
        const int col0 = u.pn * BM + wc * 32 + 4 * fq;
#pragma unroll
        for (int bj = 0; bj < 2; ++bj)
#pragma unroll
            for (int n = 0; n < 2; ++n) { const f32x4 bv = bias ? *(const f32x4*)(bias + col0 + bj * HALF + n * 16) : (f32x4){0.f, 0.f, 0.f, 0.f};
#pragma unroll
                for (int ai = 0; ai < 2; ++ai)
#pragma unroll
                    for (int m = 0; m < 4; ++m) acc[ai][bj][m][n] += bv; }
        f32x4 pre[4][2][2];
#pragma unroll
        for (int m = 0; m < 4; ++m) { const size_t off = (size_t)(u.pm * BM + wr * 64 + m * 16 + fr) * ldc + col0;
#pragma unroll
            for (int bj = 0; bj < 2; ++bj)
#pragma unroll
                for (int n = 0; n < 2; ++n) pre[m][bj][n] = *(const f32x4*)(base + off + bj * HALF + n * 16); }
        const bool bad = st.run(acc, u, wr, wc, fr, fq, lds, wid, lane) || poison != 0u;
        const float qnan = __builtin_nanf("");
#pragma unroll
        for (int ai = 0; ai < 2; ++ai)
#pragma unroll
            for (int m = 0; m < 4; ++m) { const int r = ai * HALF + wr * 64 + m * 16 + fr; const f32x2v sr = S[r]; const size_t off = (size_t)(u.pm * BM + r) * ldc + col0;
#pragma unroll
                for (int bj = 0; bj < 2; ++bj)
#pragma unroll
                    for (int n = 0; n < 2; ++n) { const f32x4 bs = ai == 0 ? pre[m][bj][n] : *(const f32x4*)(base + off + bj * HALF + n * 16); f32x4 o = bs + (acc[ai][bj][m][n] - sr.x) * sr.y;
                        if (bad) o = (f32x4){qnan, qnan, qnan, qnan}; *(f32x4*)(out + off + bj * HALF + n * 16) = o; }
                if (m & 1) asm volatile("" ::: "memory"); }
    }
};
struct EpiLnResLn {
    static constexpr bool PERM = false, AFTER_DRAIN = true;
    const float* base; float* out; bf16_t* xn; int ldc; const float* bias; PanelStats st1, st2; unsigned poison;
    __device__ __forceinline__ void fused(f32x4 (&acc)[2][2][4][2], const Unit& u, int wr, int wc, int fr, int fq, PG8_LAS unsigned char* lds, int wid, int lane) const {
        typedef float f32x2v __attribute__((ext_vector_type(2))); typedef unsigned u32x2v __attribute__((ext_vector_type(2)));
        const PG8_LAS f32x2v* S = (const PG8_LAS f32x2v*)(lds + 8192);
        const int col0 = u.pn * BM + wc * 32 + 4 * fq;
#pragma unroll
        for (int bj = 0; bj < 2; ++bj)
#pragma unroll
            for (int n = 0; n < 2; ++n) { const f32x4 bv = bias ? *(const f32x4*)(bias + col0 + bj * HALF + n * 16) : (f32x4){0.f, 0.f, 0.f, 0.f};
#pragma unroll
                for (int ai = 0; ai < 2; ++ai)
#pragma unroll
                    for (int m = 0; m < 4; ++m) acc[ai][bj][m][n] += bv; }
        bool bad = st1.run(acc, u, wr, wc, fr, fq, lds, wid, lane) || poison != 0u;
        const float qnan = __builtin_nanf("");
#pragma unroll
        for (int ai = 0; ai < 2; ++ai)
#pragma unroll
            for (int m = 0; m < 4; ++m) { const int r = ai * HALF + wr * 64 + m * 16 + fr; const f32x2v sr = S[r]; const size_t off = (size_t)(u.pm * BM + r) * ldc + col0;
#pragma unroll
                for (int bj = 0; bj < 2; ++bj)
#pragma unroll
                    for (int n = 0; n < 2; ++n) { const f32x4 bs = *(const f32x4*)(base + off + bj * HALF + n * 16); acc[ai][bj][m][n] = bs + (acc[ai][bj][m][n] - sr.x) * sr.y; }
                asm volatile("" : "+v"(acc[ai][0][m][0]), "+v"(acc[ai][0][m][1]), "+v"(acc[ai][1][m][0]), "+v"(acc[ai][1][m][1]));
                if (m & 1) asm volatile("" ::: "memory"); }
        const bool bad1 = bad;
        bad = st2.run(acc, u, wr, wc, fr, fq, lds, wid, lane) || bad;
#pragma unroll
        for (int ai = 0; ai < 2; ++ai)
#pragma unroll
            for (int m = 0; m < 4; ++m) { const int r = ai * HALF + wr * 64 + m * 16 + fr; const f32x2v sr = S[r]; const size_t off = (size_t)(u.pm * BM + r) * ldc + col0;
#pragma unroll
                for (int bj = 0; bj < 2; ++bj)
#pragma unroll
                    for (int n = 0; n < 2; ++n) { const f32x4 x1 = acc[ai][bj][m][n]; *(f32x4*)(out + off + bj * HALF + n * 16) = bad1 ? (f32x4){qnan, qnan, qnan, qnan} : x1;
                        const f32x4 o = (x1 - sr.x) * sr.y; u32x2v w; w.x = cvt_pk_bf16(o[0], o[1]); w.y = cvt_pk_bf16(o[2], o[3]);
                        if (bad) { w.x = 0x7fc07fc0u; w.y = 0x7fc07fc0u; } *(u32x2v*)(xn + off + bj * HALF + n * 16) = w; }
                asm volatile("" ::: "memory"); }
    }
};

template <class Epi, class Sched, bool ALIGN_EPI = false, bool SP2 = false>
__device__ __forceinline__ void gemm_phase(PG8_LAS unsigned char* lds, const Gemm g, const Sched& S, const Epi& E) {
    const int tid = threadIdx.x, wid = __builtin_amdgcn_readfirstlane(tid >> 6), lane = tid & 63, wr = wid >> 2, wc = wid & 3, fr = lane & 15, fq = lane >> 4;
    const int K = g.K, nt = K / BK;
    unsigned voffA[2], voffB[2];
#pragma unroll
    for (int i = 0; i < 2; ++i) { int R, C; stage_rc(tid * 16 + i * 8192, R, C); const int Rb = Epi::PERM ? ((R & ~31) + perm32(R & 31)) : R;
        voffA[i] = (unsigned)(R * K + C) * 2u; voffB[i] = (unsigned)(Rb * K + C) * 2u; }
    const size_t kstep = (size_t)(BK * 2);
    const size_t hstep = (size_t)HALF * K * 2;
    const size_t tstep = 2 * hstep;
    const unsigned ldsw = (unsigned)wid * 1024u;
    const int aoff = lds_byte(wr * 64 + fr, fq * 8), boff = lds_byte(wc * 32 + fr, fq * 8);
#define PG8_SA(b, h) (((b) * 2 + (h)) * HTB)
#define PG8_SB(b, h) ((4 + (b) * 2 + (h)) * HTB)
#define PG8_STAGE(bufoff, gbase, voff) do { _Pragma("unroll") for (int _i = 0; _i < 2; ++_i) \
        __builtin_amdgcn_global_load_lds((const unsigned*)((const char*)(gbase) + (voff)[_i]), (PG8_LAS unsigned*)(lds + (bufoff) + ldsw + _i * 8192), 16, 0, 0); } while (0)
#define PG8_LDA(dst, b, h) do { _Pragma("unroll") for (int m = 0; m < 4; ++m) _Pragma("unroll") for (int k = 0; k < 2; ++k) dst[m][k] = *(const PG8_LAS bf16x8*)(lds + PG8_SA(b, h) + aoff + m * 2048 + k * 1024); } while (0)
#define PG8_LDB(dst, b, h) do { _Pragma("unroll") for (int n = 0; n < 2; ++n) _Pragma("unroll") for (int k = 0; k < 2; ++k) dst[n][k] = *(const PG8_LAS bf16x8*)(lds + PG8_SB(b, h) + boff + n * 2048 + k * 1024); } while (0)
#define PG8_MMA(ai, bj, At, Bt) do { __builtin_amdgcn_s_setprio(1); _Pragma("unroll") for (int m = 0; m < 4; ++m) _Pragma("unroll") for (int n = 0; n < 2; ++n) _Pragma("unroll") for (int k = 0; k < 2; ++k) \
        acc[ai][bj][m][n] = __builtin_amdgcn_mfma_f32_16x16x32_bf16(Bt[n][k], At[m][k], acc[ai][bj][m][n], 0, 0, 0); __builtin_amdgcn_s_setprio(0); } while (0)
#define PG8_WAIT_V(n) asm volatile("s_waitcnt vmcnt(" #n ")" ::: "memory")
#define PG8_WAIT_L(n) asm volatile("s_waitcnt lgkmcnt(" #n ")" ::: "memory")
#define PG8_BAR __builtin_amdgcn_s_barrier()
#define PG8_SCHED __builtin_amdgcn_sched_barrier(0)
    Unit cur, nxt; int ui = 0;
    if (!S.next(0, cur)) return;
    f32x4 acc[2][2][4][2];
#pragma unroll
    for (int a = 0; a < 2; ++a)
#pragma unroll
        for (int b = 0; b < 2; ++b)
#pragma unroll
            for (int m = 0; m < 4; ++m)
#pragma unroll
                for (int n = 0; n < 2; ++n) acc[a][b][m][n] = (f32x4){0.f, 0.f, 0.f, 0.f};
    bf16x8 At[4][2], B0[2][2], B1[2][2];
    const char* cA = (const char*)g.A + (size_t)cur.pm * tstep; const char* cB = (const char*)g.Bt + (size_t)cur.pn * tstep;
    S.a_ready(cur);
    if constexpr (SP2) {
        PG8_STAGE(PG8_SB(0, 0), cB, voffB); PG8_STAGE(PG8_SB(0, 1), cB + hstep, voffB); PG8_STAGE(PG8_SA(0, 0), cA, voffA); PG8_STAGE(PG8_SA(0, 1), cA + hstep, voffA);
        if (wr == 1) PG8_BAR;
        PG8_WAIT_V(2); PG8_BAR;
        PG8_STAGE(PG8_SB(1, 0), cB + kstep, voffB); PG8_STAGE(PG8_SA(1, 0), cA + kstep, voffA); PG8_STAGE(PG8_SB(1, 1), cB + hstep + kstep, voffB);
        PG8_WAIT_V(6); PG8_BAR;
    } else {
        PG8_STAGE(PG8_SB(0, 0), cB, voffB); PG8_STAGE(PG8_SA(0, 0), cA, voffA); PG8_STAGE(PG8_SB(0, 1), cB + hstep, voffB); PG8_STAGE(PG8_SA(0, 1), cA + hstep, voffA);
        if (wr == 1) PG8_BAR;
        PG8_WAIT_V(4); PG8_BAR;
        PG8_STAGE(PG8_SB(1, 0), cB + kstep, voffB); PG8_STAGE(PG8_SA(1, 0), cA + kstep, voffA); PG8_STAGE(PG8_SB(1, 1), cB + hstep + kstep, voffB);
        PG8_WAIT_V(6); PG8_BAR;
    }
    for (;;) {
        const bool has_next = S.next(ui + 1, nxt);
        const char* nA = has_next ? (const char*)g.A + (size_t)nxt.pm * tstep : cA; const char* nB = has_next ? (const char*)g.Bt + (size_t)nxt.pn * tstep : cB;
        for (int t = 0; t < nt; t += 2) {
            const bool last = (t == nt - 2);
            const char* a1 = cA + (size_t)(t + 1) * kstep;
            const char* a2 = last ? nA : cA + (size_t)(t + 2) * kstep; const char* b2 = last ? nB : cB + (size_t)(t + 2) * kstep;
            const char* a3 = a2 + kstep; const char* b3 = b2 + kstep;
            if (last && has_next) S.a_ready(nxt);
            if constexpr (SP2) {
            PG8_LDB(B0, 0, 0); PG8_LDB(B1, 0, 1); PG8_SCHED; PG8_LDA(At, 0, 0); PG8_STAGE(PG8_SA(1, 1), a1 + hstep, voffA);
            PG8_WAIT_V(8); PG8_WAIT_L(0); PG8_BAR; PG8_MMA(0, 0, At, B0); PG8_MMA(0, 1, At, B1); PG8_BAR; PG8_SCHED;
            PG8_LDA(At, 0, 1); PG8_STAGE(PG8_SB(0, 0), b2, voffB); PG8_STAGE(PG8_SB(0, 1), b2 + hstep, voffB); PG8_STAGE(PG8_SA(0, 0), a2, voffA);
            PG8_WAIT_V(8); PG8_WAIT_L(0); PG8_BAR; PG8_MMA(1, 0, At, B0); PG8_MMA(1, 1, At, B1); PG8_BAR; PG8_SCHED;
            PG8_LDB(B0, 1, 0); PG8_LDB(B1, 1, 1); PG8_SCHED; PG8_LDA(At, 1, 0); PG8_STAGE(PG8_SA(0, 1), a2 + hstep, voffA);
            PG8_WAIT_V(8); PG8_WAIT_L(0); PG8_BAR; PG8_MMA(0, 0, At, B0); PG8_MMA(0, 1, At, B1); PG8_BAR; PG8_SCHED;
            PG8_LDA(At, 1, 1); PG8_STAGE(PG8_SB(1, 0), b3, voffB); PG8_STAGE(PG8_SB(1, 1), b3 + hstep, voffB); PG8_STAGE(PG8_SA(1, 0), a3, voffA);
            PG8_WAIT_V(8); PG8_WAIT_L(0); PG8_BAR; PG8_MMA(1, 0, At, B0); PG8_MMA(1, 1, At, B1); PG8_BAR; PG8_SCHED;
            } else {
            PG8_LDB(B0, 0, 0); PG8_SCHED; PG8_LDA(At, 0, 0); PG8_STAGE(PG8_SA(1, 1), a1 + hstep, voffA);
            PG8_WAIT_L(8); PG8_BAR; PG8_WAIT_L(0); PG8_MMA(0, 0, At, B0); PG8_BAR; PG8_SCHED;
            PG8_LDB(B1, 0, 1); PG8_STAGE(PG8_SB(0, 0), b2, voffB);
            PG8_BAR; PG8_WAIT_L(0); PG8_MMA(0, 1, At, B1); PG8_BAR;
            PG8_LDA(At, 0, 1); PG8_STAGE(PG8_SA(0, 0), a2, voffA);
            PG8_BAR; PG8_WAIT_L(0); PG8_MMA(1, 0, At, B0); PG8_BAR; PG8_SCHED;
            PG8_STAGE(PG8_SB(0, 1), b2 + hstep, voffB);
            PG8_WAIT_V(6); PG8_BAR; PG8_MMA(1, 1, At, B1); PG8_BAR;
            PG8_LDB(B0, 1, 0); PG8_SCHED; PG8_LDA(At, 1, 0); PG8_STAGE(PG8_SA(0, 1), a2 + hstep, voffA);
            PG8_WAIT_L(8); PG8_BAR; PG8_WAIT_L(0); PG8_MMA(0, 0, At, B0); PG8_BAR; PG8_SCHED;
            PG8_LDB(B1, 1, 1); PG8_STAGE(PG8_SB(1, 0), b3, voffB);
            PG8_BAR; PG8_WAIT_L(0); PG8_MMA(0, 1, At, B1); PG8_BAR;
            PG8_LDA(At, 1, 1); PG8_STAGE(PG8_SA(1, 0), a3, voffA);
            PG8_BAR; PG8_WAIT_L(0); PG8_MMA(1, 0, At, B0); PG8_BAR; PG8_SCHED;
            PG8_STAGE(PG8_SB(1, 1), b3 + hstep, voffB);
            PG8_WAIT_V(6); PG8_BAR; PG8_MMA(1, 1, At, B1); PG8_BAR;
            }
        }
        if constexpr (ALIGN_EPI) { if (wr == 0) PG8_BAR; }
        if constexpr (!Epi::AFTER_DRAIN) { E(acc, cur, wr, wc, fr, fq); S.done(cur); }
        if (!has_next) break;
#pragma unroll
        for (int a = 0; a < 2; ++a)
#pragma unroll
            for (int b = 0; b < 2; ++b)
#pragma unroll
                for (int m = 0; m < 4; ++m)
#pragma unroll
                    for (int n = 0; n < 2; ++n) acc[a][b][m][n] = (f32x4){0.f, 0.f, 0.f, 0.f};
        cur = nxt; cA = nA; cB = nB; ++ui;
        if constexpr (ALIGN_EPI) { if (wr == 1) PG8_BAR; }
    }
    PG8_WAIT_V(0);
    if constexpr (!ALIGN_EPI) { if (wr == 0) PG8_BAR; }
    PG8_BAR;
    if constexpr (Epi::AFTER_DRAIN) { E.fused(acc, cur, wr, wc, fr, fq, lds, wid, lane); S.done(cur); }
#undef PG8_SA
#undef PG8_SB
#undef PG8_STAGE
#undef PG8_LDA
#undef PG8_LDB
#undef PG8_MMA
#undef PG8_WAIT_V
#undef PG8_WAIT_L
#undef PG8_BAR
#undef PG8_SCHED
}
}
#ifndef PG8_SP2
#define PG8_SP2 true
#endif
#ifndef PG8_ALIGN
#define PG8_ALIGN true
#endif
constexpr int NWAVES = 8;
#ifndef MK_N_LAUNCHES
#define MK_N_LAUNCHES 1
#endif
constexpr int N_PHASES = 9;
constexpr int N_LAUNCHES = MK_N_LAUNCHES;

constexpr int DM = 1024, SEQ = 8192, NBATCH = 2, MP = NBATCH * SEQ, DBATCH = 128, DSEQ = 4, MS = DBATCH * DSEQ, M = MP + MS;
constexpr int NIN = 9344, NH = 9472;
constexpr int RW = 512, SHIFTC = 1664;
constexpr int C_R = 0, C_K = 512, C_V = 1024, C_WD = 1536, C_AD = 1600, C_ZR = 1792, C_AQ = 2304, C_AK = 3840, C_AV = 5376, C_ZA = 6912, C_GR = 7424, C_GA = 8448;
constexpr float LN_EPS = 1e-5f, GN_EPS = 64e-5f;
constexpr float ALPHA = 1.189207115002721f;
constexpr float ATT_SCALE = 0.08838834764831845f;
constexpr size_t O_YP = 0, O_YS = O_YP + (size_t)MP * DM, O_KV1P = O_YS + (size_t)MS * DM, O_KV1S = O_KV1P + (size_t)2 * 128 * 1024, O_KV2P = O_KV1S + (size_t)MS * 1024,
                 O_KV2S = O_KV2P + (size_t)2 * 512 * 1024, O_KV3P = O_KV2S + (size_t)MS * 1024, O_KV3S = O_KV3P + (size_t)2 * 2048 * 1024, O_WKVP = O_KV3S + (size_t)MS * 1024,
                 O_WKVS = O_WKVP + (size_t)2 * 8 * 64 * 64, O_SHP = O_WKVS + (size_t)128 * 8 * 64 * 64, O_SHS = O_SHP + (size_t)2 * SHIFTC, O_END = O_SHS + (size_t)128 * SHIFTC;
static_assert(O_END == 28855552, "d_out size");

constexpr size_t MiB = 1u << 20;
constexpr size_t WS_CTL = 0, CTL_ZERO_BYTES = 1 * MiB;
constexpr size_t WS_WIN = 2 * MiB, WS_WOA = 22 * MiB, WS_WOB = 23 * MiB, WS_WOUT = 24 * MiB;
constexpr size_t WS_XB = 32 * MiB, WS_H = 96 * MiB, WS_YR = 416 * MiB, WS_YA = 448 * MiB, WS_MIX = 480 * MiB, WS_MIXF = 528 * MiB, WS_PRE = 608 * MiB;
constexpr size_t WS_RR = 704 * MiB, WS_DEC = 744 * MiB, WS_K2 = 784 * MiB, WS_VV = 824 * MiB, WS_KK = 864 * MiB, WS_KA = 904 * MiB, WS_OO = 944 * MiB, WS_END = 984 * MiB;
static_assert(WS_WIN + (size_t)NH * DM * 2 <= WS_WOA && WS_XB + (size_t)M * DM * 2 <= WS_H && WS_H + (size_t)M * NH * 2 <= WS_YR, "ws map");
constexpr int CW_TMO = 0, CW_CODE = 1, CW_BAR = 4096;

constexpr int RING_OFF = 0, RING_BYTES = 131072;
constexpr int LDSCTL_OFF = RING_BYTES, MISC_OFF = LDSCTL_OFF + 320;
constexpr int LDS_BYTES = 147456;
#define GAS __attribute__((address_space(1)))
#define LAS __attribute__((address_space(3)))
typedef unsigned short bf16;
typedef unsigned v4u __attribute__((ext_vector_type(4)));
typedef float f32x4 __attribute__((ext_vector_type(4)));
typedef short bf16x8 __attribute__((ext_vector_type(8)));
typedef GAS unsigned gu32;
typedef GAS unsigned long long gu64;
#define RLX_AGENT __ATOMIC_RELAXED, __HIP_MEMORY_SCOPE_AGENT
#define LDS_WAIT() asm volatile("s_waitcnt lgkmcnt(0)" ::: "memory")
#define VM_WAIT() asm volatile("s_waitcnt vmcnt(0)" ::: "memory")
__device__ __forceinline__ unsigned long long rt() { return __builtin_amdgcn_s_memrealtime(); }
__device__ __forceinline__ unsigned f2bf(float f) { unsigned u = __builtin_bit_cast(unsigned, f); return (u + 0x7fffu + ((u >> 16) & 1u)) >> 16; }
__device__ __forceinline__ unsigned pk2(float lo, float hi) { return f2bf(lo) | (f2bf(hi) << 16); }

#define XB_TMO      128
#define XB_XCNT(j)  (256  + 64 * (j))
#define XB_XSUB(j)  (1280 + 64 * (j))
#define XB_XGEN(j)  (2304 + 64 * (j))
#define XB_TOP      3328
#define XB_TOPGEN   3392
#define XCD_BAR_WORDS 3456
#define XB_SPIN_CAP (1u << 18)

__device__ __forceinline__ unsigned xb_ld(unsigned* p)              { return __hip_atomic_load(p, __ATOMIC_RELAXED, __HIP_MEMORY_SCOPE_AGENT); }
__device__ __forceinline__ unsigned xb_add(unsigned* p, unsigned v) { return __hip_atomic_fetch_add(p, v, __ATOMIC_RELAXED, __HIP_MEMORY_SCOPE_AGENT); }
__device__ __forceinline__ unsigned xb_xcc_id() { return (unsigned)__builtin_amdgcn_s_getreg((3 << 11) | 20) & 0xFu; }
#define XB_SPIN(cond, bar) do { unsigned _sp = 0; while (cond) { __builtin_amdgcn_s_sleep(1); \
    if ((++_sp & 255u) == 0u) { if (xb_ld(&(bar)[XB_TMO])) break; if (_sp > XB_SPIN_CAP) { atomicAdd(&(bar)[XB_TMO], 1u); break; } } } } while (0)

struct XcdBarrier {
    unsigned* bar; unsigned x;
    volatile LAS unsigned* st;
};

__device__ __forceinline__ XcdBarrier xcd_barrier_post(unsigned* bar, volatile LAS unsigned* st) {
    XcdBarrier b; b.bar = bar; b.x = xb_xcc_id(); b.st = st;
    if (threadIdx.x == 0) (void)xb_add(&bar[XB_XCNT(b.x)], 1u);
    return b;
}
__device__ __forceinline__ void xcd_barrier_complete(unsigned* bar, unsigned x, unsigned& nloc, unsigned& nx) {
    const unsigned G = gridDim.x * gridDim.y * gridDim.z;
    unsigned sum, cnt, mine, sp = 0u;
    for (;;) {
        sum = 0u; cnt = 0u; mine = 0u;
#pragma unroll
        for (unsigned j = 0; j < 16; ++j) { const unsigned c = xb_ld(&bar[XB_XCNT(j)]); sum += c; cnt += (c > 0u) ? 1u : 0u; mine = (j == x) ? c : mine; }
        if (sum == G) break;
        __builtin_amdgcn_s_sleep(1);
        if ((++sp & 255u) == 0u) { if (xb_ld(&bar[XB_TMO])) break; if (sp > XB_SPIN_CAP) { atomicAdd(&bar[XB_TMO], 1u); break; } }
    }
    nloc = mine > 0u ? mine : 1u; nx = cnt > 0u ? cnt : 1u;
}

__device__ __forceinline__ void xcd_barrier(const XcdBarrier& b) {
    asm volatile("s_waitcnt vmcnt(0)" ::: "memory");
    __syncthreads();
    if (threadIdx.x == 0) {
        unsigned* bar = b.bar;
        __builtin_amdgcn_s_waitcnt(0);
        unsigned nloc = b.st[0], nx = b.st[1];
        if (nloc == 0u) { xcd_barrier_complete(bar, b.x, nloc, nx); b.st[0] = nloc; b.st[1] = nx; }
        const unsigned old = xb_add(&bar[XB_XSUB(b.x)], 1u);
        const unsigned gen = old / nloc;
        if (old + 1u == (gen + 1u) * nloc) {
            __builtin_amdgcn_fence(__ATOMIC_RELEASE, "agent");
            asm volatile("s_waitcnt vmcnt(0)" ::: "memory");
            const unsigned og = xb_add(&bar[XB_TOP], 1u);
            const unsigned tg = og / nx;
            if (og + 1u == (tg + 1u) * nx) xb_add(&bar[XB_TOPGEN], 1u);
            else XB_SPIN(xb_ld(&bar[XB_TOPGEN]) == tg, bar);
            __builtin_amdgcn_fence(__ATOMIC_ACQUIRE, "agent");
            xb_add(&bar[XB_XGEN(b.x)], 1u);
            asm volatile("s_waitcnt vmcnt(0)" ::: "memory");
        } else {
            XB_SPIN(xb_ld(&bar[XB_XGEN(b.x)]) == gen, bar);
            __builtin_amdgcn_fence(__ATOMIC_ACQUIRE, "agent");
            asm volatile("s_waitcnt vmcnt(0)" ::: "memory");
        }
    }
    __syncthreads();
}

typedef unsigned u32x2 __attribute__((ext_vector_type(2)));
__device__ __forceinline__ float bf2f(unsigned b) { return __builtin_bit_cast(float, b << 16); }
__device__ __forceinline__ float wave_sum(float v) {
#pragma unroll
    for (int o = 1; o < 64; o <<= 1) v += __shfl_xor(v, o);
    return v;
}
__device__ __forceinline__ float wave_max(float v) {
#pragma unroll
    for (int o = 1; o < 64; o <<= 1) v = fmaxf(v, __shfl_xor(v, o));
    return v;
}
__device__ __forceinline__ float sigmoidf_(float x) { return 1.0f / (1.0f + __expf(-x)); }
__device__ __forceinline__ float siluf_(float x) { return x / (1.0f + __expf(-x)); }

namespace pg8 {
struct EpiH {
    static constexpr bool PERM = true, AFTER_DRAIN = false;
    bf16_t* H; const float* bgate; float* out;
    __device__ __forceinline__ void operator()(const f32x4 (&acc)[2][2][4][2], const Unit& u, int wr, int wc, int fr, int fq) const {
        const int pn = u.pn;
        const int row0 = u.pm * BM + wr * 64 + fr, cw = wc * 32 + 8 * fq;
        const int mode = (pn >= 29) ? 2 : ((pn == 7 || pn == 8 || pn == 27 || pn == 28) ? 1 : 0);
        const bool is_zs = pn <= 6, is_kv = (pn >= 15 && pn <= 26);
        int kvsel = 0, g = 0, hcb = 0;
        if (is_kv) { int q = pn - 15; kvsel = q >= 6 ? 1 : 0; q = q >= 6 ? q - 6 : q; g = q >> 1; hcb = (q & 1) * 256; }
        const int keep = 128 << (2 * g);
        float* kvp = out + (g == 0 ? O_KV1P : (g == 1 ? O_KV2P : O_KV3P));
        float* kvs = out + (g == 0 ? O_KV1S : (g == 1 ? O_KV2S : O_KV3S));
        f32x4 bv[2][2];
#pragma unroll
        for (int bj = 0; bj < 2; ++bj)
#pragma unroll
            for (int n = 0; n < 2; ++n) bv[bj][n] = (mode == 2) ? *(const f32x4*)(bgate + (pn * BM + bj * HALF + cw - C_GR) + 4 * n) : (f32x4){0.f, 0.f, 0.f, 0.f};
#pragma unroll
        for (int ai = 0; ai < 2; ++ai)
#pragma unroll
            for (int m = 0; m < 4; ++m) {
                const int row = row0 + ai * HALF + m * 16;
                bf16_t* rowp = H + (size_t)row * NH + pn * BM + cw;
#pragma unroll
                for (int bj = 0; bj < 2; ++bj) {
                    f32x4 v0 = acc[ai][bj][m][0], v1 = acc[ai][bj][m][1];
                    const int col = pn * BM + bj * HALF + cw;
                    if (is_zs && col < SHIFTC) {
                        float* dst = nullptr;
                        if (row < MP) { if ((row & (SEQ - 1)) == SEQ - 1) dst = out + O_SHP + (size_t)(row >> 13) * SHIFTC + col; }
                        else if (((row - MP) & 3) == 3) dst = out + O_SHS + (size_t)((row - MP) >> 2) * SHIFTC + col;
                        if (dst) { *(f32x4*)dst = v0; *(f32x4*)(dst + 4) = v1; }
                    }
                    if (is_kv) {
                        const int hc = hcb + bj * HALF + cw;
                        float* dst = nullptr;
                        if (row < MP) { const int t = row & (SEQ - 1), b = row >> 13; if (t >= SEQ - keep) dst = kvp + ((size_t)(b * keep + t - (SEQ - keep)) * 2 + kvsel) * 512 + hc; }
                        else dst = kvs + ((size_t)(row - MP) * 2 + kvsel) * 512 + hc;
                        if (dst) { *(f32x4*)dst = v0; *(f32x4*)(dst + 4) = v1; }
                    }
                    if (mode == 1) {
#pragma unroll
                        for (int j = 0; j < 4; ++j) { v0[j] = siluf_(v0[j]); v1[j] = siluf_(v1[j]); }
                    } else if (mode == 2) {
                        v0 = v0 + bv[bj][0]; v1 = v1 + bv[bj][1];
#pragma unroll
                        for (int j = 0; j < 4; ++j) { v0[j] = sigmoidf_(v0[j]); v1[j] = sigmoidf_(v1[j]); }
                    }
                    u32x4 w; w.x = cvt_pk_bf16(v0[0], v0[1]); w.y = cvt_pk_bf16(v0[2], v0[3]); w.z = cvt_pk_bf16(v1[0], v1[1]); w.w = cvt_pk_bf16(v1[2], v1[3]);
                    *(u32x4*)(rowp + bj * HALF) = w;
                }
            }
    }
};
struct EpiMixA {
    static constexpr bool PERM = false, AFTER_DRAIN = false;
    const bf16_t* H; float* MIXF;
    __device__ __forceinline__ void operator()(const f32x4 (&acc)[2][2][4][2], const Unit& u, int wr, int wc, int fr, int fq) const {
        const int row0 = u.pm * BM + wr * 64 + fr, col0 = u.pn * BM + wc * 32 + 4 * fq;
#pragma unroll
        for (int ai = 0; ai < 2; ++ai)
#pragma unroll
            for (int m = 0; m < 4; ++m) { const int row = row0 + ai * HALF + m * 16;
#pragma unroll
                for (int bj = 0; bj < 2; ++bj)
#pragma unroll
                    for (int n = 0; n < 2; ++n) { const int c = col0 + bj * HALF + n * 16;
                        const u32x2 gb = *(const u32x2*)(H + (size_t)row * NH + C_GR + c);
                        f32x4 gt = {bf2f(gb.x & 0xffffu), bf2f(gb.x >> 16), bf2f(gb.y & 0xffffu), bf2f(gb.y >> 16)};
                        *(f32x4*)(MIXF + (size_t)row * DM + c) = gt * acc[ai][bj][m][n]; } }
    }
};
struct EpiMixB {
    static constexpr bool PERM = false, AFTER_DRAIN = false;
    const bf16_t* H; const float* MIXF; bf16_t* MIX;
    __device__ __forceinline__ void operator()(const f32x4 (&acc)[2][2][4][2], const Unit& u, int wr, int wc, int fr, int fq) const {
        const int row0 = u.pm * BM + wr * 64 + fr, col0 = u.pn * BM + wc * 32 + 4 * fq;
#pragma unroll
        for (int ai = 0; ai < 2; ++ai)
#pragma unroll
            for (int m = 0; m < 4; ++m) { const int row = row0 + ai * HALF + m * 16;
#pragma unroll
                for (int bj = 0; bj < 2; ++bj)
#pragma unroll
                    for (int n = 0; n < 2; ++n) { const int c = col0 + bj * HALF + n * 16;
                        const u32x2 gb = *(const u32x2*)(H + (size_t)row * NH + C_GA + c);
                        f32x4 gt = {bf2f(gb.x & 0xffffu), bf2f(gb.x >> 16), bf2f(gb.y & 0xffffu), bf2f(gb.y >> 16)};
                        const f32x4 v = *(const f32x4*)(MIXF + (size_t)row * DM + c) + gt * acc[ai][bj][m][n];
                        u32x2 w; w.x = cvt_pk_bf16(v[0], v[1]); w.y = cvt_pk_bf16(v[2], v[3]);
                        *(u32x2*)(MIX + (size_t)row * DM + c) = w; } }
    }
};
struct EpiPre {
    static constexpr bool PERM = false, AFTER_DRAIN = false;
    const float* xp; const float* xs; float* PRE;
    __device__ __forceinline__ void operator()(const f32x4 (&acc)[2][2][4][2], const Unit& u, int wr, int wc, int fr, int fq) const {
        const int row0 = u.pm * BM + wr * 64 + fr, col0 = u.pn * BM + wc * 32 + 4 * fq;
#pragma unroll
        for (int ai = 0; ai < 2; ++ai)
#pragma unroll
            for (int m = 0; m < 4; ++m) { const int row = row0 + ai * HALF + m * 16;
                const float* xr = row < MP ? xp + (size_t)row * DM : xs + (size_t)(row - MP) * DM;
#pragma unroll
                for (int bj = 0; bj < 2; ++bj)
#pragma unroll
                    for (int n = 0; n < 2; ++n) { const int c = col0 + bj * HALF + n * 16;
                        *(f32x4*)(PRE + (size_t)row * DM + c) = *(const f32x4*)(xr + c) * ALPHA + acc[ai][bj][m][n]; } }
    }
};
}

struct Args { const float* in[24]; float* out; unsigned char* ws; int ph_lo, ph_hi; };
struct Frame {
    LAS unsigned char* lds;
    volatile LAS unsigned* MISC;
    gu32* ctl;
    int tid, lane, wave, G;
};
#define XP_(A) ((A).in[0])
#define XS_(A) ((A).in[1])
#define C1_(A) ((A).in[2])
#define C2_(A) ((A).in[3])
#define C3_(A) ((A).in[4])
#define WKV0_(A) ((A).in[5])
#define SHIFT0_(A) ((A).in[6])
#define W_IN_(A) ((A).in[7])
#define B_GATE_(A) ((A).in[8])
#define MU_(A) ((A).in[9])
#define W0_(A) ((A).in[10])
#define W_W2_(A) ((A).in[11])
#define A0_(A) ((A).in[12])
#define W_A2_(A) ((A).in[13])
#define K_K_(A) ((A).in[14])
#define K_A_(A) ((A).in[15])
#define R_K_(A) ((A).in[16])
#define LNX_G_(A) ((A).in[17])
#define LNX_B_(A) ((A).in[18])
#define W_OA_(A) ((A).in[19])
#define W_OB_(A) ((A).in[20])
#define W_OUT_(A) ((A).in[21])
#define LN_G_(A) ((A).in[22])
#define LN_B_(A) ((A).in[23])
#define WSB_(A, off) ((bf16*)((A).ws + (off)))
#define WSF_(A, off) ((float*)((A).ws + (off)))

__device__ __forceinline__ void p0_transpose_item(const float* W, int K, int N, bf16* WT, int split_at, int split_add, LAS float* scr, int item, int lane) {
    const int nblk = N / 32, kb = item / nblk, nb = item % nblk, k0 = 64 * kb, n0 = 32 * nb;
    const int radd = n0 >= split_at ? split_add : 0;
#pragma unroll 8
    for (int i = 0; i < 32; ++i) { const int kk = 2 * i + (lane >> 5); scr[kk * 33 + (lane & 31)] = W[(size_t)(k0 + kk) * N + n0 + (lane & 31)]; }
    LDS_WAIT(); asm volatile("" ::: "memory");
    const int c = lane & 7;
#pragma unroll
    for (int j = 0; j < 4; ++j) { const int n = (lane >> 3) + 8 * j; const LAS float* s = scr + (8 * c) * 33 + n;
        v4u o; o.x = pk2(s[0 * 33], s[1 * 33]); o.y = pk2(s[2 * 33], s[3 * 33]); o.z = pk2(s[4 * 33], s[5 * 33]); o.w = pk2(s[6 * 33], s[7 * 33]);
        *(GAS v4u*)(WT + (size_t)(radd + n0 + n) * K + k0 + 8 * c) = o; }
    LDS_WAIT(); asm volatile("" ::: "memory");
}
__device__ __forceinline__ void p0_prologue(Frame& F, const Args& A) {
    LAS float* scr = (LAS float*)(F.lds + RING_OFF + F.wave * 16384);
    const int gw = blockIdx.x * NWAVES + F.wave, NGW = F.G * NWAVES;
    constexpr int I_IN = (DM / 64) * (NIN / 32), I_OA = (RW / 64) * (DM / 32), I_OUT = (DM / 64) * (DM / 32);
    constexpr int NITEMS = I_IN + 2 * I_OA + I_OUT;
    for (int it = gw; it < NITEMS; it += NGW) {
        int r = it;
        if (r < I_IN) { p0_transpose_item(W_IN_(A), DM, NIN, WSB_(A, WS_WIN), SHIFTC, 128, scr, r, F.lane); continue; } r -= I_IN;
        if (r < I_OA) { p0_transpose_item(W_OA_(A), RW, DM, WSB_(A, WS_WOA), 1 << 30, 0, scr, r, F.lane); continue; } r -= I_OA;
        if (r < I_OA) { p0_transpose_item(W_OB_(A), RW, DM, WSB_(A, WS_WOB), 1 << 30, 0, scr, r, F.lane); continue; } r -= I_OA;
        p0_transpose_item(W_OUT_(A), DM, DM, WSB_(A, WS_WOUT), 1 << 30, 0, scr, r, F.lane);
    }
    const size_t gt = (size_t)blockIdx.x * 512 + F.tid, GT = (size_t)F.G * 512;
    for (size_t i = gt; i < (size_t)128 * DM / 8; i += GT) *(GAS v4u*)(WSB_(A, WS_WIN) + (size_t)SHIFTC * DM + i * 8) = (v4u){0u, 0u, 0u, 0u};
    for (size_t i = gt; i < (size_t)M * DM / 8; i += GT) {
        const size_t e = i * 8; const float* src = e < (size_t)MP * DM ? XP_(A) + e : XS_(A) + (e - (size_t)MP * DM);
        const f32x4 a = *(const GAS f32x4*)src, b = *(const GAS f32x4*)(src + 4);
        v4u o; o.x = pk2(a.x, a.y); o.y = pk2(a.z, a.w); o.z = pk2(b.x, b.y); o.w = pk2(b.z, b.w);
        *(GAS v4u*)(WSB_(A, WS_XB) + e) = o;
    }
}

__device__ __forceinline__ void ld8bf(const bf16* p, float (&v)[8]) {
    const v4u w = *(const GAS v4u*)p;
    v[0] = bf2f(w.x & 0xffffu); v[1] = bf2f(w.x >> 16); v[2] = bf2f(w.y & 0xffffu); v[3] = bf2f(w.y >> 16);
    v[4] = bf2f(w.z & 0xffffu); v[5] = bf2f(w.z >> 16); v[6] = bf2f(w.w & 0xffffu); v[7] = bf2f(w.w >> 16);
}
__device__ __forceinline__ void ld8f(const float* p, float (&v)[8]) {
    const f32x4 a = *(const GAS f32x4*)p, b = *(const GAS f32x4*)(p + 4);
    v[0] = a.x; v[1] = a.y; v[2] = a.z; v[3] = a.w; v[4] = b.x; v[5] = b.y; v[6] = b.z; v[7] = b.w;
}
__device__ __forceinline__ void st8f(float* p, const float (&v)[8]) {
    *(GAS f32x4*)p = (f32x4){v[0], v[1], v[2], v[3]}; *(GAS f32x4*)(p + 4) = (f32x4){v[4], v[5], v[6], v[7]};
}
__device__ __forceinline__ void mixed8(Frame& F, const Args& A, int m, int c0, float (&z)[8]) {
    ld8bf(WSB_(A, WS_H) + (size_t)m * NH + c0, z);
    float p[8], mu[8];
    bool first; int sb = 0;
    if (m < MP) first = (m & (SEQ - 1)) == 0; else { first = ((m - MP) & 3) == 0; sb = (m - MP) >> 2; }
    if (!first) ld8bf(WSB_(A, WS_H) + (size_t)(m - 1) * NH + c0, p);
    else if (m < MP) {
#pragma unroll
        for (int j = 0; j < 8; ++j) p[j] = 0.f;
    } else ld8f(SHIFT0_(A) + (size_t)sb * SHIFTC + c0, p);
    ld8f(MU_(A) + c0, mu);
#pragma unroll
    for (int j = 0; j < 8; ++j) z[j] = z[j] + mu[j] * (p[j] - z[j]);
}
__device__ __forceinline__ void rwkv_prep_row(Frame& F, const Args& A, int m) {
    const int lane = F.lane, c0 = lane * 8;
    float r[8], k[8], v[8];
    mixed8(F, A, m, C_R + c0, r); mixed8(F, A, m, C_K + c0, k); mixed8(F, A, m, C_V + c0, v);
    float wa8[8];
#pragma unroll
    for (int j = 0; j < 8; ++j) wa8[j] = 0.f;
    if (lane < 16) mixed8(F, A, m, C_WD + c0, wa8);
    float wdl = 0.f, adl = 0.f;
#pragma unroll
    for (int j = 0; j < 8; ++j) { const float a = __shfl(wa8[j], lane >> 3), b = __shfl(wa8[j], 8 + (lane >> 3)); if ((lane & 7) == j) { wdl = a; adl = b; } }
    wdl = tanhf(wdl);
    float wp[8], ap[8];
#pragma unroll
    for (int j = 0; j < 8; ++j) { wp[j] = 0.f; ap[j] = 0.f; }
    for (int j = 0; j < 64; ++j) {
        const float tw = __shfl(wdl, j), ta = __shfl(adl, j);
        float w2[8], a2[8]; ld8f(W_W2_(A) + (size_t)j * RW + c0, w2); ld8f(W_A2_(A) + (size_t)j * RW + c0, a2);
#pragma unroll
        for (int q = 0; q < 8; ++q) { wp[q] += tw * w2[q]; ap[q] += ta * a2[q]; }
    }
    float w0[8], a0[8], kkc[8], kac[8];
    ld8f(W0_(A) + c0, w0); ld8f(A0_(A) + c0, a0); ld8f(K_K_(A) + c0, kkc); ld8f(K_A_(A) + c0, kac);
    float dec[8], kk[8], ka[8], k2[8]; float ss = 0.f;
#pragma unroll
    for (int j = 0; j < 8; ++j) {
        const float x = -(w0[j] + wp[j]);
        const float sp = fmaxf(x, 0.f) + log1pf(__expf(-fabsf(x)));
        const float w = -sp - 0.5f;
        dec[j] = __expf(-__expf(w));
        const float a = sigmoidf_(a0[j] + ap[j]);
        kk[j] = k[j] * kkc[j]; ss += kk[j] * kk[j];
        k2[j] = k[j] * (1.0f + (a - 1.0f) * kac[j]);
        ka[j] = a;
    }
    ss += __shfl_xor(ss, 1); ss += __shfl_xor(ss, 2); ss += __shfl_xor(ss, 4);
    const float inv = 1.0f / fmaxf(sqrtf(ss), 1e-12f);
#pragma unroll
    for (int j = 0; j < 8; ++j) { kk[j] *= inv; ka[j] *= kk[j]; }
    const size_t o = (size_t)m * RW + c0;
    st8f(WSF_(A, WS_RR) + o, r); st8f(WSF_(A, WS_DEC) + o, dec); st8f(WSF_(A, WS_K2) + o, k2); st8f(WSF_(A, WS_VV) + o, v); st8f(WSF_(A, WS_KK) + o, kk); st8f(WSF_(A, WS_KA) + o, ka);
}

template <bool PROMPT>
__device__ __forceinline__ void attn_item(Frame& F, const Args& A, int m, int h, LAS float* sq, LAS float* sp) {
    const int lane = F.lane;
    int b, t; if (PROMPT) { b = m >> 13; t = m & (SEQ - 1); } else { b = (m - MP) >> 2; t = (m - MP) & 3; }
    float og[3][2], lse[3];
#pragma unroll
    for (int g = 0; g < 3; ++g) {
        const int d = 1 << (2 * g), Wb = 128 << (2 * g);
        const float* cache = g == 0 ? C1_(A) : (g == 1 ? C2_(A) : C3_(A));
        const int hoff = g * 512 + h * 128;
        { const unsigned qq = *(const GAS unsigned*)(WSB_(A, WS_H) + (size_t)m * NH + C_AQ + hoff + 2 * lane); sq[2 * lane] = bf2f(qq & 0xffffu); sq[2 * lane + 1] = bf2f(qq >> 16); }
        LDS_WAIT(); asm volatile("" ::: "memory");
        float s[3];
#pragma unroll
        for (int kx = 0; kx < 3; ++kx) {
            const int j = lane + 64 * kx; float sc = -1e30f;
            if (kx < 2 || lane == 0) {
                const bf16* kr = nullptr; const float* kf = nullptr;
                if (PROMPT) { const int tk = t - j * d; if (tk >= 0) kr = WSB_(A, WS_H) + (size_t)(b * SEQ + tk) * NH + C_AK + hoff; }
                else { const int idx = Wb + t - j * d; if (idx >= Wb) kr = WSB_(A, WS_H) + (size_t)(MP + b * DSEQ + idx - Wb) * NH + C_AK + hoff; else kf = cache + ((size_t)(b * Wb + idx) * 2 + 0) * 512 + h * 128; }
                if (kr) { float a = 0.f;
                    for (int e = 0; e < 128; e += 8) { float kv[8]; ld8bf(kr + e, kv);
#pragma unroll
                        for (int q = 0; q < 8; ++q) a += sq[e + q] * kv[q]; }
                    sc = a * ATT_SCALE; }
                else if (kf) { float a = 0.f;
                    for (int e = 0; e < 128; e += 8) { float kv[8]; ld8f(kf + e, kv);
#pragma unroll
                        for (int q = 0; q < 8; ++q) a += sq[e + q] * kv[q]; }
                    sc = a * ATT_SCALE; }
            }
            s[kx] = sc;
        }
        const float mx = wave_max(fmaxf(fmaxf(s[0], s[1]), s[2]));
        float p[3]; float ls = 0.f;
#pragma unroll
        for (int kx = 0; kx < 3; ++kx) { p[kx] = s[kx] > -1e29f ? __expf(s[kx] - mx) : 0.f; ls += p[kx]; }
        const float l = wave_sum(ls);
        sp[lane] = p[0]; sp[lane + 64] = p[1]; if (lane == 0) sp[128] = p[2];
        LDS_WAIT(); asm volatile("" ::: "memory");
        float a0 = 0.f, a1 = 0.f;
        for (int j = 0; j < 129; ++j) {
            const float pj = sp[j];
            if (PROMPT) { const int tk = t - j * d; if (tk >= 0) { const unsigned vv = *(const GAS unsigned*)(WSB_(A, WS_H) + (size_t)(b * SEQ + tk) * NH + C_AV + hoff + 2 * lane); a0 += pj * bf2f(vv & 0xffffu); a1 += pj * bf2f(vv >> 16); } }
            else { const int idx = Wb + t - j * d;
                if (idx >= Wb) { const unsigned vv = *(const GAS unsigned*)(WSB_(A, WS_H) + (size_t)(MP + b * DSEQ + idx - Wb) * NH + C_AV + hoff + 2 * lane); a0 += pj * bf2f(vv & 0xffffu); a1 += pj * bf2f(vv >> 16); }
                else { const float* vf = cache + ((size_t)(b * Wb + idx) * 2 + 1) * 512 + h * 128 + 2 * lane; a0 += pj * vf[0]; a1 += pj * vf[1]; } }
        }
        const float il = 1.0f / l;
        og[g][0] = a0 * il; og[g][1] = a1 * il; lse[g] = mx + __logf(l);
        LDS_WAIT(); asm volatile("" ::: "memory");
    }
    const float ml = fmaxf(fmaxf(lse[0], lse[1]), lse[2]);
    const float w0 = __expf(lse[0] - ml), w1 = __expf(lse[1] - ml), w2 = __expf(lse[2] - ml), iw = 1.0f / (w0 + w1 + w2);
    const unsigned zz = *(const GAS unsigned*)(WSB_(A, WS_H) + (size_t)m * NH + C_ZA + h * 128 + 2 * lane);
    const float y0 = (w0 * og[0][0] + w1 * og[1][0] + w2 * og[2][0]) * iw * bf2f(zz & 0xffffu);
    const float y1 = (w0 * og[0][1] + w1 * og[1][1] + w2 * og[2][1]) * iw * bf2f(zz >> 16);
    *(GAS unsigned*)(WSB_(A, WS_YA) + (size_t)m * RW + h * 128 + 2 * lane) = pk2(y0, y1);
}

__device__ __forceinline__ void scan_item(Frame& F, const Args& A, int item) {
    const int lane = F.lane;
    int T, row0, h; float* sout; const float* s0 = nullptr;
    if (item < 16) { const int b = item >> 3; h = item & 7; T = SEQ; row0 = b * SEQ; sout = A.out + O_WKVP + ((size_t)(b * 8 + h) * 64 + lane) * 64; }
    else { const int s = item - 16, b = s >> 3; h = s & 7; T = DSEQ; row0 = MP + b * DSEQ; sout = A.out + O_WKVS + ((size_t)(b * 8 + h) * 64 + lane) * 64; s0 = WKV0_(A) + ((size_t)(b * 8 + h) * 64 + lane) * 64; }
    float S[64];
#pragma unroll
    for (int k = 0; k < 64; k += 4) { f32x4 v = s0 ? *(const GAS f32x4*)(s0 + k) : (f32x4){0.f, 0.f, 0.f, 0.f}; S[k] = v.x; S[k + 1] = v.y; S[k + 2] = v.z; S[k + 3] = v.w; }
    for (int t = 0; t < T; ++t) {
        const size_t base = (size_t)(row0 + t) * RW + h * 64;
        const float vi = WSF_(A, WS_VV)[base + lane];
        float sa = 0.f;
#pragma unroll
        for (int k = 0; k < 64; k += 4) { const f32x4 q = *(const GAS f32x4*)(WSF_(A, WS_KK) + base + k); sa -= S[k] * q.x; sa -= S[k + 1] * q.y; sa -= S[k + 2] * q.z; sa -= S[k + 3] * q.w; if ((k & 15) == 12) asm volatile("" ::: "memory"); }
        float o = 0.f;
#pragma unroll
        for (int k = 0; k < 64; k += 4) {
            const f32x4 dc = *(const GAS f32x4*)(WSF_(A, WS_DEC) + base + k), ka = *(const GAS f32x4*)(WSF_(A, WS_KA) + base + k), k2 = *(const GAS f32x4*)(WSF_(A, WS_K2) + base + k), rr = *(const GAS f32x4*)(WSF_(A, WS_RR) + base + k);
            S[k] = S[k] * dc.x + sa * ka.x + vi * k2.x; S[k + 1] = S[k + 1] * dc.y + sa * ka.y + vi * k2.y; S[k + 2] = S[k + 2] * dc.z + sa * ka.z + vi * k2.z; S[k + 3] = S[k + 3] * dc.w + sa * ka.w + vi * k2.w;
            o += S[k] * rr.x; o += S[k + 1] * rr.y; o += S[k + 2] * rr.z; o += S[k + 3] * rr.w;
            if ((k & 7) == 4) asm volatile("" ::: "memory");
        }
        WSF_(A, WS_OO)[base + lane] = o;
    }
#pragma unroll
    for (int k = 0; k < 64; k += 4) *(GAS f32x4*)(sout + k) = (f32x4){S[k], S[k + 1], S[k + 2], S[k + 3]};
}

__device__ __forceinline__ void rwkv_post_row(Frame& F, const Args& A, int m) {
    const int lane = F.lane, c0 = lane * 8; const size_t o = (size_t)m * RW + c0;
    float ov[8], r[8], k2[8], v[8], rk[8], g[8], bb[8], z[8];
    ld8f(WSF_(A, WS_OO) + o, ov); ld8f(WSF_(A, WS_RR) + o, r); ld8f(WSF_(A, WS_K2) + o, k2); ld8f(WSF_(A, WS_VV) + o, v); ld8f(R_K_(A) + c0, rk); ld8f(LNX_G_(A) + c0, g); ld8f(LNX_B_(A) + c0, bb);
    ld8bf(WSB_(A, WS_H) + (size_t)m * NH + C_ZR + c0, z);
    float s = 0.f, bs = 0.f;
#pragma unroll
    for (int j = 0; j < 8; ++j) { s += ov[j]; bs += r[j] * k2[j] * rk[j]; }
    s += __shfl_xor(s, 1); s += __shfl_xor(s, 2); s += __shfl_xor(s, 4);
    bs += __shfl_xor(bs, 1); bs += __shfl_xor(bs, 2); bs += __shfl_xor(bs, 4);
    const float mean = s * (1.0f / 64.0f); float q = 0.f;
#pragma unroll
    for (int j = 0; j < 8; ++j) { const float dlt = ov[j] - mean; q += dlt * dlt; }
    q += __shfl_xor(q, 1); q += __shfl_xor(q, 2); q += __shfl_xor(q, 4);
    const float rstd = 1.0f / sqrtf(q * (1.0f / 64.0f) + GN_EPS);
    float y[8];
#pragma unroll
    for (int j = 0; j < 8; ++j) y[j] = ((ov[j] - mean) * rstd * g[j] + bb[j] + bs * v[j]) * z[j];
    v4u w; w.x = pk2(y[0], y[1]); w.y = pk2(y[2], y[3]); w.z = pk2(y[4], y[5]); w.w = pk2(y[6], y[7]);
    *(GAS v4u*)(WSB_(A, WS_YR) + o) = w;
}

__device__ __forceinline__ void ln_row(Frame& F, const Args& A, int m) {
    const GAS f32x4* xr = (const GAS f32x4*)(WSF_(A, WS_PRE) + (size_t)m * DM) + F.lane;
    f32x4 v[4]; float s = 0.f;
#pragma unroll
    for (int j = 0; j < 4; ++j) { v[j] = xr[64 * j]; s += (v[j].x + v[j].y) + (v[j].z + v[j].w); }
    const float mean = wave_sum(s) * (1.f / DM); float s2 = 0.f;
#pragma unroll
    for (int j = 0; j < 4; ++j) { v[j] = v[j] - mean; s2 += (v[j].x * v[j].x + v[j].y * v[j].y) + (v[j].z * v[j].z + v[j].w * v[j].w); }
    const float rstd = 1.f / sqrtf(wave_sum(s2) * (1.f / DM) + LN_EPS);
    GAS f32x4* o = (GAS f32x4*)(A.out + (size_t)m * DM) + F.lane;
#pragma unroll
    for (int j = 0; j < 4; ++j) { const f32x4 g = *((const GAS f32x4*)LN_G_(A) + F.lane + 64 * j), bta = *((const GAS f32x4*)LN_B_(A) + F.lane + 64 * j); o[64 * j] = v[j] * rstd * g + bta; }
}

__global__ void __launch_bounds__(NWAVES * 64, 2) mega_fwd(Args args) {
    extern __shared__ __attribute__((aligned(16))) unsigned char lds[];
    Frame F;
    F.lds = (LAS unsigned char*)lds;
    F.MISC = (volatile LAS unsigned*)(F.lds + MISC_OFF);
    F.tid = threadIdx.x; F.lane = F.tid & 63; F.wave = __builtin_amdgcn_readfirstlane(F.tid >> 6);
    F.G = gridDim.x;
    F.ctl = (gu32*)(args.ws + WS_CTL);
    for (int u = F.tid; u < (LDS_BYTES - LDSCTL_OFF) / 4; u += NWAVES * 64) ((LAS unsigned*)(F.lds + LDSCTL_OFF))[u] = 0u;
    __syncthreads();
    XcdBarrier bar; bar.bar = (unsigned*)(F.ctl + CW_BAR); bar.x = 0; bar.st = nullptr;
    if (N_LAUNCHES == 1) bar = xcd_barrier_post((unsigned*)(F.ctl + CW_BAR), F.MISC + 8);
#define GRID_BAR() do { if (N_LAUNCHES == 1) xcd_barrier(bar); } while (0)
    const int lo = args.ph_lo, hi = args.ph_hi;
#ifndef PH_MASK
#define PH_MASK 0xFFFF
#endif
#define IN(k) ((((PH_MASK) >> (k)) & 1) && lo <= (k) && (k) < hi)
#define BOTH(k) (IN(k) && IN((k) + 1))
    const int gw = blockIdx.x * NWAVES + F.wave, NGW = F.G * NWAVES;

    if (IN(0)) { p0_prologue(F, args); if (BOTH(0)) GRID_BAR(); }
    if (IN(1)) {
        pg8::Gemm g{WSB_(args, WS_XB), WSB_(args, WS_WIN), M, NH, DM}; pg8::StaticOrder S; S.init(M, NH, F.G, (int)blockIdx.x);
        pg8::EpiH E{WSB_(args, WS_H), B_GATE_(args), args.out};
        pg8::gemm_phase<pg8::EpiH, pg8::StaticOrder, PG8_ALIGN, PG8_SP2>(F.lds + RING_OFF, g, S, E);
        if (BOTH(1)) GRID_BAR();
    }
    if (IN(2)) {
        for (int m = gw; m < M; m += NGW) rwkv_prep_row(F, args, m);
        LAS float* sq = (LAS float*)(F.lds + RING_OFF + F.wave * 2048); LAS float* sp = sq + 128;
        for (int it = gw; it < M * 4; it += NGW) { const int m = it >> 2, h = it & 3; if (m < MP) attn_item<true>(F, args, m, h, sq, sp); else attn_item<false>(F, args, m, h, sq, sp); }
        if (BOTH(2)) GRID_BAR();
    }
    if (IN(3)) {
        const int vw = F.wave * F.G + blockIdx.x;
        for (int it = vw; it < 16 + DBATCH * 8; it += NGW) scan_item(F, args, it);
        if (BOTH(3)) GRID_BAR();
    }
    if (IN(4)) {
        for (int m = gw; m < M; m += NGW) rwkv_post_row(F, args, m);
        if (BOTH(4)) GRID_BAR();
    }
    if (IN(5)) {
        pg8::Gemm g{WSB_(args, WS_YR), WSB_(args, WS_WOA), M, DM, RW}; pg8::StaticOrder S; S.init(M, DM, F.G, (int)blockIdx.x);
        pg8::EpiMixA E{WSB_(args, WS_H), WSF_(args, WS_MIXF)};
        pg8::gemm_phase<pg8::EpiMixA, pg8::StaticOrder, PG8_ALIGN, PG8_SP2>(F.lds + RING_OFF, g, S, E);
        if (BOTH(5)) GRID_BAR();
    }
    if (IN(6)) {
        pg8::Gemm g{WSB_(args, WS_YA), WSB_(args, WS_WOB), M, DM, RW}; pg8::StaticOrder S; S.init(M, DM, F.G, (int)blockIdx.x);
        pg8::EpiMixB E{WSB_(args, WS_H), WSF_(args, WS_MIXF), WSB_(args, WS_MIX)};
        pg8::gemm_phase<pg8::EpiMixB, pg8::StaticOrder, PG8_ALIGN, PG8_SP2>(F.lds + RING_OFF, g, S, E);
        if (BOTH(6)) GRID_BAR();
    }
    if (IN(7)) {
        pg8::Gemm g{WSB_(args, WS_MIX), WSB_(args, WS_WOUT), M, DM, DM}; pg8::StaticOrder S; S.init(M, DM, F.G, (int)blockIdx.x);
        pg8::EpiPre E{XP_(args), XS_(args), WSF_(args, WS_PRE)};
        pg8::gemm_phase<pg8::EpiPre, pg8::StaticOrder, PG8_ALIGN, PG8_SP2>(F.lds + RING_OFF, g, S, E);
        if (BOTH(7)) GRID_BAR();
    }
    if (IN(8)) {
        for (int m = gw; m < M; m += NGW) ln_row(F, args, m);
    }
#undef IN
#undef BOTH
}

extern "C" void kernel_launch(void* const* d_in, const int* in_sizes, int n_in, void* d_out, int out_size, void* d_ws, size_t ws_size, hipStream_t stream) {
    static int grid = 0;
    if (grid == 0) {
        if (n_in != 24 || in_sizes[0] != MP * DM || (size_t)out_size != O_END || ws_size < WS_END) { fprintf(stderr, "kernel_launch: unexpected shapes (n_in %d, in0 %d, out %d, ws %zu); nothing launched\n", n_in, n_in > 0 ? in_sizes[0] : -1, out_size, ws_size); grid = -1; return; }
        int dev = 0, cus = 0, per_cu = 0;
        if (hipGetDevice(&dev) != hipSuccess || hipDeviceGetAttribute(&cus, hipDeviceAttributeMultiprocessorCount, dev) != hipSuccess) { grid = -1; return; }
        if (hipFuncSetAttribute((const void*)mega_fwd, hipFuncAttributeMaxDynamicSharedMemorySize, LDS_BYTES) != hipSuccess) { fprintf(stderr, "kernel_launch: hipFuncSetAttribute failed\n"); grid = -1; return; }
        if (hipOccupancyMaxActiveBlocksPerMultiprocessor(&per_cu, (const void*)mega_fwd, NWAVES * 64, LDS_BYTES) != hipSuccess || per_cu < 1) fprintf(stderr, "kernel_launch: occupancy query reports %d\n", per_cu);
        (void)hipGetLastError();
        grid = cus;
    }
    if (grid < 0) return;
    if (hipMemsetAsync((char*)d_ws + WS_CTL, 0, CTL_ZERO_BYTES, stream) != hipSuccess) return;
    Args a{};
    for (int i = 0; i < 24; ++i) a.in[i] = (const float*)d_in[i];
    a.out = (float*)d_out; a.ws = (unsigned char*)d_ws;
    if (N_LAUNCHES == 1) { a.ph_lo = 0; a.ph_hi = N_PHASES; hipLaunchKernelGGL(mega_fwd, dim3(grid), dim3(NWAVES * 64), LDS_BYTES, stream, a); }
    else for (int li = 0; li < N_PHASES; ++li) { a.ph_lo = li; a.ph_hi = li + 1; hipLaunchKernelGGL(mega_fwd, dim3(grid), dim3(NWAVES * 64), LDS_BYTES, stream, a); }
}
```

```cpp
#include <hip/hip_runtime.h>
#include <cstdio>
#include <cstdint>
namespace pg8 {
#define PG8_LAS __attribute__((address_space(3)))
typedef unsigned short bf16_t;
typedef short bf16x8 __attribute__((ext_vector_type(8)));
typedef float f32x4 __attribute__((ext_vector_type(4)));
typedef unsigned u32x4 __attribute__((ext_vector_type(4)));
constexpr int BM = 256, BK = 64, HALF = 128, HTB = HALF * BK * 2  , STAGE_BYTES = 8 * HTB, NXCD = 8, WGM = 8;

__host__ __device__ __forceinline__ int lds_byte(int r, int c) { const int st = (r >> 4) * 2 + (c >> 5), rr = r & 15, cc = c & 31, ob = rr * 64 + cc * 2; return st * 1024 + (ob ^ (((ob >> 9) & 1) << 5)); }
__host__ __device__ __forceinline__ void stage_rc(int b, int& R, int& C) { const int st = b / 1024, sb = b % 1024, swz = sb ^ (((sb >> 9) & 1) << 5); R = (st >> 1) * 16 + swz / 64; C = (st & 1) * 32 + (swz % 64) / 2; }
__host__ __device__ __forceinline__ int perm32(int rho) { const int n = rho >> 4, i = rho & 15; return 8 * (i >> 2) + 4 * n + (i & 3); }

struct Unit { int pm, pn; };
struct Gemm { const bf16_t* A; const bf16_t* Bt; int M, N, K; };

struct StaticOrder {
    int nM, nN, nwg, G, c;
    __host__ __device__ void init(int M, int N, int G_, int c_) { nM = M / BM; nN = N / BM; nwg = nM * nN; G = G_; c = c_; }
    __host__ __device__ bool next(int i, Unit& u) const {
        const long L = (long)i * G + c; if (L >= nwg) return false;
        int wgid = (int)L; { const int q = nwg / NXCD, r = nwg % NXCD, xcd = wgid % NXCD, off = wgid / NXCD; wgid = (xcd < r ? xcd * (q + 1) : r * (q + 1) + (xcd - r) * q) + off; }
        const int nig = WGM * nN, gid = wgid / nig, fm = gid * WGM, gsz = (nM - fm) < WGM ? (nM - fm) : WGM;
        u.pm = fm + ((wgid % nig) % gsz); u.pn = (wgid % nig) / gsz; return true;
    }
    __device__ __forceinline__ void a_ready(const Unit&) const {}
    __device__ __forceinline__ void done(const Unit&) const {}
};

__device__ __forceinline__ unsigned cvt_pk_bf16(float lo, float hi) { unsigned r; asm volatile("v_cvt_pk_bf16_f32 %0, %1, %2" : "=v"(r) : "v"(lo), "v"(hi)); return r; }
typedef float f32x2 __attribute__((ext_vector_type(2)));
__device__ __forceinline__ f32x2 gelu_pk(f32x2 v) {
    const f32x2 av = __builtin_elementwise_abs(v), d = av * 0.2316418882f + 1.0f;
    f32x2 t; t.x = __builtin_amdgcn_rcpf(d.x); t.y = __builtin_amdgcn_rcpf(d.y);
    f32x2 q = t * 0.5307027145f + (-0.7265760135f); q = q * t + 0.7107068705f; q = q * t + (-0.142248368f); q = q * t + 0.127414796f; q = q * t;
    const f32x2 s = (v * v) * (-0.72134752044f);
    f32x2 e; e.x = __builtin_amdgcn_exp2f(s.x); e.y = __builtin_amdgcn_exp2f(s.y);
    const f32x2 m = v * (q * e), r = v - m;
    f32x2 o; o.x = v.x < 0.f ? m.x : r.x; o.y = v.y < 0.f ? m.y : r.y; return o;
}

template <int ACT  > struct EpiBf16 {
    static constexpr bool PERM = true, AFTER_DRAIN = false; static_assert(ACT == 0 || ACT == 1, "EpiBf16: ACT is 0 (none) or 1 (gelu_pk)");
    bf16_t* O; int ldc; const float* bias; int split_cols; size_t split_stride; float scale0;
    __device__ __forceinline__ void operator()(const f32x4 (&acc)[2][2][4][2], const Unit& u, int wr, int wc, int fr, int fq) const {
        const int row0 = u.pm * BM + wr * 64 + fr; int colt = u.pn * BM; bf16_t* base = O;
        float sc = 1.f; if (split_cols) { const int t = colt / split_cols; base += (size_t)t * split_stride; colt -= t * split_cols; if (t == 0) sc = scale0; }
        const int col0 = colt + wc * 32 + 8 * fq, bcol0 = u.pn * BM + wc * 32 + 8 * fq;
        f32x4 bv[2][2];
#pragma unroll
        for (int bj = 0; bj < 2; ++bj)
#pragma unroll
            for (int n = 0; n < 2; ++n) bv[bj][n] = bias ? *(const f32x4*)(bias + bcol0 + bj * HALF + 4 * n) : (f32x4){0.f, 0.f, 0.f, 0.f};
#pragma unroll
        for (int ai = 0; ai < 2; ++ai)
#pragma unroll
            for (int m = 0; m < 4; ++m) { bf16_t* rowp = base + (size_t)(row0 + ai * HALF + m * 16) * ldc + col0;
#pragma unroll
                for (int bj = 0; bj < 2; ++bj) { f32x4 v0 = acc[ai][bj][m][0] + bv[bj][0], v1 = acc[ai][bj][m][1] + bv[bj][1];
                    if (ACT == 1) { f32x2 a = gelu_pk((f32x2){v0[0], v0[1]}), b = gelu_pk((f32x2){v0[2], v0[3]}), c = gelu_pk((f32x2){v1[0], v1[1]}), d = gelu_pk((f32x2){v1[2], v1[3]});
                        v0 = (f32x4){a.x, a.y, b.x, b.y}; v1 = (f32x4){c.x, c.y, d.x, d.y}; }
                    v0 = v0 * sc; v1 = v1 * sc; u32x4 w; w.x = cvt_pk_bf16(v0[0], v0[1]); w.y = cvt_pk_bf16(v0[2], v0[3]); w.z = cvt_pk_bf16(v1[0], v1[1]); w.w = cvt_pk_bf16(v1[2], v1[3]);
                    *(u32x4*)(rowp + bj * HALF) = w; } }
    }
};

struct PanelStats {
    unsigned* xbuf;
    unsigned* cnt;
    unsigned* tmo;
    int ntn; float eps;
    unsigned code;
    __device__ __forceinline__ bool run(const f32x4 (&v)[2][2][4][2], const Unit& u, int wr, int wc, int fr, int fq, PG8_LAS unsigned char* lds, int wid, int lane) const {
        typedef float f32x2v __attribute__((ext_vector_type(2)));
        PG8_LAS f32x2v* P = (PG8_LAS f32x2v*)lds;
        PG8_LAS f32x2v* S = (PG8_LAS f32x2v*)(lds + 8192);
        PG8_LAS unsigned* flag = (PG8_LAS unsigned*)(lds + 8192 + 2048);
#pragma unroll
        for (int ai = 0; ai < 2; ++ai)
#pragma unroll
            for (int m = 0; m < 4; ++m) {
                float s = 0.f;
#pragma unroll
                for (int bj = 0; bj < 2; ++bj)
#pragma unroll
                    for (int n = 0; n < 2; ++n) { const f32x4 x = v[ai][bj][m][n]; s += (x[0] + x[1]) + (x[2] + x[3]); }
                s += __shfl_xor(s, 16); s += __shfl_xor(s, 32);
                const float mw = s * (1.0f / 64.0f); float q = 0.f;
#pragma unroll
                for (int bj = 0; bj < 2; ++bj)
#pragma unroll
                    for (int n = 0; n < 2; ++n) { const f32x4 d = v[ai][bj][m][n] - mw; q += (d[0] * d[0] + d[1] * d[1]) + (d[2] * d[2] + d[3] * d[3]); }
                q += __shfl_xor(q, 16); q += __shfl_xor(q, 32);
                if (fq == 0) P[(ai * HALF + wr * 64 + m * 16 + fr) * 4 + wc] = (f32x2v){mw, q};
            }
        asm volatile("s_waitcnt lgkmcnt(0)" ::: "memory"); __builtin_amdgcn_s_barrier(); asm volatile("" ::: "memory");
#if defined(BROKEN_EXCHANGE_NO_WAIT)
#warning BROKEN CONTROL BUILD: the row-statistics exchange does not wait; results are wrong by design
        if (blockIdx.x >= 64) { const long long t0_ = clock64(); while (clock64() - t0_ < 60000) __builtin_amdgcn_s_sleep(8); }
#endif
        const int row = wid * 32 + (lane & 31);
        if (lane < 32) {
            const f32x2v a = P[row * 4 + 0], b = P[row * 4 + 1], c = P[row * 4 + 2], d = P[row * 4 + 3];
            const float mt = (a.x + b.x + c.x + d.x) * 0.25f;
            const float da = a.x - mt, db = b.x - mt, dc = c.x - mt, dd = d.x - mt;
            const float m2 = (a.y + b.y) + (c.y + d.y) + 64.0f * ((da * da + db * db) + (dc * dc + dd * dd));
            unsigned long long* slot = (unsigned long long*)xbuf + ((size_t)(u.pm * BM + row) * 4 + u.pn);
            __hip_atomic_store(slot, ((unsigned long long)__float_as_uint(m2) << 32) | __float_as_uint(mt), __ATOMIC_RELAXED, __HIP_MEMORY_SCOPE_AGENT);
        }
        asm volatile("s_waitcnt vmcnt(0)" ::: "memory");
        if (lane == 0) __hip_atomic_fetch_add(cnt + 64 * u.pm, 1u, __ATOMIC_RELAXED, __HIP_MEMORY_SCOPE_AGENT);
        if (wid == 0) {
            bool dead = false; const unsigned long long t0 = __builtin_amdgcn_s_memrealtime(); const unsigned want = 8u * (unsigned)ntn;
            for (;;) {
#if defined(BROKEN_EXCHANGE_NO_WAIT)
                break;
#endif
                if ((unsigned)__builtin_amdgcn_readfirstlane(__hip_atomic_load(cnt + 64 * u.pm, __ATOMIC_RELAXED, __HIP_MEMORY_SCOPE_AGENT)) >= want) break;
                if (__builtin_amdgcn_s_memrealtime() - t0 > 2000000ull) {
                    if (lane == 0) { unsigned expect = 0u; __hip_atomic_compare_exchange_strong(tmo + 1, &expect, code | (unsigned)(u.pm & 0xff), __ATOMIC_RELAXED, __ATOMIC_RELAXED, __HIP_MEMORY_SCOPE_AGENT);
                                     __hip_atomic_store(tmo, 1u, __ATOMIC_RELAXED, __HIP_MEMORY_SCOPE_AGENT); }
                    dead = true; break; }
                __builtin_amdgcn_s_sleep(2);
            }
            __builtin_amdgcn_fence(__ATOMIC_ACQUIRE, "agent");
            if (lane == 0) flag[0] = dead ? 1u : 0u;
        }
        asm volatile("s_waitcnt vmcnt(0) lgkmcnt(0)" ::: "memory"); __builtin_amdgcn_s_barrier(); asm volatile("" ::: "memory");
        const bool bad = flag[0] != 0u;
        if (lane < 32) {
            const unsigned long long* slot = (const unsigned long long*)xbuf + (size_t)(u.pm * BM + row) * 4; float mt[4], m2[4]; float ms = 0.f;
#pragma unroll
            for (int t = 0; t < 4; ++t) { if (t < ntn) { const unsigned long long w = __hip_atomic_load(slot + t, __ATOMIC_RELAXED, __HIP_MEMORY_SCOPE_AGENT); mt[t] = __uint_as_float((unsigned)w); m2[t] = __uint_as_float((unsigned)(w >> 32)); } else { mt[t] = 0.f; m2[t] = 0.f; } ms += mt[t]; }
            const float mean = ms / (float)ntn; float q = 0.f;
#pragma unroll
            for (int t = 0; t < 4; ++t) if (t < ntn) { const float dm = mt[t] - mean; q += m2[t] + 256.0f * dm * dm; }
            S[row] = (f32x2v){mean, 1.0f / sqrtf(q / (256.0f * (float)ntn) + eps)};
        }
        asm volatile("s_waitcnt lgkmcnt(0)" ::: "memory"); __builtin_amdgcn_s_barrier(); asm volatile("" ::: "memory");
        return bad;
    }
};
struct EpiLnRes {
    static constexpr bool PERM = false, AFTER_DRAIN = true;
    const float* base; float* out; int ldc; const float* bias; PanelStats st; unsigned poison;
    __device__ __forceinline__ void fused(f32x4 (&acc)[2][2][4][2], const Unit& u, int wr, int wc, int fr, int fq, PG8_LAS unsigned char* lds, int wid, int lane) const {
        typedef float f32x2v __attribute__((ext_vector_type(2)));
        const PG8_LAS f32x2v* S = (const PG8_LAS f32x2v*)(lds + 8192);
        const int col0 = u.pn * BM + wc * 32 + 4 * fq;
#pragma unroll
        for (int bj = 0; bj < 2; ++bj)
#pragma unroll
            for (int n = 0; n < 2; ++n) { const f32x4 bv = bias ? *(const f32x4*)(bias + col0 + bj * HALF + n * 16) : (f32x4){0.f, 0.f, 0.f, 0.f};
#pragma unroll
                for (int ai = 0; ai < 2; ++ai)
#pragma unroll
                    for (int m = 0; m < 4; ++m) acc[ai][bj][m][n] += bv; }
        f32x4 pre[4][2][2];
#pragma unroll
        for (int m = 0; m < 4; ++m) { const size_t off = (size_t)(u.pm * BM + wr * 64 + m * 16 + fr) * ldc + col0;
#pragma unroll
            for (int bj = 0; bj < 2; ++bj)
#pragma unroll
                for (int n = 0; n < 2; ++n) pre[m][bj][n] = *(const f32x4*)(base + off + bj * HALF + n * 16); }
        const bool bad = st.run(acc, u, wr, wc, fr, fq, lds, wid, lane) || poison != 0u;
        const float qnan = __builtin_nanf("");
#pragma unroll
        for (int ai = 0; ai < 2; ++ai)
#pragma unroll
            for (int m = 0; m < 4; ++m) { const int r = ai * HALF + wr * 64 + m * 16 + fr; const f32x2v sr = S[r]; const size_t off = (size_t)(u.pm * BM + r) * ldc + col0;
#pragma unroll
                for (int bj = 0; bj < 2; ++bj)
#pragma unroll
                    for (int n = 0; n < 2; ++n) { const f32x4 bs = ai == 0 ? pre[m][bj][n] : *(const f32x4*)(base + off + bj * HALF + n * 16); f32x4 o = bs + (acc[ai][bj][m][n] - sr.x) * sr.y;
                        if (bad) o = (f32x4){qnan, qnan, qnan, qnan}; *(f32x4*)(out + off + bj * HALF + n * 16) = o; }
                if (m & 1) asm volatile("" ::: "memory"); }
    }
};
struct EpiLnResLn {
    static constexpr bool PERM = false, AFTER_DRAIN = true;
    const float* base; float* out; bf16_t* xn; int ldc; const float* bias; PanelStats st1, st2; unsigned poison;
    __device__ __forceinline__ void fused(f32x4 (&acc)[2][2][4][2], const Unit& u, int wr, int wc, int fr, int fq, PG8_LAS unsigned char* lds, int wid, int lane) const {
        typedef float f32x2v __attribute__((ext_vector_type(2))); typedef unsigned u32x2v __attribute__((ext_vector_type(2)));
        const PG8_LAS f32x2v* S = (const PG8_LAS f32x2v*)(lds + 8192);
        const int col0 = u.pn * BM + wc * 32 + 4 * fq;
#pragma unroll
        for (int bj = 0; bj < 2; ++bj)
#pragma unroll
            for (int n = 0; n < 2; ++n) { const f32x4 bv = bias ? *(const f32x4*)(bias + col0 + bj * HALF + n * 16) : (f32x4){0.f, 0.f, 0.f, 0.f};
#pragma unroll
                for (int ai = 0; ai < 2; ++ai)
#pragma unroll
                    for (int m = 0; m < 4; ++m) acc[ai][bj][m][n] += bv; }
        bool bad = st1.run(acc, u, wr, wc, fr, fq, lds, wid, lane) || poison != 0u;
        const float qnan = __builtin_nanf("");
#pragma unroll
        for (int ai = 0; ai < 2; ++ai)
#pragma unroll
            for (int m = 0; m < 4; ++m) { const int r = ai * HALF + wr * 64 + m * 16 + fr; const f32x2v sr = S[r]; const size_t off = (size_t)(u.pm * BM + r) * ldc + col0;
#pragma unroll
                for (int bj = 0; bj < 2; ++bj)
#pragma unroll
                    for (int n = 0; n < 2; ++n) { const f32x4 bs = *(const f32x4*)(base + off + bj * HALF + n * 16); acc[ai][bj][m][n] = bs + (acc[ai][bj][m][n] - sr.x) * sr.y; }
                asm volatile("" : "+v"(acc[ai][0][m][0]), "+v"(acc[ai][0][m][1]), "+v"(acc[ai][1][m][0]), "+v"(acc[ai][1][m][1]));
                if (m & 1) asm volatile("" ::: "memory"); }
        const bool bad1 = bad;
        bad = st2.run(acc, u, wr, wc, fr, fq, lds, wid, lane) || bad;
#pragma unroll
        for (int ai = 0; ai < 2; ++ai)
#pragma unroll
            for (int m = 0; m < 4; ++m) { const int r = ai * HALF + wr * 64 + m * 16 + fr; const f32x2v sr = S[r]; const size_t off = (size_t)(u.pm * BM + r) * ldc + col0;
#pragma unroll
                for (int bj = 0; bj < 2; ++bj)
#pragma unroll
                    for (int n = 0; n < 2; ++n) { const f32x4 x1 = acc[ai][bj][m][n]; *(f32x4*)(out + off + bj * HALF + n * 16) = bad1 ? (f32x4){qnan, qnan, qnan, qnan} : x1;
                        const f32x4 o = (x1 - sr.x) * sr.y; u32x2v w; w.x = cvt_pk_bf16(o[0], o[1]); w.y = cvt_pk_bf16(o[2], o[3]);
                        if (bad) { w.x = 0x7fc07fc0u; w.y = 0x7fc07fc0u; } *(u32x2v*)(xn + off + bj * HALF + n * 16) = w; }
                asm volatile("" ::: "memory"); }
    }
};

template <class Epi, class Sched, bool ALIGN_EPI = false, bool SP2 = false>
__device__ __forceinline__ void gemm_phase(PG8_LAS unsigned char* lds, const Gemm g, const Sched& S, const Epi& E) {
    const int tid = threadIdx.x, wid = __builtin_amdgcn_readfirstlane(tid >> 6), lane = tid & 63, wr = wid >> 2, wc = wid & 3, fr = lane & 15, fq = lane >> 4;
    const int K = g.K, nt = K / BK;
    unsigned voffA[2], voffB[2];
#pragma unroll
    for (int i = 0; i < 2; ++i) { int R, C; stage_rc(tid * 16 + i * 8192, R, C); const int Rb = Epi::PERM ? ((R & ~31) + perm32(R & 31)) : R;
        voffA[i] = (unsigned)(R * K + C) * 2u; voffB[i] = (unsigned)(Rb * K + C) * 2u; }
    const size_t kstep = (size_t)(BK * 2);
    const size_t hstep = (size_t)HALF * K * 2;
    const size_t tstep = 2 * hstep;
    const unsigned ldsw = (unsigned)wid * 1024u;
    const int aoff = lds_byte(wr * 64 + fr, fq * 8), boff = lds_byte(wc * 32 + fr, fq * 8);
#define PG8_SA(b, h) (((b) * 2 + (h)) * HTB)
#define PG8_SB(b, h) ((4 + (b) * 2 + (h)) * HTB)
#define PG8_STAGE(bufoff, gbase, voff) do { _Pragma("unroll") for (int _i = 0; _i < 2; ++_i) \
        __builtin_amdgcn_global_load_lds((const unsigned*)((const char*)(gbase) + (voff)[_i]), (PG8_LAS unsigned*)(lds + (bufoff) + ldsw + _i * 8192), 16, 0, 0); } while (0)
#define PG8_LDA(dst, b, h) do { _Pragma("unroll") for (int m = 0; m < 4; ++m) _Pragma("unroll") for (int k = 0; k < 2; ++k) dst[m][k] = *(const PG8_LAS bf16x8*)(lds + PG8_SA(b, h) + aoff + m * 2048 + k * 1024); } while (0)
#define PG8_LDB(dst, b, h) do { _Pragma("unroll") for (int n = 0; n < 2; ++n) _Pragma("unroll") for (int k = 0; k < 2; ++k) dst[n][k] = *(const PG8_LAS bf16x8*)(lds + PG8_SB(b, h) + boff + n * 2048 + k * 1024); } while (0)
#define PG8_MMA(ai, bj, At, Bt) do { __builtin_amdgcn_s_setprio(1); _Pragma("unroll") for (int m = 0; m < 4; ++m) _Pragma("unroll") for (int n = 0; n < 2; ++n) _Pragma("unroll") for (int k = 0; k < 2; ++k) \
        acc[ai][bj][m][n] = __builtin_amdgcn_mfma_f32_16x16x32_bf16(Bt[n][k], At[m][k], acc[ai][bj][m][n], 0, 0, 0); __builtin_amdgcn_s_setprio(0); } while (0)
#define PG8_WAIT_V(n) asm volatile("s_waitcnt vmcnt(" #n ")" ::: "memory")
#define PG8_WAIT_L(n) asm volatile("s_waitcnt lgkmcnt(" #n ")" ::: "memory")
#define PG8_BAR __builtin_amdgcn_s_barrier()
#define PG8_SCHED __builtin_amdgcn_sched_barrier(0)
    Unit cur, nxt; int ui = 0;
    if (!S.next(0, cur)) return;
    f32x4 acc[2][2][4][2];
#pragma unroll
    for (int a = 0; a < 2; ++a)
#pragma unroll
        for (int b = 0; b < 2; ++b)
#pragma unroll
            for (int m = 0; m < 4; ++m)
#pragma unroll
                for (int n = 0; n < 2; ++n) acc[a][b][m][n] = (f32x4){0.f, 0.f, 0.f, 0.f};
    bf16x8 At[4][2], B0[2][2], B1[2][2];
    const char* cA = (const char*)g.A + (size_t)cur.pm * tstep; const char* cB = (const char*)g.Bt + (size_t)cur.pn * tstep;
    S.a_ready(cur);
    if constexpr (SP2) {
        PG8_STAGE(PG8_SB(0, 0), cB, voffB); PG8_STAGE(PG8_SB(0, 1), cB + hstep, voffB); PG8_STAGE(PG8_SA(0, 0), cA, voffA); PG8_STAGE(PG8_SA(0, 1), cA + hstep, voffA);
        if (wr == 1) PG8_BAR;
        PG8_WAIT_V(2); PG8_BAR;
        PG8_STAGE(PG8_SB(1, 0), cB + kstep, voffB); PG8_STAGE(PG8_SA(1, 0), cA + kstep, voffA); PG8_STAGE(PG8_SB(1, 1), cB + hstep + kstep, voffB);
        PG8_WAIT_V(6); PG8_BAR;
    } else {
        PG8_STAGE(PG8_SB(0, 0), cB, voffB); PG8_STAGE(PG8_SA(0, 0), cA, voffA); PG8_STAGE(PG8_SB(0, 1), cB + hstep, voffB); PG8_STAGE(PG8_SA(0, 1), cA + hstep, voffA);
        if (wr == 1) PG8_BAR;
        PG8_WAIT_V(4); PG8_BAR;
        PG8_STAGE(PG8_SB(1, 0), cB + kstep, voffB); PG8_STAGE(PG8_SA(1, 0), cA + kstep, voffA); PG8_STAGE(PG8_SB(1, 1), cB + hstep + kstep, voffB);
        PG8_WAIT_V(6); PG8_BAR;
    }
    for (;;) {
        const bool has_next = S.next(ui + 1, nxt);
        const char* nA = has_next ? (const char*)g.A + (size_t)nxt.pm * tstep : cA; const char* nB = has_next ? (const char*)g.Bt + (size_t)nxt.pn * tstep : cB;
        for (int t = 0; t < nt; t += 2) {
            const bool last = (t == nt - 2);
            const char* a1 = cA + (size_t)(t + 1) * kstep;
            const char* a2 = last ? nA : cA + (size_t)(t + 2) * kstep; const char* b2 = last ? nB : cB + (size_t)(t + 2) * kstep;
            const char* a3 = a2 + kstep; const char* b3 = b2 + kstep;
            if (last && has_next) S.a_ready(nxt);
            if constexpr (SP2) {
            PG8_LDB(B0, 0, 0); PG8_LDB(B1, 0, 1); PG8_SCHED; PG8_LDA(At, 0, 0); PG8_STAGE(PG8_SA(1, 1), a1 + hstep, voffA);
            PG8_WAIT_V(8); PG8_WAIT_L(0); PG8_BAR; PG8_MMA(0, 0, At, B0); PG8_MMA(0, 1, At, B1); PG8_BAR; PG8_SCHED;
            PG8_LDA(At, 0, 1); PG8_STAGE(PG8_SB(0, 0), b2, voffB); PG8_STAGE(PG8_SB(0, 1), b2 + hstep, voffB); PG8_STAGE(PG8_SA(0, 0), a2, voffA);
            PG8_WAIT_V(8); PG8_WAIT_L(0); PG8_BAR; PG8_MMA(1, 0, At, B0); PG8_MMA(1, 1, At, B1); PG8_BAR; PG8_SCHED;
            PG8_LDB(B0, 1, 0); PG8_LDB(B1, 1, 1); PG8_SCHED; PG8_LDA(At, 1, 0); PG8_STAGE(PG8_SA(0, 1), a2 + hstep, voffA);
            PG8_WAIT_V(8); PG8_WAIT_L(0); PG8_BAR; PG8_MMA(0, 0, At, B0); PG8_MMA(0, 1, At, B1); PG8_BAR; PG8_SCHED;
            PG8_LDA(At, 1, 1); PG8_STAGE(PG8_SB(1, 0), b3, voffB); PG8_STAGE(PG8_SB(1, 1), b3 + hstep, voffB); PG8_STAGE(PG8_SA(1, 0), a3, voffA);
            PG8_WAIT_V(8); PG8_WAIT_L(0); PG8_BAR; PG8_MMA(1, 0, At, B0); PG8_MMA(1, 1, At, B1); PG8_BAR; PG8_SCHED;
            } else {
            PG8_LDB(B0, 0, 0); PG8_SCHED; PG8_LDA(At, 0, 0); PG8_STAGE(PG8_SA(1, 1), a1 + hstep, voffA);
            PG8_WAIT_L(8); PG8_BAR; PG8_WAIT_L(0); PG8_MMA(0, 0, At, B0); PG8_BAR; PG8_SCHED;
            PG8_LDB(B1, 0, 1); PG8_STAGE(PG8_SB(0, 0), b2, voffB);
            PG8_BAR; PG8_WAIT_L(0); PG8_MMA(0, 1, At, B1); PG8_BAR;
            PG8_LDA(At, 0, 1); PG8_STAGE(PG8_SA(0, 0), a2, voffA);
            PG8_BAR; PG8_WAIT_L(0); PG8_MMA(1, 0, At, B0); PG8_BAR; PG8_SCHED;
            PG8_STAGE(PG8_SB(0, 1), b2 + hstep, voffB);
            PG8_WAIT_V(6); PG8_BAR; PG8_MMA(1, 1, At, B1); PG8_BAR;
            PG8_LDB(B0, 1, 0); PG8_SCHED; PG8_LDA(At, 1, 0); PG8_STAGE(PG8_SA(0, 1), a2 + hstep, voffA);
            PG8_WAIT_L(8); PG8_BAR; PG8_WAIT_L(0); PG8_MMA(0, 0, At, B0); PG8_BAR; PG8_SCHED;
            PG8_LDB(B1, 1, 1); PG8_STAGE(PG8_SB(1, 0), b3, voffB);
            PG8_BAR; PG8_WAIT_L(0); PG8_MMA(0, 1, At, B1); PG8_BAR;
            PG8_LDA(At, 1, 1); PG8_STAGE(PG8_SA(1, 0), a3, voffA);
            PG8_BAR; PG8_WAIT_L(0); PG8_MMA(1, 0, At, B0); PG8_BAR; PG8_SCHED;
            PG8_STAGE(PG8_SB(1, 1), b3 + hstep, voffB);
            PG8_WAIT_V(6); PG8_BAR; PG8_MMA(1, 1, At, B1); PG8_BAR;
            }
        }
        if constexpr (ALIGN_EPI) { if (wr == 0) PG8_BAR; }
        if constexpr (!Epi::AFTER_DRAIN) { E(acc, cur, wr, wc, fr, fq); S.done(cur); }
        if (!has_next) break;
#pragma unroll
        for (int a = 0; a < 2; ++a)
#pragma unroll
            for (int b = 0; b < 2; ++b)
#pragma unroll
                for (int m = 0; m < 4; ++m)
#pragma unroll
                    for (int n = 0; n < 2; ++n) acc[a][b][m][n] = (f32x4){0.f, 0.f, 0.f, 0.f};
        cur = nxt; cA = nA; cB = nB; ++ui;
        if constexpr (ALIGN_EPI) { if (wr == 1) PG8_BAR; }
    }
    PG8_WAIT_V(0);
    if constexpr (!ALIGN_EPI) { if (wr == 0) PG8_BAR; }
    PG8_BAR;
    if constexpr (Epi::AFTER_DRAIN) { E.fused(acc, cur, wr, wc, fr, fq, lds, wid, lane); S.done(cur); }
#undef PG8_SA
#undef PG8_SB
#undef PG8_STAGE
#undef PG8_LDA
#undef PG8_LDB
#undef PG8_MMA
#undef PG8_WAIT_V
#undef PG8_WAIT_L
#undef PG8_BAR
#undef PG8_SCHED
}
}
#ifndef PG8_SP2
#define PG8_SP2 true
#endif
#ifndef PG8_ALIGN
#define PG8_ALIGN true
#endif
constexpr int NWAVES = 8;
#ifndef MK_N_LAUNCHES
#define MK_N_LAUNCHES 1
#endif
constexpr int N_PHASES = 9;
constexpr int N_LAUNCHES = MK_N_LAUNCHES;

constexpr int DM = 1024, SEQ = 8192, NBATCH = 2, MP = NBATCH * SEQ, DBATCH = 128, DSEQ = 4, MS = DBATCH * DSEQ, M = MP + MS;
constexpr int NIN = 9344, NH = 9472;
constexpr int RW = 512, SHIFTC = 1664;
constexpr int C_R = 0, C_K = 512, C_V = 1024, C_WD = 1536, C_AD = 1600, C_ZR = 1792, C_AQ = 2304, C_AK = 3840, C_AV = 5376, C_ZA = 6912, C_GR = 7424, C_GA = 8448;
constexpr float LN_EPS = 1e-5f, GN_EPS = 64e-5f;
constexpr float ALPHA = 1.189207115002721f;
constexpr float ATT_SCALE = 0.08838834764831845f;
constexpr size_t O_YP = 0, O_YS = O_YP + (size_t)MP * DM, O_KV1P = O_YS + (size_t)MS * DM, O_KV1S = O_KV1P + (size_t)2 * 128 * 1024, O_KV2P = O_KV1S + (size_t)MS * 1024,
                 O_KV2S = O_KV2P + (size_t)2 * 512 * 1024, O_KV3P = O_KV2S + (size_t)MS * 1024, O_KV3S = O_KV3P + (size_t)2 * 2048 * 1024, O_WKVP = O_KV3S + (size_t)MS * 1024,
                 O_WKVS = O_WKVP + (size_t)2 * 8 * 64 * 64, O_SHP = O_WKVS + (size_t)128 * 8 * 64 * 64, O_SHS = O_SHP + (size_t)2 * SHIFTC, O_END = O_SHS + (size_t)128 * SHIFTC;
static_assert(O_END == 28855552, "d_out size");

constexpr size_t MiB = 1u << 20;
constexpr size_t WS_CTL = 0, CTL_ZERO_BYTES = 1 * MiB;
constexpr size_t WS_WIN = 2 * MiB, WS_WOA = 22 * MiB, WS_WOB = 23 * MiB, WS_WOUT = 24 * MiB;
constexpr size_t WS_XB = 32 * MiB, WS_H = 96 * MiB, WS_YR = 416 * MiB, WS_YA = 448 * MiB, WS_MIX = 480 * MiB, WS_MIXF = 528 * MiB, WS_PRE = 608 * MiB;
constexpr size_t WS_RR = 704 * MiB, WS_DEC = 744 * MiB, WS_K2 = 784 * MiB, WS_VV = 824 * MiB, WS_KK = 864 * MiB, WS_KA = 904 * MiB, WS_OO = 944 * MiB;
constexpr size_t WS_W2T = 26 * MiB, WS_A2T = 27 * MiB;
constexpr size_t WS_QE = 984 * MiB, WS_PT = 1000 * MiB, WS_S0B = 1016 * MiB, WS_OL = 1032 * MiB, WS_SL = 1064 * MiB, WS_VMX = 1096 * MiB, WS_BON = 1112 * MiB, WS_END = 1120 * MiB;
static_assert(WS_WIN + (size_t)NH * DM * 2 <= WS_WOA && WS_XB + (size_t)M * DM * 2 <= WS_H && WS_H + (size_t)M * NH * 2 <= WS_YR, "ws map");
constexpr int CW_TMO = 0, CW_CODE = 1, CW_BAR = 4096;

constexpr int RING_OFF = 0, RING_BYTES = 131072;
constexpr int LDSCTL_OFF = RING_BYTES, MISC_OFF = LDSCTL_OFF + 320;
constexpr int LDS_BYTES = 147456;
#define GAS __attribute__((address_space(1)))
#define LAS __attribute__((address_space(3)))
typedef unsigned short bf16;
typedef unsigned v4u __attribute__((ext_vector_type(4)));
typedef float f32x4 __attribute__((ext_vector_type(4)));
typedef short bf16x8 __attribute__((ext_vector_type(8)));
typedef GAS unsigned gu32;
typedef GAS unsigned long long gu64;
#define RLX_AGENT __ATOMIC_RELAXED, __HIP_MEMORY_SCOPE_AGENT
#define LDS_WAIT() asm volatile("s_waitcnt lgkmcnt(0)" ::: "memory")
#define VM_WAIT() asm volatile("s_waitcnt vmcnt(0)" ::: "memory")
__device__ __forceinline__ unsigned long long rt() { return __builtin_amdgcn_s_memrealtime(); }
__device__ __forceinline__ unsigned f2bf(float f) { unsigned u = __builtin_bit_cast(unsigned, f); return (u + 0x7fffu + ((u >> 16) & 1u)) >> 16; }
__device__ __forceinline__ unsigned pk2(float lo, float hi) { return f2bf(lo) | (f2bf(hi) << 16); }

#define XB_TMO      128
#define XB_XCNT(j)  (256  + 64 * (j))
#define XB_XSUB(j)  (1280 + 64 * (j))
#define XB_XGEN(j)  (2304 + 64 * (j))
#define XB_TOP      3328
#define XB_TOPGEN   3392
#define XCD_BAR_WORDS 3456
#define XB_SPIN_CAP (1u << 18)

__device__ __forceinline__ unsigned xb_ld(unsigned* p)              { return __hip_atomic_load(p, __ATOMIC_RELAXED, __HIP_MEMORY_SCOPE_AGENT); }
__device__ __forceinline__ unsigned xb_add(unsigned* p, unsigned v) { return __hip_atomic_fetch_add(p, v, __ATOMIC_RELAXED, __HIP_MEMORY_SCOPE_AGENT); }
__device__ __forceinline__ unsigned xb_xcc_id() { return (unsigned)__builtin_amdgcn_s_getreg((3 << 11) | 20) & 0xFu; }
#define XB_SPIN(cond, bar) do { unsigned _sp = 0; while (cond) { __builtin_amdgcn_s_sleep(1); \
    if ((++_sp & 255u) == 0u) { if (xb_ld(&(bar)[XB_TMO])) break; if (_sp > XB_SPIN_CAP) { atomicAdd(&(bar)[XB_TMO], 1u); break; } } } } while (0)

struct XcdBarrier {
    unsigned* bar; unsigned x;
    volatile LAS unsigned* st;
};

__device__ __forceinline__ XcdBarrier xcd_barrier_post(unsigned* bar, volatile LAS unsigned* st) {
    XcdBarrier b; b.bar = bar; b.x = xb_xcc_id(); b.st = st;
    if (threadIdx.x == 0) (void)xb_add(&bar[XB_XCNT(b.x)], 1u);
    return b;
}
__device__ __forceinline__ void xcd_barrier_complete(unsigned* bar, unsigned x, unsigned& nloc, unsigned& nx) {
    const unsigned G = gridDim.x * gridDim.y * gridDim.z;
    unsigned sum, cnt, mine, sp = 0u;
    for (;;) {
        sum = 0u; cnt = 0u; mine = 0u;
#pragma unroll
        for (unsigned j = 0; j < 16; ++j) { const unsigned c = xb_ld(&bar[XB_XCNT(j)]); sum += c; cnt += (c > 0u) ? 1u : 0u; mine = (j == x) ? c : mine; }
        if (sum == G) break;
        __builtin_amdgcn_s_sleep(1);
        if ((++sp & 255u) == 0u) { if (xb_ld(&bar[XB_TMO])) break; if (sp > XB_SPIN_CAP) { atomicAdd(&bar[XB_TMO], 1u); break; } }
    }
    nloc = mine > 0u ? mine : 1u; nx = cnt > 0u ? cnt : 1u;
}

__device__ __forceinline__ void xcd_barrier(const XcdBarrier& b) {
    asm volatile("s_waitcnt vmcnt(0)" ::: "memory");
    __syncthreads();
    if (threadIdx.x == 0) {
        unsigned* bar = b.bar;
        __builtin_amdgcn_s_waitcnt(0);
        unsigned nloc = b.st[0], nx = b.st[1];
        if (nloc == 0u) { xcd_barrier_complete(bar, b.x, nloc, nx); b.st[0] = nloc; b.st[1] = nx; }
        const unsigned old = xb_add(&bar[XB_XSUB(b.x)], 1u);
        const unsigned gen = old / nloc;
        if (old + 1u == (gen + 1u) * nloc) {
            __builtin_amdgcn_fence(__ATOMIC_RELEASE, "agent");
            asm volatile("s_waitcnt vmcnt(0)" ::: "memory");
            const unsigned og = xb_add(&bar[XB_TOP], 1u);
            const unsigned tg = og / nx;
            if (og + 1u == (tg + 1u) * nx) xb_add(&bar[XB_TOPGEN], 1u);
            else XB_SPIN(xb_ld(&bar[XB_TOPGEN]) == tg, bar);
            __builtin_amdgcn_fence(__ATOMIC_ACQUIRE, "agent");
            xb_add(&bar[XB_XGEN(b.x)], 1u);
            asm volatile("s_waitcnt vmcnt(0)" ::: "memory");
        } else {
            XB_SPIN(xb_ld(&bar[XB_XGEN(b.x)]) == gen, bar);
            __builtin_amdgcn_fence(__ATOMIC_ACQUIRE, "agent");
            asm volatile("s_waitcnt vmcnt(0)" ::: "memory");
        }
    }
    __syncthreads();
}

typedef unsigned u32x2 __attribute__((ext_vector_type(2)));
__device__ __forceinline__ float bf2f(unsigned b) { return __builtin_bit_cast(float, b << 16); }
__device__ __forceinline__ float wave_sum(float v) {
#pragma unroll
    for (int o = 1; o < 64; o <<= 1) v += __shfl_xor(v, o);
    return v;
}
__device__ __forceinline__ float wave_max(float v) {
#pragma unroll
    for (int o = 1; o < 64; o <<= 1) v = fmaxf(v, __shfl_xor(v, o));
    return v;
}
__device__ __forceinline__ float sigmoidf_(float x) { return 1.0f / (1.0f + __expf(-x)); }
__device__ __forceinline__ float siluf_(float x) { return x / (1.0f + __expf(-x)); }

namespace pg8 {
struct EpiH {
    static constexpr bool PERM = true, AFTER_DRAIN = false;
    bf16_t* H; const float* bgate; float* out;
    __device__ __forceinline__ void operator()(const f32x4 (&acc)[2][2][4][2], const Unit& u, int wr, int wc, int fr, int fq) const {
        const int pn = u.pn;
        const int row0 = u.pm * BM + wr * 64 + fr, cw = wc * 32 + 8 * fq;
        const int mode = (pn >= 29) ? 2 : ((pn == 7 || pn == 8 || pn == 27 || pn == 28) ? 1 : 0);
        const bool is_zs = pn <= 6, is_kv = (pn >= 15 && pn <= 26);
        int kvsel = 0, g = 0, hcb = 0;
        if (is_kv) { int q = pn - 15; kvsel = q >= 6 ? 1 : 0; q = q >= 6 ? q - 6 : q; g = q >> 1; hcb = (q & 1) * 256; }
        const int keep = 128 << (2 * g);
        float* kvp = out + (g == 0 ? O_KV1P : (g == 1 ? O_KV2P : O_KV3P));
        float* kvs = out + (g == 0 ? O_KV1S : (g == 1 ? O_KV2S : O_KV3S));
        f32x4 bv[2][2];
#pragma unroll
        for (int bj = 0; bj < 2; ++bj)
#pragma unroll
            for (int n = 0; n < 2; ++n) bv[bj][n] = (mode == 2) ? *(const f32x4*)(bgate + (pn * BM + bj * HALF + cw - C_GR) + 4 * n) : (f32x4){0.f, 0.f, 0.f, 0.f};
#pragma unroll
        for (int ai = 0; ai < 2; ++ai)
#pragma unroll
            for (int m = 0; m < 4; ++m) {
                const int row = row0 + ai * HALF + m * 16;
                bf16_t* rowp = H + (size_t)row * NH + pn * BM + cw;
#pragma unroll
                for (int bj = 0; bj < 2; ++bj) {
                    f32x4 v0 = acc[ai][bj][m][0], v1 = acc[ai][bj][m][1];
                    const int col = pn * BM + bj * HALF + cw;
                    if (is_zs && col < SHIFTC) {
                        float* dst = nullptr;
                        if (row < MP) { if ((row & (SEQ - 1)) == SEQ - 1) dst = out + O_SHP + (size_t)(row >> 13) * SHIFTC + col; }
                        else if (((row - MP) & 3) == 3) dst = out + O_SHS + (size_t)((row - MP) >> 2) * SHIFTC + col;
                        if (dst) { *(f32x4*)dst = v0; *(f32x4*)(dst + 4) = v1; }
                    }
                    if (is_kv) {
                        const int hc = hcb + bj * HALF + cw;
                        float* dst = nullptr;
                        if (row < MP) { const int t = row & (SEQ - 1), b = row >> 13; if (t >= SEQ - keep) dst = kvp + ((size_t)(b * keep + t - (SEQ - keep)) * 2 + kvsel) * 512 + hc; }
                        else dst = kvs + ((size_t)(row - MP) * 2 + kvsel) * 512 + hc;
                        if (dst) { *(f32x4*)dst = v0; *(f32x4*)(dst + 4) = v1; }
                    }
                    if (mode == 1) {
#pragma unroll
                        for (int j = 0; j < 4; ++j) { v0[j] = siluf_(v0[j]); v1[j] = siluf_(v1[j]); }
                    } else if (mode == 2) {
                        v0 = v0 + bv[bj][0]; v1 = v1 + bv[bj][1];
#pragma unroll
                        for (int j = 0; j < 4; ++j) { v0[j] = sigmoidf_(v0[j]); v1[j] = sigmoidf_(v1[j]); }
                    }
                    u32x4 w; w.x = cvt_pk_bf16(v0[0], v0[1]); w.y = cvt_pk_bf16(v0[2], v0[3]); w.z = cvt_pk_bf16(v1[0], v1[1]); w.w = cvt_pk_bf16(v1[2], v1[3]);
                    *(u32x4*)(rowp + bj * HALF) = w;
                }
            }
    }
};
struct EpiMixA {
    static constexpr bool PERM = false, AFTER_DRAIN = false;
    const bf16_t* H; float* MIXF;
    __device__ __forceinline__ void operator()(const f32x4 (&acc)[2][2][4][2], const Unit& u, int wr, int wc, int fr, int fq) const {
        const int row0 = u.pm * BM + wr * 64 + fr, col0 = u.pn * BM + wc * 32 + 4 * fq;
#pragma unroll
        for (int ai = 0; ai < 2; ++ai)
#pragma unroll
            for (int m = 0; m < 4; ++m) { const int row = row0 + ai * HALF + m * 16;
#pragma unroll
                for (int bj = 0; bj < 2; ++bj)
#pragma unroll
                    for (int n = 0; n < 2; ++n) { const int c = col0 + bj * HALF + n * 16;
                        const u32x2 gb = *(const u32x2*)(H + (size_t)row * NH + C_GR + c);
                        f32x4 gt = {bf2f(gb.x & 0xffffu), bf2f(gb.x >> 16), bf2f(gb.y & 0xffffu), bf2f(gb.y >> 16)};
                        *(f32x4*)(MIXF + (size_t)row * DM + c) = gt * acc[ai][bj][m][n]; } }
    }
};
struct EpiMixB {
    static constexpr bool PERM = false, AFTER_DRAIN = false;
    const bf16_t* H; const float* MIXF; bf16_t* MIX;
    __device__ __forceinline__ void operator()(const f32x4 (&acc)[2][2][4][2], const Unit& u, int wr, int wc, int fr, int fq) const {
        const int row0 = u.pm * BM + wr * 64 + fr, col0 = u.pn * BM + wc * 32 + 4 * fq;
#pragma unroll
        for (int ai = 0; ai < 2; ++ai)
#pragma unroll
            for (int m = 0; m < 4; ++m) { const int row = row0 + ai * HALF + m * 16;
#pragma unroll
                for (int bj = 0; bj < 2; ++bj)
#pragma unroll
                    for (int n = 0; n < 2; ++n) { const int c = col0 + bj * HALF + n * 16;
                        const u32x2 gb = *(const u32x2*)(H + (size_t)row * NH + C_GA + c);
                        f32x4 gt = {bf2f(gb.x & 0xffffu), bf2f(gb.x >> 16), bf2f(gb.y & 0xffffu), bf2f(gb.y >> 16)};
                        const f32x4 v = *(const f32x4*)(MIXF + (size_t)row * DM + c) + gt * acc[ai][bj][m][n];
                        u32x2 w; w.x = cvt_pk_bf16(v[0], v[1]); w.y = cvt_pk_bf16(v[2], v[3]);
                        *(u32x2*)(MIX + (size_t)row * DM + c) = w; } }
    }
};
struct EpiPre {
    static constexpr bool PERM = false, AFTER_DRAIN = false;
    const float* xp; const float* xs; float* PRE;
    __device__ __forceinline__ void operator()(const f32x4 (&acc)[2][2][4][2], const Unit& u, int wr, int wc, int fr, int fq) const {
        const int row0 = u.pm * BM + wr * 64 + fr, col0 = u.pn * BM + wc * 32 + 4 * fq;
#pragma unroll
        for (int ai = 0; ai < 2; ++ai)
#pragma unroll
            for (int m = 0; m < 4; ++m) { const int row = row0 + ai * HALF + m * 16;
                const float* xr = row < MP ? xp + (size_t)row * DM : xs + (size_t)(row - MP) * DM;
#pragma unroll
                for (int bj = 0; bj < 2; ++bj)
#pragma unroll
                    for (int n = 0; n < 2; ++n) { const int c = col0 + bj * HALF + n * 16;
                        *(f32x4*)(PRE + (size_t)row * DM + c) = *(const f32x4*)(xr + c) * ALPHA + acc[ai][bj][m][n]; } }
    }
};
}

struct Args { const float* in[24]; float* out; unsigned char* ws; int ph_lo, ph_hi; };
struct Frame {
    LAS unsigned char* lds;
    volatile LAS unsigned* MISC;
    gu32* ctl;
    int tid, lane, wave, G;
};
#define XP_(A) ((A).in[0])
#define XS_(A) ((A).in[1])
#define C1_(A) ((A).in[2])
#define C2_(A) ((A).in[3])
#define C3_(A) ((A).in[4])
#define WKV0_(A) ((A).in[5])
#define SHIFT0_(A) ((A).in[6])
#define W_IN_(A) ((A).in[7])
#define B_GATE_(A) ((A).in[8])
#define MU_(A) ((A).in[9])
#define W0_(A) ((A).in[10])
#define W_W2_(A) ((A).in[11])
#define A0_(A) ((A).in[12])
#define W_A2_(A) ((A).in[13])
#define K_K_(A) ((A).in[14])
#define K_A_(A) ((A).in[15])
#define R_K_(A) ((A).in[16])
#define LNX_G_(A) ((A).in[17])
#define LNX_B_(A) ((A).in[18])
#define W_OA_(A) ((A).in[19])
#define W_OB_(A) ((A).in[20])
#define W_OUT_(A) ((A).in[21])
#define LN_G_(A) ((A).in[22])
#define LN_B_(A) ((A).in[23])
#define WSB_(A, off) ((bf16*)((A).ws + (off)))
#define WSF_(A, off) ((float*)((A).ws + (off)))

__device__ __forceinline__ void p0_transpose_item(const float* W, int K, int N, bf16* WT, int split_at, int split_add, LAS float* scr, int item, int lane) {
    const int nblk = N / 32, kb = item / nblk, nb = item % nblk, k0 = 64 * kb, n0 = 32 * nb;
    const int radd = n0 >= split_at ? split_add : 0;
#pragma unroll 8
    for (int i = 0; i < 32; ++i) { const int kk = 2 * i + (lane >> 5); scr[kk * 33 + (lane & 31)] = W[(size_t)(k0 + kk) * N + n0 + (lane & 31)]; }
    LDS_WAIT(); asm volatile("" ::: "memory");
    const int c = lane & 7;
#pragma unroll
    for (int j = 0; j < 4; ++j) { const int n = (lane >> 3) + 8 * j; const LAS float* s = scr + (8 * c) * 33 + n;
        v4u o; o.x = pk2(s[0 * 33], s[1 * 33]); o.y = pk2(s[2 * 33], s[3 * 33]); o.z = pk2(s[4 * 33], s[5 * 33]); o.w = pk2(s[6 * 33], s[7 * 33]);
        *(GAS v4u*)(WT + (size_t)(radd + n0 + n) * K + k0 + 8 * c) = o; }
    LDS_WAIT(); asm volatile("" ::: "memory");
}
__device__ __forceinline__ void p0_prologue(Frame& F, const Args& A) {
    LAS float* scr = (LAS float*)(F.lds + RING_OFF + F.wave * 16384);
    const int gw = blockIdx.x * NWAVES + F.wave, NGW = F.G * NWAVES;
    constexpr int I_IN = (DM / 64) * (NIN / 32), I_OA = (RW / 64) * (DM / 32), I_OUT = (DM / 64) * (DM / 32);
    constexpr int I_LR = (RW / 32);
    constexpr int NITEMS = I_IN + 2 * I_OA + I_OUT + 2 * I_LR;
    for (int it = gw; it < NITEMS; it += NGW) {
        int r = it;
        if (r < I_IN) { p0_transpose_item(W_IN_(A), DM, NIN, WSB_(A, WS_WIN), SHIFTC, 128, scr, r, F.lane); continue; } r -= I_IN;
        if (r < I_OA) { p0_transpose_item(W_OA_(A), RW, DM, WSB_(A, WS_WOA), 1 << 30, 0, scr, r, F.lane); continue; } r -= I_OA;
        if (r < I_OA) { p0_transpose_item(W_OB_(A), RW, DM, WSB_(A, WS_WOB), 1 << 30, 0, scr, r, F.lane); continue; } r -= I_OA;
        if (r < I_OUT) { p0_transpose_item(W_OUT_(A), DM, DM, WSB_(A, WS_WOUT), 1 << 30, 0, scr, r, F.lane); continue; } r -= I_OUT;
        if (r < I_LR) { p0_transpose_item(W_W2_(A), 64, RW, WSB_(A, WS_W2T), 1 << 30, 0, scr, r, F.lane); continue; } r -= I_LR;
        p0_transpose_item(W_A2_(A), 64, RW, WSB_(A, WS_A2T), 1 << 30, 0, scr, r, F.lane);
    }
    const size_t gt = (size_t)blockIdx.x * 512 + F.tid, GT = (size_t)F.G * 512;
    for (size_t i = gt; i < (size_t)128 * DM / 8; i += GT) *(GAS v4u*)(WSB_(A, WS_WIN) + (size_t)SHIFTC * DM + i * 8) = (v4u){0u, 0u, 0u, 0u};
    for (size_t i = gt; i < (size_t)M * DM / 8; i += GT) {
        const size_t e = i * 8; const float* src = e < (size_t)MP * DM ? XP_(A) + e : XS_(A) + (e - (size_t)MP * DM);
        const f32x4 a = *(const GAS f32x4*)src, b = *(const GAS f32x4*)(src + 4);
        v4u o; o.x = pk2(a.x, a.y); o.y = pk2(a.z, a.w); o.z = pk2(b.x, b.y); o.w = pk2(b.z, b.w);
        *(GAS v4u*)(WSB_(A, WS_XB) + e) = o;
    }
}

__device__ __forceinline__ void ld8bf(const bf16* p, float (&v)[8]) {
    const v4u w = *(const GAS v4u*)p;
    v[0] = bf2f(w.x & 0xffffu); v[1] = bf2f(w.x >> 16); v[2] = bf2f(w.y & 0xffffu); v[3] = bf2f(w.y >> 16);
    v[4] = bf2f(w.z & 0xffffu); v[5] = bf2f(w.z >> 16); v[6] = bf2f(w.w & 0xffffu); v[7] = bf2f(w.w >> 16);
}
__device__ __forceinline__ void ld8f(const float* p, float (&v)[8]) {
    const f32x4 a = *(const GAS f32x4*)p, b = *(const GAS f32x4*)(p + 4);
    v[0] = a.x; v[1] = a.y; v[2] = a.z; v[3] = a.w; v[4] = b.x; v[5] = b.y; v[6] = b.z; v[7] = b.w;
}
__device__ __forceinline__ void st8f(float* p, const float (&v)[8]) {
    *(GAS f32x4*)p = (f32x4){v[0], v[1], v[2], v[3]}; *(GAS f32x4*)(p + 4) = (f32x4){v[4], v[5], v[6], v[7]};
}
__device__ __forceinline__ void mixed8(Frame& F, const Args& A, int m, int c0, float (&z)[8]) {
    ld8bf(WSB_(A, WS_H) + (size_t)m * NH + c0, z);
    float p[8], mu[8];
    bool first; int sb = 0;
    if (m < MP) first = (m & (SEQ - 1)) == 0; else { first = ((m - MP) & 3) == 0; sb = (m - MP) >> 2; }
    if (!first) ld8bf(WSB_(A, WS_H) + (size_t)(m - 1) * NH + c0, p);
    else if (m < MP) {
#pragma unroll
        for (int j = 0; j < 8; ++j) p[j] = 0.f;
    } else ld8f(SHIFT0_(A) + (size_t)sb * SHIFTC + c0, p);
    ld8f(MU_(A) + c0, mu);
#pragma unroll
    for (int j = 0; j < 8; ++j) z[j] = z[j] + mu[j] * (p[j] - z[j]);
}
__device__ __forceinline__ void rwkv_prep_row(Frame& F, const Args& A, int m) {
    const int lane = F.lane, c0 = lane * 8;
    float r[8], k[8], v[8];
    mixed8(F, A, m, C_R + c0, r); mixed8(F, A, m, C_K + c0, k); mixed8(F, A, m, C_V + c0, v);
    float wa8[8];
#pragma unroll
    for (int j = 0; j < 8; ++j) wa8[j] = 0.f;
    if (lane < 16) mixed8(F, A, m, C_WD + c0, wa8);
    float wdl = 0.f, adl = 0.f;
#pragma unroll
    for (int j = 0; j < 8; ++j) { const float a = __shfl(wa8[j], lane >> 3), b = __shfl(wa8[j], 8 + (lane >> 3)); if ((lane & 7) == j) { wdl = a; adl = b; } }
    wdl = tanhf(wdl);
    float wp[8], ap[8];
#pragma unroll
    for (int j = 0; j < 8; ++j) { wp[j] = 0.f; ap[j] = 0.f; }
    for (int j = 0; j < 64; ++j) {
        const float tw = __shfl(wdl, j), ta = __shfl(adl, j);
        float w2[8], a2[8]; ld8f(W_W2_(A) + (size_t)j * RW + c0, w2); ld8f(W_A2_(A) + (size_t)j * RW + c0, a2);
#pragma unroll
        for (int q = 0; q < 8; ++q) { wp[q] += tw * w2[q]; ap[q] += ta * a2[q]; }
    }
    float w0[8], a0[8], kkc[8], kac[8];
    ld8f(W0_(A) + c0, w0); ld8f(A0_(A) + c0, a0); ld8f(K_K_(A) + c0, kkc); ld8f(K_A_(A) + c0, kac);
    float dec[8], kk[8], ka[8], k2[8]; float ss = 0.f;
#pragma unroll
    for (int j = 0; j < 8; ++j) {
        const float x = -(w0[j] + wp[j]);
        const float sp = fmaxf(x, 0.f) + log1pf(__expf(-fabsf(x)));
        const float w = -sp - 0.5f;
        dec[j] = __expf(-__expf(w));
        const float a = sigmoidf_(a0[j] + ap[j]);
        kk[j] = k[j] * kkc[j]; ss += kk[j] * kk[j];
        k2[j] = k[j] * (1.0f + (a - 1.0f) * kac[j]);
        ka[j] = a;
    }
    ss += __shfl_xor(ss, 1); ss += __shfl_xor(ss, 2); ss += __shfl_xor(ss, 4);
    const float inv = 1.0f / fmaxf(sqrtf(ss), 1e-12f);
#pragma unroll
    for (int j = 0; j < 8; ++j) { kk[j] *= inv; ka[j] *= kk[j]; }
    const size_t o = (size_t)m * RW + c0;
    st8f(WSF_(A, WS_RR) + o, r); st8f(WSF_(A, WS_DEC) + o, dec); st8f(WSF_(A, WS_K2) + o, k2); st8f(WSF_(A, WS_VV) + o, v); st8f(WSF_(A, WS_KK) + o, kk); st8f(WSF_(A, WS_KA) + o, ka);
}

template <bool PROMPT>
__device__ __forceinline__ void attn_item(Frame& F, const Args& A, int m, int h, LAS float* sq, LAS float* sp) {
    const int lane = F.lane;
    int b, t; if (PROMPT) { b = m >> 13; t = m & (SEQ - 1); } else { b = (m - MP) >> 2; t = (m - MP) & 3; }
    float og[3][2], lse[3];
#pragma unroll
    for (int g = 0; g < 3; ++g) {
        const int d = 1 << (2 * g), Wb = 128 << (2 * g);
        const float* cache = g == 0 ? C1_(A) : (g == 1 ? C2_(A) : C3_(A));
        const int hoff = g * 512 + h * 128;
        { const unsigned qq = *(const GAS unsigned*)(WSB_(A, WS_H) + (size_t)m * NH + C_AQ + hoff + 2 * lane); sq[2 * lane] = bf2f(qq & 0xffffu); sq[2 * lane + 1] = bf2f(qq >> 16); }
        LDS_WAIT(); asm volatile("" ::: "memory");
        float s[3];
#pragma unroll
        for (int kx = 0; kx < 3; ++kx) {
            const int j = lane + 64 * kx; float sc = -1e30f;
            if (kx < 2 || lane == 0) {
                const bf16* kr = nullptr; const float* kf = nullptr;
                if (PROMPT) { const int tk = t - j * d; if (tk >= 0) kr = WSB_(A, WS_H) + (size_t)(b * SEQ + tk) * NH + C_AK + hoff; }
                else { const int idx = Wb + t - j * d; if (idx >= Wb) kr = WSB_(A, WS_H) + (size_t)(MP + b * DSEQ + idx - Wb) * NH + C_AK + hoff; else kf = cache + ((size_t)(b * Wb + idx) * 2 + 0) * 512 + h * 128; }
                if (kr) { float a = 0.f;
                    for (int e = 0; e < 128; e += 8) { float kv[8]; ld8bf(kr + e, kv);
#pragma unroll
                        for (int q = 0; q < 8; ++q) a += sq[e + q] * kv[q]; }
                    sc = a * ATT_SCALE; }
                else if (kf) { float a = 0.f;
                    for (int e = 0; e < 128; e += 8) { float kv[8]; ld8f(kf + e, kv);
#pragma unroll
                        for (int q = 0; q < 8; ++q) a += sq[e + q] * kv[q]; }
                    sc = a * ATT_SCALE; }
            }
            s[kx] = sc;
        }
        const float mx = wave_max(fmaxf(fmaxf(s[0], s[1]), s[2]));
        float p[3]; float ls = 0.f;
#pragma unroll
        for (int kx = 0; kx < 3; ++kx) { p[kx] = s[kx] > -1e29f ? __expf(s[kx] - mx) : 0.f; ls += p[kx]; }
        const float l = wave_sum(ls);
        sp[lane] = p[0]; sp[lane + 64] = p[1]; if (lane == 0) sp[128] = p[2];
        LDS_WAIT(); asm volatile("" ::: "memory");
        float a0 = 0.f, a1 = 0.f;
        for (int j = 0; j < 129; ++j) {
            const float pj = sp[j];
            if (PROMPT) { const int tk = t - j * d; if (tk >= 0) { const unsigned vv = *(const GAS unsigned*)(WSB_(A, WS_H) + (size_t)(b * SEQ + tk) * NH + C_AV + hoff + 2 * lane); a0 += pj * bf2f(vv & 0xffffu); a1 += pj * bf2f(vv >> 16); } }
            else { const int idx = Wb + t - j * d;
                if (idx >= Wb) { const unsigned vv = *(const GAS unsigned*)(WSB_(A, WS_H) + (size_t)(MP + b * DSEQ + idx - Wb) * NH + C_AV + hoff + 2 * lane); a0 += pj * bf2f(vv & 0xffffu); a1 += pj * bf2f(vv >> 16); }
                else { const float* vf = cache + ((size_t)(b * Wb + idx) * 2 + 1) * 512 + h * 128 + 2 * lane; a0 += pj * vf[0]; a1 += pj * vf[1]; } }
        }
        const float il = 1.0f / l;
        og[g][0] = a0 * il; og[g][1] = a1 * il; lse[g] = mx + __logf(l);
        LDS_WAIT(); asm volatile("" ::: "memory");
    }
    const float ml = fmaxf(fmaxf(lse[0], lse[1]), lse[2]);
    const float w0 = __expf(lse[0] - ml), w1 = __expf(lse[1] - ml), w2 = __expf(lse[2] - ml), iw = 1.0f / (w0 + w1 + w2);
    const unsigned zz = *(const GAS unsigned*)(WSB_(A, WS_H) + (size_t)m * NH + C_ZA + h * 128 + 2 * lane);
    const float y0 = (w0 * og[0][0] + w1 * og[1][0] + w2 * og[2][0]) * iw * bf2f(zz & 0xffffu);
    const float y1 = (w0 * og[0][1] + w1 * og[1][1] + w2 * og[2][1]) * iw * bf2f(zz >> 16);
    *(GAS unsigned*)(WSB_(A, WS_YA) + (size_t)m * RW + h * 128 + 2 * lane) = pk2(y0, y1);
}

__device__ __forceinline__ void scan_item(Frame& F, const Args& A, int item) {
    const int lane = F.lane;
    int T, row0, h; float* sout; const float* s0 = nullptr;
    if (item < 16) { const int b = item >> 3; h = item & 7; T = SEQ; row0 = b * SEQ; sout = A.out + O_WKVP + ((size_t)(b * 8 + h) * 64 + lane) * 64; }
    else { const int s = item - 16, b = s >> 3; h = s & 7; T = DSEQ; row0 = MP + b * DSEQ; sout = A.out + O_WKVS + ((size_t)(b * 8 + h) * 64 + lane) * 64; s0 = WKV0_(A) + ((size_t)(b * 8 + h) * 64 + lane) * 64; }
    float S[64];
#pragma unroll
    for (int k = 0; k < 64; k += 4) { f32x4 v = s0 ? *(const GAS f32x4*)(s0 + k) : (f32x4){0.f, 0.f, 0.f, 0.f}; S[k] = v.x; S[k + 1] = v.y; S[k + 2] = v.z; S[k + 3] = v.w; }
    for (int t = 0; t < T; ++t) {
        const size_t base = (size_t)(row0 + t) * RW + h * 64;
        const float vi = WSF_(A, WS_VV)[base + lane];
        float sa = 0.f;
#pragma unroll
        for (int k = 0; k < 64; k += 4) { const f32x4 q = *(const GAS f32x4*)(WSF_(A, WS_KK) + base + k); sa -= S[k] * q.x; sa -= S[k + 1] * q.y; sa -= S[k + 2] * q.z; sa -= S[k + 3] * q.w; if ((k & 15) == 12) asm volatile("" ::: "memory"); }
        float o = 0.f;
#pragma unroll
        for (int k = 0; k < 64; k += 4) {
            const f32x4 dc = *(const GAS f32x4*)(WSF_(A, WS_DEC) + base + k), ka = *(const GAS f32x4*)(WSF_(A, WS_KA) + base + k), k2 = *(const GAS f32x4*)(WSF_(A, WS_K2) + base + k), rr = *(const GAS f32x4*)(WSF_(A, WS_RR) + base + k);
            S[k] = S[k] * dc.x + sa * ka.x + vi * k2.x; S[k + 1] = S[k + 1] * dc.y + sa * ka.y + vi * k2.y; S[k + 2] = S[k + 2] * dc.z + sa * ka.z + vi * k2.z; S[k + 3] = S[k + 3] * dc.w + sa * ka.w + vi * k2.w;
            o += S[k] * rr.x; o += S[k + 1] * rr.y; o += S[k + 2] * rr.z; o += S[k + 3] * rr.w;
            if ((k & 7) == 4) asm volatile("" ::: "memory");
        }
        WSF_(A, WS_OO)[base + lane] = o;
    }
#pragma unroll
    for (int k = 0; k < 64; k += 4) *(GAS f32x4*)(sout + k) = (f32x4){S[k], S[k + 1], S[k + 2], S[k + 3]};
}

__device__ __forceinline__ void rwkv_post_row(Frame& F, const Args& A, int m) {
    const int lane = F.lane, c0 = lane * 8; const size_t o = (size_t)m * RW + c0;
    float ov[8], r[8], k2[8], v[8], rk[8], g[8], bb[8], z[8];
    ld8f(WSF_(A, WS_OO) + o, ov); ld8f(WSF_(A, WS_RR) + o, r); ld8f(WSF_(A, WS_K2) + o, k2); ld8f(WSF_(A, WS_VV) + o, v); ld8f(R_K_(A) + c0, rk); ld8f(LNX_G_(A) + c0, g); ld8f(LNX_B_(A) + c0, bb);
    ld8bf(WSB_(A, WS_H) + (size_t)m * NH + C_ZR + c0, z);
    float s = 0.f, bs = 0.f;
#pragma unroll
    for (int j = 0; j < 8; ++j) { s += ov[j]; bs += r[j] * k2[j] * rk[j]; }
    s += __shfl_xor(s, 1); s += __shfl_xor(s, 2); s += __shfl_xor(s, 4);
    bs += __shfl_xor(bs, 1); bs += __shfl_xor(bs, 2); bs += __shfl_xor(bs, 4);
    const float mean = s * (1.0f / 64.0f); float q = 0.f;
#pragma unroll
    for (int j = 0; j < 8; ++j) { const float dlt = ov[j] - mean; q += dlt * dlt; }
    q += __shfl_xor(q, 1); q += __shfl_xor(q, 2); q += __shfl_xor(q, 4);
    const float rstd = 1.0f / sqrtf(q * (1.0f / 64.0f) + GN_EPS);
    float y[8];
#pragma unroll
    for (int j = 0; j < 8; ++j) y[j] = ((ov[j] - mean) * rstd * g[j] + bb[j] + bs * v[j]) * z[j];
    v4u w; w.x = pk2(y[0], y[1]); w.y = pk2(y[2], y[3]); w.z = pk2(y[4], y[5]); w.w = pk2(y[6], y[7]);
    *(GAS v4u*)(WSB_(A, WS_YR) + o) = w;
}

typedef short s16x4 __attribute__((ext_vector_type(4)));
typedef short v4i16_t __attribute__((ext_vector_type(4)));
constexpr int LDP = 72;
constexpr int ARRB = 64 * LDP * 2;
enum { A_AT = 0, A_BH, A_KH, A_RT, A_VQ, A_XA, A_XB, A_TA, A_TB, A_MAK, A_MRB, A_MRK, A_NARR };
constexpr int A_SMALL = A_NARR * ARRB;
static_assert(A_SMALL + 4096 <= RING_BYTES, "phase A LDS");
constexpr int NUNITS = 16 * 128;

__device__ __forceinline__ f32x4 mfma16(bf16x8 a, bf16x8 b, f32x4 c) { return __builtin_amdgcn_mfma_f32_16x16x32_bf16(a, b, c, 0, 0, 0); }
__device__ __forceinline__ bf16x8 frag_rows(const LAS bf16* X, int row0, int k0, int lane) { return *(const LAS bf16x8*)(X + (row0 + (lane & 15)) * LDP + k0 + 8 * (lane >> 4)); }
__device__ __forceinline__ bf16x8 frag_tr(const LAS bf16* X, int k0, int col0, int lane) {
    const int g = lane >> 4, i = lane & 15;
    const LAS bf16* a0 = X + (k0 + 8 * g + (i >> 2)) * LDP + col0 + 4 * (i & 3);
    const s16x4 lo = __builtin_bit_cast(s16x4, __builtin_amdgcn_ds_read_tr16_b64_v4i16((LAS v4i16_t*)a0));
    const s16x4 hi = __builtin_bit_cast(s16x4, __builtin_amdgcn_ds_read_tr16_b64_v4i16((LAS v4i16_t*)(a0 + 4 * LDP)));
    return __builtin_shufflevector(lo, hi, 0, 1, 2, 3, 4, 5, 6, 7);
}
__device__ __forceinline__ u32x2 pk4(f32x4 v) { u32x2 w; w.x = pk2(v[0], v[1]); w.y = pk2(v[2], v[3]); return w; }
__device__ __forceinline__ f32x4 up4(u32x2 w) { return (f32x4){bf2f(w.x & 0xffffu), bf2f(w.x >> 16), bf2f(w.y & 0xffffu), bf2f(w.y >> 16)}; }
__device__ __forceinline__ void st4(LAS bf16* X, int row, int col, f32x4 v) { *(LAS u32x2*)(X + row * LDP + col) = pk4(v); }
__device__ __forceinline__ f32x4 ld4(const LAS bf16* X, int row, int col) { return up4(*(const LAS u32x2*)(X + row * LDP + col)); }
__device__ __forceinline__ float dpp_shr(float x, int n) {
    const int iv = __builtin_bit_cast(int, x); int r;
    switch (n) { case 1: r = __builtin_amdgcn_update_dpp(0, iv, 0x111, 0xf, 0xf, true); break; case 2: r = __builtin_amdgcn_update_dpp(0, iv, 0x112, 0xf, 0xf, true); break;
                 case 4: r = __builtin_amdgcn_update_dpp(0, iv, 0x114, 0xf, 0xf, true); break; default: r = __builtin_amdgcn_update_dpp(0, iv, 0x118, 0xf, 0xf, true); break; }
    return __builtin_bit_cast(float, r);
}
__device__ __forceinline__ float row_scan(float x) { x += dpp_shr(x, 1); x += dpp_shr(x, 2); x += dpp_shr(x, 4); x += dpp_shr(x, 8); return x; }
__device__ __forceinline__ f32x4 mixed4(const bf16* H, const float* mu, int m, int col, bool first) {
    const f32x4 z = up4(*(const GAS u32x2*)(H + (size_t)m * NH + col));
    f32x4 p = {0.f, 0.f, 0.f, 0.f};
    if (!first) p = up4(*(const GAS u32x2*)(H + (size_t)(m - 1) * NH + col));
    const f32x4 mv = *(const GAS f32x4*)(mu + col);
    return z + mv * (p - z);
}
__device__ __forceinline__ void pq2(const LAS bf16* P, const LAS bf16* Q, int tt, int hf, int lane, f32x4 (&acc)[2]) {
#pragma unroll
    for (int ks = 0; ks < 2; ++ks) { const bf16x8 bp = frag_rows(P, 16 * tt, 32 * ks, lane);
#pragma unroll
        for (int j = 0; j < 2; ++j) acc[j] = mfma16(frag_tr(Q, 32 * ks, 16 * (2 * hf + j), lane), bp, acc[j]); }
}
#define WG_BAR() do { asm volatile("s_waitcnt vmcnt(0) lgkmcnt(0)" ::: "memory"); __builtin_amdgcn_s_barrier(); asm volatile("" ::: "memory"); } while (0)

__device__ __forceinline__ void rwkvA_unit(Frame& F, const Args& A, int unit) {
    const int lane = F.lane, w = F.wave, tt = w & 3, hf = w >> 2, i = lane & 15, g = lane >> 4;
    const int bh = unit >> 7, c = unit & 127, b = bh >> 3, h = bh & 7;
    const int t = 16 * tt + i, m = b * SEQ + c * 64 + t;
    const bool first = (c == 0) && (t == 0);
    LAS unsigned char* L = F.lds + RING_OFF;
#define ARR(k) ((LAS bf16*)(L + (k) * ARRB))
    LAS float* tot = (LAS float*)(L + A_SMALL); LAS float* gcl = tot + 256; LAS float* pss = gcl + 64; LAS float* pbn = pss + 128;
    const bf16* H = WSB_(A, WS_H);
    const float z4[4] = {0.f, 0.f, 0.f, 0.f}; (void)z4;
    f32x4 rv[2], kv[2], vv[2];
#pragma unroll
    for (int j = 0; j < 2; ++j) { const int cb = 16 * (2 * hf + j) + 4 * g;
        rv[j] = mixed4(H, MU_(A), m, C_R + h * 64 + cb, first); kv[j] = mixed4(H, MU_(A), m, C_K + h * 64 + cb, first); vv[j] = mixed4(H, MU_(A), m, C_V + h * 64 + cb, first);
        f32x4 wd = mixed4(H, MU_(A), m, C_WD + cb, first); const f32x4 ad = mixed4(H, MU_(A), m, C_AD + cb, first);
#pragma unroll
        for (int r = 0; r < 4; ++r) wd[r] = tanhf(wd[r]);
        st4(ARR(A_XA), t, cb, wd); st4(ARR(A_XB), t, cb, ad); }
    WG_BAR();
    f32x4 aw[2] = {{0.f, 0.f, 0.f, 0.f}, {0.f, 0.f, 0.f, 0.f}}, aa[2] = {{0.f, 0.f, 0.f, 0.f}, {0.f, 0.f, 0.f, 0.f}};
#pragma unroll
    for (int ks = 0; ks < 2; ++ks) { const bf16x8 btw = frag_rows(ARR(A_XA), 16 * tt, 32 * ks, lane), bad = frag_rows(ARR(A_XB), 16 * tt, 32 * ks, lane);
#pragma unroll
        for (int j = 0; j < 2; ++j) { const size_t wo = (size_t)(h * 64 + 16 * (2 * hf + j) + i) * 64 + 32 * ks + 8 * g;
            const bf16x8 a_w = *(const GAS bf16x8*)(WSB_(A, WS_W2T) + wo), a_a = *(const GAS bf16x8*)(WSB_(A, WS_A2T) + wo);
            aw[j] = mfma16(a_w, btw, aw[j]); aa[j] = mfma16(a_a, bad, aa[j]); } }
    f32x4 ld[2], av[2], kkr[2], k2[2], cum[2]; float ssq = 0.f, bon = 0.f;
#pragma unroll
    for (int j = 0; j < 2; ++j) { const int hc = h * 64 + 16 * (2 * hf + j) + 4 * g;
        const f32x4 w0 = *(const GAS f32x4*)(W0_(A) + hc), a0 = *(const GAS f32x4*)(A0_(A) + hc), kkc = *(const GAS f32x4*)(K_K_(A) + hc), kac = *(const GAS f32x4*)(K_A_(A) + hc), rkc = *(const GAS f32x4*)(R_K_(A) + hc);
#pragma unroll
        for (int r = 0; r < 4; ++r) {
            const float x = -(w0[r] + aw[j][r]); const float sp = fmaxf(x, 0.f) + log1pf(__expf(-fabsf(x)));
            ld[j][r] = -__expf(-sp - 0.5f);
            const float a = sigmoidf_(a0[r] + aa[j][r]); av[j][r] = a;
            kkr[j][r] = kv[j][r] * kkc[r]; ssq += kkr[j][r] * kkr[j][r];
            k2[j][r] = kv[j][r] * (1.0f + (a - 1.0f) * kac[r]);
            bon += rv[j][r] * k2[j][r] * rkc[r];
            cum[j][r] = row_scan(ld[j][r]);
        }
        if (i == 15) *(LAS f32x4*)(tot + tt * 64 + 16 * (2 * hf + j) + 4 * g) = cum[j]; }
    ssq += __shfl_xor(ssq, 16); ssq += __shfl_xor(ssq, 32); bon += __shfl_xor(bon, 16); bon += __shfl_xor(bon, 32);
    if (g == 0) { pss[w * 16 + i] = ssq; pbn[w * 16 + i] = bon; }
    WG_BAR();
    ssq = pss[w * 16 + i] + pss[(w ^ 4) * 16 + i]; bon = pbn[w * 16 + i] + pbn[(w ^ 4) * 16 + i];
    const float inv = 1.0f / fmaxf(sqrtf(ssq), 1e-12f);
#pragma unroll
    for (int j = 0; j < 2; ++j) { const int cb = 16 * (2 * hf + j) + 4 * g;
        f32x4 off = {0.f, 0.f, 0.f, 0.f}, all = {0.f, 0.f, 0.f, 0.f};
#pragma unroll
        for (int q = 0; q < 4; ++q) { const f32x4 tq = *(const LAS f32x4*)(tot + q * 64 + cb); all = all + tq; if (q < tt) off = off + tq; }
        f32x4 at, bhv, khv, rt;
#pragma unroll
        for (int r = 0; r < 4; ++r) { const float cm = cum[j][r] + off[r]; const float ep = __expf(cm), em = __expf(-cm), epv = __expf(cm - ld[j][r]); const float kk = kkr[j][r] * inv;
            at[r] = -kk * epv; bhv[r] = kk * av[j][r] * em; khv[r] = k2[j][r] * em; rt[r] = rv[j][r] * ep; }
        st4(ARR(A_AT), t, cb, at); st4(ARR(A_BH), t, cb, bhv); st4(ARR(A_KH), t, cb, khv); st4(ARR(A_RT), t, cb, rt); st4(ARR(A_VQ), t, cb, vv[j]);
        *(GAS u32x2*)(WSB_(A, WS_VMX) + (size_t)m * RW + h * 64 + cb) = pk4(vv[j]);
        if (tt == 0 && i == 0) { f32x4 gc; for (int r = 0; r < 4; ++r) gc[r] = __expf(all[r]); *(LAS f32x4*)(gcl + cb) = gc; } }
    if (hf == 0 && g == 0) WSF_(A, WS_BON)[(size_t)m * 8 + h] = bon;
    WG_BAR();
#pragma unroll
    for (int j = 0; j < 2; ++j) { const int mt = 2 * hf + j;
        f32x4 ab = {0.f, 0.f, 0.f, 0.f}, ak = ab, rb = ab, rk = ab;
        if (mt <= tt) {
#pragma unroll
            for (int ks = 0; ks < 2; ++ks) { const bf16x8 abh = frag_rows(ARR(A_BH), 16 * mt, 32 * ks, lane), akh = frag_rows(ARR(A_KH), 16 * mt, 32 * ks, lane), bat = frag_rows(ARR(A_AT), 16 * tt, 32 * ks, lane), brt = frag_rows(ARR(A_RT), 16 * tt, 32 * ks, lane);
                ab = mfma16(abh, bat, ab); ak = mfma16(akh, bat, ak); rb = mfma16(abh, brt, rb); rk = mfma16(akh, brt, rk); } }
        f32x4 t1;
#pragma unroll
        for (int r = 0; r < 4; ++r) { const int s = 16 * mt + 4 * g + r; const bool lt = s < t, le = s <= t;
            ab[r] = lt ? ab[r] : 0.f; ak[r] = lt ? ak[r] : 0.f; rb[r] = le ? rb[r] : 0.f; rk[r] = le ? rk[r] : 0.f; t1[r] = ab[r] + (s == t ? 1.0f : 0.f); }
        const int cb = 16 * mt + 4 * g;
        st4(ARR(A_XA), t, cb, ab); st4(ARR(A_TA), t, cb, t1); st4(ARR(A_MAK), t, cb, ak); st4(ARR(A_MRB), t, cb, rb); st4(ARR(A_MRK), t, cb, rk); }
    WG_BAR();
    const int cb0 = 16 * (2 * hf) + 4 * g, cb1 = cb0 + 16;
#define SQ_STAGE(XC, XN) do { f32x4 z[2] = {{0.f, 0.f, 0.f, 0.f}, {0.f, 0.f, 0.f, 0.f}}; pq2(ARR(XC), ARR(XC), tt, hf, lane, z); st4(ARR(XN), t, cb0, z[0]); st4(ARR(XN), t, cb1, z[1]); } while (0)
#define T_STAGE(TC, TN, XC) do { f32x4 z[2]; z[0] = ld4(ARR(TC), t, cb0); z[1] = ld4(ARR(TC), t, cb1); pq2(ARR(TC), ARR(XC), tt, hf, lane, z); st4(ARR(TN), t, cb0, z[0]); st4(ARR(TN), t, cb1, z[1]); } while (0)
    SQ_STAGE(A_XA, A_XB); WG_BAR();
    SQ_STAGE(A_XB, A_XA); T_STAGE(A_TA, A_TB, A_XB); WG_BAR();
    SQ_STAGE(A_XA, A_XB); T_STAGE(A_TB, A_TA, A_XA); WG_BAR();
    SQ_STAGE(A_XB, A_XA); T_STAGE(A_TA, A_TB, A_XB); WG_BAR();
    SQ_STAGE(A_XA, A_XB); T_STAGE(A_TB, A_TA, A_XA); WG_BAR();
    T_STAGE(A_TA, A_TB, A_XB); WG_BAR();
    { f32x4 z[2] = {{0.f, 0.f, 0.f, 0.f}, {0.f, 0.f, 0.f, 0.f}}; pq2(ARR(A_TB), ARR(A_AT), tt, hf, lane, z); st4(ARR(A_XA), t, cb0, z[0]); st4(ARR(A_XA), t, cb1, z[1]); }
    { f32x4 z[2] = {{0.f, 0.f, 0.f, 0.f}, {0.f, 0.f, 0.f, 0.f}}; pq2(ARR(A_MAK), ARR(A_VQ), tt, hf, lane, z); st4(ARR(A_TA), t, cb0, z[0]); st4(ARR(A_TA), t, cb1, z[1]); }
    WG_BAR();
    { f32x4 z[2] = {{0.f, 0.f, 0.f, 0.f}, {0.f, 0.f, 0.f, 0.f}}; pq2(ARR(A_TB), ARR(A_TA), tt, hf, lane, z); st4(ARR(A_XB), t, cb0, z[0]); st4(ARR(A_XB), t, cb1, z[1]); }
    WG_BAR();
    { f32x4 z[2]; z[0] = ld4(ARR(A_RT), t, cb0); z[1] = ld4(ARR(A_RT), t, cb1); pq2(ARR(A_MRB), ARR(A_XA), tt, hf, lane, z);
      bf16* qe = WSB_(A, WS_QE) + ((size_t)unit * 64 + t) * 64; *(GAS u32x2*)(qe + cb0) = pk4(z[0]); *(GAS u32x2*)(qe + cb1) = pk4(z[1]); }
    { f32x4 z[2] = {{0.f, 0.f, 0.f, 0.f}, {0.f, 0.f, 0.f, 0.f}}; pq2(ARR(A_MRB), ARR(A_XB), tt, hf, lane, z); pq2(ARR(A_MRK), ARR(A_VQ), tt, hf, lane, z);
      float* ol = WSF_(A, WS_OL) + ((size_t)unit * 64 + t) * 64; *(GAS f32x4*)(ol + cb0) = z[0]; *(GAS f32x4*)(ol + cb1) = z[1]; }
    {
      f32x4 p[2] = {{0.f, 0.f, 0.f, 0.f}, {0.f, 0.f, 0.f, 0.f}}, s[2] = {{0.f, 0.f, 0.f, 0.f}, {0.f, 0.f, 0.f, 0.f}};
#pragma unroll
      for (int ks = 0; ks < 2; ++ks) { const bf16x8 bbh = frag_tr(ARR(A_BH), 32 * ks, 16 * tt, lane), bul = frag_tr(ARR(A_XB), 32 * ks, 16 * tt, lane), bvq = frag_tr(ARR(A_VQ), 32 * ks, 16 * tt, lane);
#pragma unroll
          for (int j = 0; j < 2; ++j) { const int mt = 2 * hf + j;
              p[j] = mfma16(frag_tr(ARR(A_XA), 32 * ks, 16 * mt, lane), bbh, p[j]);
              s[j] = mfma16(frag_tr(ARR(A_BH), 32 * ks, 16 * mt, lane), bul, s[j]);
              s[j] = mfma16(frag_tr(ARR(A_KH), 32 * ks, 16 * mt, lane), bvq, s[j]); } }
      const float gkp = gcl[16 * tt + i];
      bf16* pt = WSB_(A, WS_PT) + ((size_t)unit * 64 + 16 * tt + i) * 64; float* sl = WSF_(A, WS_SL) + ((size_t)unit * 64 + 16 * tt + i) * 64;
#pragma unroll
      for (int j = 0; j < 2; ++j) { const int cb = 16 * (2 * hf + j) + 4 * g; const f32x4 gq = *(const LAS f32x4*)(gcl + cb);
#pragma unroll
          for (int r = 0; r < 4; ++r) { p[j][r] = gkp * (p[j][r] + ((cb + r) == (16 * tt + i) ? 1.0f : 0.f)); s[j][r] *= gq[r]; }
          *(GAS u32x2*)(pt + cb) = pk4(p[j]); *(GAS f32x4*)(sl + cb) = s[j]; } }
    WG_BAR();
#undef SQ_STAGE
#undef T_STAGE
#undef ARR
}

__device__ __forceinline__ void rwkv_carry(Frame& F, const Args& A, int bh) {
    const int lane = F.lane, w = F.wave, i = lane & 15, g = lane >> 4;
    if (w >= 4) return;
    const int v = 16 * w + i;
    f32x4 acc[4];
#pragma unroll
    for (int mt = 0; mt < 4; ++mt) acc[mt] = (f32x4){0.f, 0.f, 0.f, 0.f};
    u32x2 pa[4][2][2]; f32x4 sl[4];
    const bf16* PT = WSB_(A, WS_PT) + (size_t)bh * 128 * 4096; const float* SL = WSF_(A, WS_SL) + (size_t)bh * 128 * 4096; bf16* S0B = WSB_(A, WS_S0B) + (size_t)bh * 128 * 4096;
#define CARRY_LOAD(cc) do { const bf16* pp = PT + (size_t)(cc) * 4096; const float* ss = SL + (size_t)(cc) * 4096 + v * 64 + 4 * g; \
        _Pragma("unroll") for (int mt = 0; mt < 4; ++mt) { sl[mt] = *(const GAS f32x4*)(ss + 16 * mt); \
            _Pragma("unroll") for (int ks = 0; ks < 2; ++ks) { pa[mt][ks][0] = *(const GAS u32x2*)(pp + (16 * mt + i) * 64 + 32 * ks + 4 * g); pa[mt][ks][1] = *(const GAS u32x2*)(pp + (16 * mt + i) * 64 + 32 * ks + 16 + 4 * g); } } } while (0)
    CARRY_LOAD(0);
    for (int c = 0; c < 128; ++c) {
        u32x2 pc[4][2][2]; f32x4 sc[4];
#pragma unroll
        for (int mt = 0; mt < 4; ++mt) { sc[mt] = sl[mt];
#pragma unroll
            for (int ks = 0; ks < 2; ++ks) { pc[mt][ks][0] = pa[mt][ks][0]; pc[mt][ks][1] = pa[mt][ks][1]; } }
        if (c + 1 < 128) CARRY_LOAD(c + 1);
        bf16* s0 = S0B + (size_t)c * 4096 + v * 64 + 4 * g;
        u32x2 pk[4];
#pragma unroll
        for (int mt = 0; mt < 4; ++mt) { pk[mt] = pk4(acc[mt]); *(GAS u32x2*)(s0 + 16 * mt) = pk[mt]; }
#pragma unroll
        for (int ks = 0; ks < 2; ++ks) { const v4u bw = {pk[2 * ks].x, pk[2 * ks].y, pk[2 * ks + 1].x, pk[2 * ks + 1].y}; const bf16x8 bf = __builtin_bit_cast(bf16x8, bw);
#pragma unroll
            for (int mt = 0; mt < 4; ++mt) { const v4u aw4 = {pc[mt][ks][0].x, pc[mt][ks][0].y, pc[mt][ks][1].x, pc[mt][ks][1].y}; sc[mt] = mfma16(__builtin_bit_cast(bf16x8, aw4), bf, sc[mt]); } }
#pragma unroll
        for (int mt = 0; mt < 4; ++mt) acc[mt] = sc[mt];
    }
#undef CARRY_LOAD
    float* so = A.out + O_WKVP + ((size_t)bh * 64 + v) * 64 + 4 * g;
#pragma unroll
    for (int mt = 0; mt < 4; ++mt) *(GAS f32x4*)(so + 16 * mt) = acc[mt];
}

__device__ __forceinline__ void rwkvC_unit(Frame& F, const Args& A, int unit) {
    const int lane = F.lane, tt = F.wave & 3, i = lane & 15, g = lane >> 4;
    const int bh = unit >> 7, c = unit & 127, b = bh >> 3, h = bh & 7;
    const int t = 16 * tt + i, m = b * SEQ + c * 64 + t;
    const bf16* QE = WSB_(A, WS_QE) + (size_t)unit * 4096; const bf16* S0 = WSB_(A, WS_S0B) + (size_t)unit * 4096; const float* OL = WSF_(A, WS_OL) + (size_t)unit * 4096;
    f32x4 acc[4];
#pragma unroll
    for (int mt = 0; mt < 4; ++mt) acc[mt] = *(const GAS f32x4*)(OL + t * 64 + 16 * mt + 4 * g);
#pragma unroll
    for (int ks = 0; ks < 2; ++ks) { const bf16x8 bq = *(const GAS bf16x8*)(QE + t * 64 + 32 * ks + 8 * g);
#pragma unroll
        for (int mt = 0; mt < 4; ++mt) acc[mt] = mfma16(*(const GAS bf16x8*)(S0 + (16 * mt + i) * 64 + 32 * ks + 8 * g), bq, acc[mt]); }
    float s = 0.f;
#pragma unroll
    for (int mt = 0; mt < 4; ++mt) s += (acc[mt][0] + acc[mt][1]) + (acc[mt][2] + acc[mt][3]);
    s += __shfl_xor(s, 16); s += __shfl_xor(s, 32);
    const float mean = s * (1.0f / 64.0f); float q = 0.f;
#pragma unroll
    for (int mt = 0; mt < 4; ++mt)
#pragma unroll
        for (int r = 0; r < 4; ++r) { const float d = acc[mt][r] - mean; q += d * d; }
    q += __shfl_xor(q, 16); q += __shfl_xor(q, 32);
    const float rstd = 1.0f / sqrtf(q * (1.0f / 64.0f) + GN_EPS);
    const float bon = WSF_(A, WS_BON)[(size_t)m * 8 + h];
#pragma unroll
    for (int mt = 0; mt < 4; ++mt) { const int hc = h * 64 + 16 * mt + 4 * g;
        const f32x4 gg = *(const GAS f32x4*)(LNX_G_(A) + hc), bb = *(const GAS f32x4*)(LNX_B_(A) + hc);
        const f32x4 vm = up4(*(const GAS u32x2*)(WSB_(A, WS_VMX) + (size_t)m * RW + hc)), zr = up4(*(const GAS u32x2*)(WSB_(A, WS_H) + (size_t)m * NH + C_ZR + hc));
        f32x4 y;
#pragma unroll
        for (int r = 0; r < 4; ++r) y[r] = ((acc[mt][r] - mean) * rstd * gg[r] + bb[r] + bon * vm[r]) * zr[r];
        *(GAS u32x2*)(WSB_(A, WS_YR) + (size_t)m * RW + hc) = pk4(y); }
}

__device__ __forceinline__ void ln_row(Frame& F, const Args& A, int m) {
    const GAS f32x4* xr = (const GAS f32x4*)(WSF_(A, WS_PRE) + (size_t)m * DM) + F.lane;
    f32x4 v[4]; float s = 0.f;
#pragma unroll
    for (int j = 0; j < 4; ++j) { v[j] = xr[64 * j]; s += (v[j].x + v[j].y) + (v[j].z + v[j].w); }
    const float mean = wave_sum(s) * (1.f / DM); float s2 = 0.f;
#pragma unroll
    for (int j = 0; j < 4; ++j) { v[j] = v[j] - mean; s2 += (v[j].x * v[j].x + v[j].y * v[j].y) + (v[j].z * v[j].z + v[j].w * v[j].w); }
    const float rstd = 1.f / sqrtf(wave_sum(s2) * (1.f / DM) + LN_EPS);
    GAS f32x4* o = (GAS f32x4*)(A.out + (size_t)m * DM) + F.lane;
#pragma unroll
    for (int j = 0; j < 4; ++j) { const f32x4 g = *((const GAS f32x4*)LN_G_(A) + F.lane + 64 * j), bta = *((const GAS f32x4*)LN_B_(A) + F.lane + 64 * j); o[64 * j] = v[j] * rstd * g + bta; }
}

__global__ void __launch_bounds__(NWAVES * 64, 2) mega_fwd(Args args) {
    extern __shared__ __attribute__((aligned(16))) unsigned char lds[];
    Frame F;
    F.lds = (LAS unsigned char*)lds;
    F.MISC = (volatile LAS unsigned*)(F.lds + MISC_OFF);
    F.tid = threadIdx.x; F.lane = F.tid & 63; F.wave = __builtin_amdgcn_readfirstlane(F.tid >> 6);
    F.G = gridDim.x;
    F.ctl = (gu32*)(args.ws + WS_CTL);
    for (int u = F.tid; u < (LDS_BYTES - LDSCTL_OFF) / 4; u += NWAVES * 64) ((LAS unsigned*)(F.lds + LDSCTL_OFF))[u] = 0u;
    __syncthreads();
    XcdBarrier bar; bar.bar = (unsigned*)(F.ctl + CW_BAR); bar.x = 0; bar.st = nullptr;
    if (N_LAUNCHES == 1) bar = xcd_barrier_post((unsigned*)(F.ctl + CW_BAR), F.MISC + 8);
#define GRID_BAR() do { if (N_LAUNCHES == 1) xcd_barrier(bar); } while (0)
    const int lo = args.ph_lo, hi = args.ph_hi;
#ifndef PH_MASK
#define PH_MASK 0xFFFF
#endif
#define IN(k) ((((PH_MASK) >> (k)) & 1) && lo <= (k) && (k) < hi)
#define BOTH(k) (IN(k) && IN((k) + 1))
    const int gw = blockIdx.x * NWAVES + F.wave, NGW = F.G * NWAVES;

    if (IN(0)) { p0_prologue(F, args); if (BOTH(0)) GRID_BAR(); }
    if (IN(1)) {
        pg8::Gemm g{WSB_(args, WS_XB), WSB_(args, WS_WIN), M, NH, DM}; pg8::StaticOrder S; S.init(M, NH, F.G, (int)blockIdx.x);
        pg8::EpiH E{WSB_(args, WS_H), B_GATE_(args), args.out};
        pg8::gemm_phase<pg8::EpiH, pg8::StaticOrder, PG8_ALIGN, PG8_SP2>(F.lds + RING_OFF, g, S, E);
        if (BOTH(1)) GRID_BAR();
    }
    if (IN(2)) {
        for (int m = MP + gw; m < M; m += NGW) rwkv_prep_row(F, args, m);
        for (int u = blockIdx.x; u < NUNITS; u += F.G) rwkvA_unit(F, args, u);
        if (BOTH(2)) GRID_BAR();
    }
    if (IN(3)) {
        if (blockIdx.x < 16) rwkv_carry(F, args, (int)blockIdx.x);
        for (int it = 16 + gw; it < 16 + DBATCH * 8; it += NGW) scan_item(F, args, it);
        LAS float* sq = (LAS float*)(F.lds + RING_OFF + F.wave * 2048); LAS float* sp = sq + 128;
        for (int it = gw; it < M * 4; it += NGW) { const int m = it >> 2, h = it & 3; if (m < MP) attn_item<true>(F, args, m, h, sq, sp); else attn_item<false>(F, args, m, h, sq, sp); }
        if (BOTH(3)) GRID_BAR();
    }
    if (IN(4)) {
        for (int u2 = blockIdx.x; u2 < NUNITS / 2; u2 += F.G) rwkvC_unit(F, args, 2 * u2 + (F.wave >> 2));
        for (int m = MP + gw; m < M; m += NGW) rwkv_post_row(F, args, m);
        if (BOTH(4)) GRID_BAR();
    }
    if (IN(5)) {
        pg8::Gemm g{WSB_(args, WS_YR), WSB_(args, WS_WOA), M, DM, RW}; pg8::StaticOrder S; S.init(M, DM, F.G, (int)blockIdx.x);
        pg8::EpiMixA E{WSB_(args, WS_H), WSF_(args, WS_MIXF)};
        pg8::gemm_phase<pg8::EpiMixA, pg8::StaticOrder, PG8_ALIGN, PG8_SP2>(F.lds + RING_OFF, g, S, E);
        if (BOTH(5)) GRID_BAR();
    }
    if (IN(6)) {
        pg8::Gemm g{WSB_(args, WS_YA), WSB_(args, WS_WOB), M, DM, RW}; pg8::StaticOrder S; S.init(M, DM, F.G, (int)blockIdx.x);
        pg8::EpiMixB E{WSB_(args, WS_H), WSF_(args, WS_MIXF), WSB_(args, WS_MIX)};
        pg8::gemm_phase<pg8::EpiMixB, pg8::StaticOrder, PG8_ALIGN, PG8_SP2>(F.lds + RING_OFF, g, S, E);
        if (BOTH(6)) GRID_BAR();
    }
    if (IN(7)) {
        pg8::Gemm g{WSB_(args, WS_MIX), WSB_(args, WS_WOUT), M, DM, DM}; pg8::StaticOrder S; S.init(M, DM, F.G, (int)blockIdx.x);
        pg8::EpiPre E{XP_(args), XS_(args), WSF_(args, WS_PRE)};
        pg8::gemm_phase<pg8::EpiPre, pg8::StaticOrder, PG8_ALIGN, PG8_SP2>(F.lds + RING_OFF, g, S, E);
        if (BOTH(7)) GRID_BAR();
    }
    if (IN(8)) {
        for (int m = gw; m < M; m += NGW) ln_row(F, args, m);
    }
#undef IN
#undef BOTH
}

extern "C" void kernel_launch(void* const* d_in, const int* in_sizes, int n_in, void* d_out, int out_size, void* d_ws, size_t ws_size, hipStream_t stream) {
    static int grid = 0;
    if (grid == 0) {
        if (n_in != 24 || in_sizes[0] != MP * DM || (size_t)out_size != O_END || ws_size < WS_END) { fprintf(stderr, "kernel_launch: unexpected shapes (n_in %d, in0 %d, out %d, ws %zu); nothing launched\n", n_in, n_in > 0 ? in_sizes[0] : -1, out_size, ws_size); grid = -1; return; }
        int dev = 0, cus = 0, per_cu = 0;
        if (hipGetDevice(&dev) != hipSuccess || hipDeviceGetAttribute(&cus, hipDeviceAttributeMultiprocessorCount, dev) != hipSuccess) { grid = -1; return; }
        if (hipFuncSetAttribute((const void*)mega_fwd, hipFuncAttributeMaxDynamicSharedMemorySize, LDS_BYTES) != hipSuccess) { fprintf(stderr, "kernel_launch: hipFuncSetAttribute failed\n"); grid = -1; return; }
        if (hipOccupancyMaxActiveBlocksPerMultiprocessor(&per_cu, (const void*)mega_fwd, NWAVES * 64, LDS_BYTES) != hipSuccess || per_cu < 1) fprintf(stderr, "kernel_launch: occupancy query reports %d\n", per_cu);
        (void)hipGetLastError();
        grid = cus;
    }
    if (grid < 0) return;
    if (hipMemsetAsync((char*)d_ws + WS_CTL, 0, CTL_ZERO_BYTES, stream) != hipSuccess) return;
    Args a{};
    for (int i = 0; i < 24; ++i) a.in[i] = (const float*)d_in[i];
    a.out = (float*)d_out; a.ws = (unsigned char*)d_ws;
    if (N_LAUNCHES == 1) { a.ph_lo = 0; a.ph_hi = N_PHASES; hipLaunchKernelGGL(mega_fwd, dim3(grid), dim3(NWAVES * 64), LDS_BYTES, stream, a); }
    else for (int li = 0; li < N_PHASES; ++li) { a.ph_lo = li; a.ph_hi = li + 1; hipLaunchKernelGGL(mega_fwd, dim3(grid), dim3(NWAVES * 64), LDS_BYTES, stream, a); }
}
```

```cpp
#include <hip/hip_runtime.h>
#include <cstdio>
#include <cstdint>
namespace pg8 {
#define PG8_LAS __attribute__((address_space(3)))
typedef unsigned short bf16_t;
typedef short bf16x8 __attribute__((ext_vector_type(8)));
typedef float f32x4 __attribute__((ext_vector_type(4)));
typedef unsigned u32x4 __attribute__((ext_vector_type(4)));
constexpr int BM = 256, BK = 64, HALF = 128, HTB = HALF * BK * 2  , STAGE_BYTES = 8 * HTB, NXCD = 8, WGM = 8;

__host__ __device__ __forceinline__ int lds_byte(int r, int c) { const int st = (r >> 4) * 2 + (c >> 5), rr = r & 15, cc = c & 31, ob = rr * 64 + cc * 2; return st * 1024 + (ob ^ (((ob >> 9) & 1) << 5)); }
__host__ __device__ __forceinline__ void stage_rc(int b, int& R, int& C) { const int st = b / 1024, sb = b % 1024, swz = sb ^ (((sb >> 9) & 1) << 5); R = (st >> 1) * 16 + swz / 64; C = (st & 1) * 32 + (swz % 64) / 2; }
__host__ __device__ __forceinline__ int perm32(int rho) { const int n = rho >> 4, i = rho & 15; return 8 * (i >> 2) + 4 * n + (i & 3); }

struct Unit { int pm, pn; };
struct Gemm { const bf16_t* A; const bf16_t* Bt; int M, N, K; };

struct StaticOrder {
    int nM, nN, nwg, G, c;
    __host__ __device__ void init(int M, int N, int G_, int c_) { nM = M / BM; nN = N / BM; nwg = nM * nN; G = G_; c = c_; }
    __host__ __device__ bool next(int i, Unit& u) const {
        const long L = (long)i * G + c; if (L >= nwg) return false;
        int wgid = (int)L; { const int q = nwg / NXCD, r = nwg % NXCD, xcd = wgid % NXCD, off = wgid / NXCD; wgid = (xcd < r ? xcd * (q + 1) : r * (q + 1) + (xcd - r) * q) + off; }
        const int nig = WGM * nN, gid = wgid / nig, fm = gid * WGM, gsz = (nM - fm) < WGM ? (nM - fm) : WGM;
        u.pm = fm + ((wgid % nig) % gsz); u.pn = (wgid % nig) / gsz; return true;
    }
    __device__ __forceinline__ void a_ready(const Unit&) const {}
    __device__ __forceinline__ void done(const Unit&) const {}
};

__device__ __forceinline__ unsigned cvt_pk_bf16(float lo, float hi) { unsigned r; asm volatile("v_cvt_pk_bf16_f32 %0, %1, %2" : "=v"(r) : "v"(lo), "v"(hi)); return r; }
typedef float f32x2 __attribute__((ext_vector_type(2)));
__device__ __forceinline__ f32x2 gelu_pk(f32x2 v) {
    const f32x2 av = __builtin_elementwise_abs(v), d = av * 0.2316418882f + 1.0f;
    f32x2 t; t.x = __builtin_amdgcn_rcpf(d.x); t.y = __builtin_amdgcn_rcpf(d.y);
    f32x2 q = t * 0.5307027145f + (-0.7265760135f); q = q * t + 0.7107068705f; q = q * t + (-0.142248368f); q = q * t + 0.127414796f; q = q * t;
    const f32x2 s = (v * v) * (-0.72134752044f);
    f32x2 e; e.x = __builtin_amdgcn_exp2f(s.x); e.y = __builtin_amdgcn_exp2f(s.y);
    const f32x2 m = v * (q * e), r = v - m;
    f32x2 o; o.x = v.x < 0.f ? m.x : r.x; o.y = v.y < 0.f ? m.y : r.y; return o;
}

template <int ACT  > struct EpiBf16 {
    static constexpr bool PERM = true, AFTER_DRAIN = false; static_assert(ACT == 0 || ACT == 1, "EpiBf16: ACT is 0 (none) or 1 (gelu_pk)");
    bf16_t* O; int ldc; const float* bias; int split_cols; size_t split_stride; float scale0;
    __device__ __forceinline__ void operator()(const f32x4 (&acc)[2][2][4][2], const Unit& u, int wr, int wc, int fr, int fq) const {
        const int row0 = u.pm * BM + wr * 64 + fr; int colt = u.pn * BM; bf16_t* base = O;
        float sc = 1.f; if (split_cols) { const int t = colt / split_cols; base += (size_t)t * split_stride; colt -= t * split_cols; if (t == 0) sc = scale0; }
        const int col0 = colt + wc * 32 + 8 * fq, bcol0 = u.pn * BM + wc * 32 + 8 * fq;
        f32x4 bv[2][2];
#pragma unroll
        for (int bj = 0; bj < 2; ++bj)
#pragma unroll
            for (int n = 0; n < 2; ++n) bv[bj][n] = bias ? *(const f32x4*)(bias + bcol0 + bj * HALF + 4 * n) : (f32x4){0.f, 0.f, 0.f, 0.f};
#pragma unroll
        for (int ai = 0; ai < 2; ++ai)
#pragma unroll
            for (int m = 0; m < 4; ++m) { bf16_t* rowp = base + (size_t)(row0 + ai * HALF + m * 16) * ldc + col0;
#pragma unroll
                for (int bj = 0; bj < 2; ++bj) { f32x4 v0 = acc[ai][bj][m][0] + bv[bj][0], v1 = acc[ai][bj][m][1] + bv[bj][1];
                    if (ACT == 1) { f32x2 a = gelu_pk((f32x2){v0[0], v0[1]}), b = gelu_pk((f32x2){v0[2], v0[3]}), c = gelu_pk((f32x2){v1[0], v1[1]}), d = gelu_pk((f32x2){v1[2], v1[3]});
                        v0 = (f32x4){a.x, a.y, b.x, b.y}; v1 = (f32x4){c.x, c.y, d.x, d.y}; }
                    v0 = v0 * sc; v1 = v1 * sc; u32x4 w; w.x = cvt_pk_bf16(v0[0], v0[1]); w.y = cvt_pk_bf16(v0[2], v0[3]); w.z = cvt_pk_bf16(v1[0], v1[1]); w.w = cvt_pk_bf16(v1[2], v1[3]);
                    *(u32x4*)(rowp + bj * HALF) = w; } }
    }
};

struct PanelStats {
    unsigned* xbuf;
    unsigned* cnt;
    unsigned* tmo;
    int ntn; float eps;
    unsigned code;
    __device__ __forceinline__ bool run(const f32x4 (&v)[2][2][4][2], const Unit& u, int wr, int wc, int fr, int fq, PG8_LAS unsigned char* lds, int wid, int lane) const {
        typedef float f32x2v __attribute__((ext_vector_type(2)));
        PG8_LAS f32x2v* P = (PG8_LAS f32x2v*)lds;
        PG8_LAS f32x2v* S = (PG8_LAS f32x2v*)(lds + 8192);
        PG8_LAS unsigned* flag = (PG8_LAS unsigned*)(lds + 8192 + 2048);
#pragma unroll
        for (int ai = 0; ai < 2; ++ai)
#pragma unroll
            for (int m = 0; m < 4; ++m) {
                float s = 0.f;
#pragma unroll
                for (int bj = 0; bj < 2; ++bj)
#pragma unroll
                    for (int n = 0; n < 2; ++n) { const f32x4 x = v[ai][bj][m][n]; s += (x[0] + x[1]) + (x[2] + x[3]); }
                s += __shfl_xor(s, 16); s += __shfl_xor(s, 32);
                const float mw = s * (1.0f / 64.0f); float q = 0.f;
#pragma unroll
                for (int bj = 0; bj < 2; ++bj)
#pragma unroll
                    for (int n = 0; n < 2; ++n) { const f32x4 d = v[ai][bj][m][n] - mw; q += (d[0] * d[0] + d[1] * d[1]) + (d[2] * d[2] + d[3] * d[3]); }
                q += __shfl_xor(q, 16); q += __shfl_xor(q, 32);
                if (fq == 0) P[(ai * HALF + wr * 64 + m * 16 + fr) * 4 + wc] = (f32x2v){mw, q};
            }
        asm volatile("s_waitcnt lgkmcnt(0)" ::: "memory"); __builtin_amdgcn_s_barrier(); asm volatile("" ::: "memory");
#if defined(BROKEN_EXCHANGE_NO_WAIT)
#warning BROKEN CONTROL BUILD: the row-statistics exchange does not wait; results are wrong by design
        if (blockIdx.x >= 64) { const long long t0_ = clock64(); while (clock64() - t0_ < 60000) __builtin_amdgcn_s_sleep(8); }
#endif
        const int row = wid * 32 + (lane & 31);
        if (lane < 32) {
            const f32x2v a = P[row * 4 + 0], b = P[row * 4 + 1], c = P[row * 4 + 2], d = P[row * 4 + 3];
            const float mt = (a.x + b.x + c.x + d.x) * 0.25f;
            const float da = a.x - mt, db = b.x - mt, dc = c.x - mt, dd = d.x - mt;
            const float m2 = (a.y + b.y) + (c.y + d.y) + 64.0f * ((da * da + db * db) + (dc * dc + dd * dd));
            unsigned long long* slot = (unsigned long long*)xbuf + ((size_t)(u.pm * BM + row) * 4 + u.pn);
            __hip_atomic_store(slot, ((unsigned long long)__float_as_uint(m2) << 32) | __float_as_uint(mt), __ATOMIC_RELAXED, __HIP_MEMORY_SCOPE_AGENT);
        }
        asm volatile("s_waitcnt vmcnt(0)" ::: "memory");
        if (lane == 0) __hip_atomic_fetch_add(cnt + 64 * u.pm, 1u, __ATOMIC_RELAXED, __HIP_MEMORY_SCOPE_AGENT);
        if (wid == 0) {
            bool dead = false; const unsigned long long t0 = __builtin_amdgcn_s_memrealtime(); const unsigned want = 8u * (unsigned)ntn;
            for (;;) {
#if defined(BROKEN_EXCHANGE_NO_WAIT)
                break;
#endif
                if ((unsigned)__builtin_amdgcn_readfirstlane(__hip_atomic_load(cnt + 64 * u.pm, __ATOMIC_RELAXED, __HIP_MEMORY_SCOPE_AGENT)) >= want) break;
                if (__builtin_amdgcn_s_memrealtime() - t0 > 2000000ull) {
                    if (lane == 0) { unsigned expect = 0u; __hip_atomic_compare_exchange_strong(tmo + 1, &expect, code | (unsigned)(u.pm & 0xff), __ATOMIC_RELAXED, __ATOMIC_RELAXED, __HIP_MEMORY_SCOPE_AGENT);
                                     __hip_atomic_store(tmo, 1u, __ATOMIC_RELAXED, __HIP_MEMORY_SCOPE_AGENT); }
                    dead = true; break; }
                __builtin_amdgcn_s_sleep(2);
            }
            __builtin_amdgcn_fence(__ATOMIC_ACQUIRE, "agent");
            if (lane == 0) flag[0] = dead ? 1u : 0u;
        }
        asm volatile("s_waitcnt vmcnt(0) lgkmcnt(0)" ::: "memory"); __builtin_amdgcn_s_barrier(); asm volatile("" ::: "memory");
        const bool bad = flag[0] != 0u;
        if (lane < 32) {
            const unsigned long long* slot = (const unsigned long long*)xbuf + (size_t)(u.pm * BM + row) * 4; float mt[4], m2[4]; float ms = 0.f;
#pragma unroll
            for (int t = 0; t < 4; ++t) { if (t < ntn) { const unsigned long long w = __hip_atomic_load(slot + t, __ATOMIC_RELAXED, __HIP_MEMORY_SCOPE_AGENT); mt[t] = __uint_as_float((unsigned)w); m2[t] = __uint_as_float((unsigned)(w >> 32)); } else { mt[t] = 0.f; m2[t] = 0.f; } ms += mt[t]; }
            const float mean = ms / (float)ntn; float q = 0.f;
#pragma unroll
            for (int t = 0; t < 4; ++t) if (t < ntn) { const float dm = mt[t] - mean; q += m2[t] + 256.0f * dm * dm; }
            S[row] = (f32x2v){mean, 1.0f / sqrtf(q / (256.0f * (float)ntn) + eps)};
        }
        asm volatile("s_waitcnt lgkmcnt(0)" ::: "memory"); __builtin_amdgcn_s_barrier(); asm volatile("" ::: "memory");
        return bad;
    }
};
struct EpiLnRes {
    static constexpr bool PERM = false, AFTER_DRAIN = true;
    const float* base; float* out; int ldc; const float* bias; PanelStats st; unsigned poison;
    __device__ __forceinline__ void fused(f32x4 (&acc)[2][2][4][2], const Unit& u, int wr, int wc, int fr, int fq, PG8_LAS unsigned char* lds, int wid, int lane) const {
        typedef float f32x2v __attribute__((ext_vector_type(2)));
        const PG8_LAS f32x2v* S = (const PG8_LAS f32x2v*)(lds + 8192);
        const int col0 = u.pn * BM + wc * 32 + 4 * fq;
#pragma unroll
        for (int bj = 0; bj < 2; ++bj)
#pragma unroll
            for (int n = 0; n < 2; ++n) { const f32x4 bv = bias ? *(const f32x4*)(bias + col0 + bj * HALF + n * 16) : (f32x4){0.f, 0.f, 0.f, 0.f};
#pragma unroll
                for (int ai = 0; ai < 2; ++ai)
#pragma unroll
                    for (int m = 0; m < 4; ++m) acc[ai][bj][m][n] += bv; }
        f32x4 pre[4][2][2];
#pragma unroll
        for (int m = 0; m < 4; ++m) { const size_t off = (size_t)(u.pm * BM + wr * 64 + m * 16 + fr) * ldc + col0;
#pragma unroll
            for (int bj = 0; bj < 2; ++bj)
#pragma unroll
                for (int n = 0; n < 2; ++n) pre[m][bj][n] = *(const f32x4*)(base + off + bj * HALF + n * 16); }
        const bool bad = st.run(acc, u, wr, wc, fr, fq, lds, wid, lane) || poison != 0u;
        const float qnan = __builtin_nanf("");
#pragma unroll
        for (int ai = 0; ai < 2; ++ai)
#pragma unroll
            for (int m = 0; m < 4; ++m) { const int r = ai * HALF + wr * 64 + m * 16 + fr; const f32x2v sr = S[r]; const size_t off = (size_t)(u.pm * BM + r) * ldc + col0;
#pragma unroll
                for (int bj = 0; bj < 2; ++bj)
#pragma unroll
                    for (int n = 0; n < 2; ++n) { const f32x4 bs = ai == 0 ? pre[m][bj][n] : *(const f32x4*)(base + off + bj * HALF + n * 16); f32x4 o = bs + (acc[ai][bj][m][n] - sr.x) * sr.y;
                        if (bad) o = (f32x4){qnan, qnan, qnan, qnan}; *(f32x4*)(out + off + bj * HALF + n * 16) = o; }
                if (m & 1) asm volatile("" ::: "memory"); }
    }
};
struct EpiLnResLn {
    static constexpr bool PERM = false, AFTER_DRAIN = true;
    const float* base; float* out; bf16_t* xn; int ldc; const float* bias; PanelStats st1, st2; unsigned poison;
    __device__ __forceinline__ void fused(f32x4 (&acc)[2][2][4][2], const Unit& u, int wr, int wc, int fr, int fq, PG8_LAS unsigned char* lds, int wid, int lane) const {
        typedef float f32x2v __attribute__((ext_vector_type(2))); typedef unsigned u32x2v __attribute__((ext_vector_type(2)));
        const PG8_LAS f32x2v* S = (const PG8_LAS f32x2v*)(lds + 8192);
        const int col0 = u.pn * BM + wc * 32 + 4 * fq;
#pragma unroll
        for (int bj = 0; bj < 2; ++bj)
#pragma unroll
            for (int n = 0; n < 2; ++n) { const f32x4 bv = bias ? *(const f32x4*)(bias + col0 + bj * HALF + n * 16) : (f32x4){0.f, 0.f, 0.f, 0.f};
#pragma unroll
                for (int ai = 0; ai < 2; ++ai)
#pragma unroll
                    for (int m = 0; m < 4; ++m) acc[ai][bj][m][n] += bv; }
        bool bad = st1.run(acc, u, wr, wc, fr, fq, lds, wid, lane) || poison != 0u;
        const float qnan = __builtin_nanf("");
#pragma unroll
        for (int ai = 0; ai < 2; ++ai)
#pragma unroll
            for (int m = 0; m < 4; ++m) { const int r = ai * HALF + wr * 64 + m * 16 + fr; const f32x2v sr = S[r]; const size_t off = (size_t)(u.pm * BM + r) * ldc + col0;
#pragma unroll
                for (int bj = 0; bj < 2; ++bj)
#pragma unroll
                    for (int n = 0; n < 2; ++n) { const f32x4 bs = *(const f32x4*)(base + off + bj * HALF + n * 16); acc[ai][bj][m][n] = bs + (acc[ai][bj][m][n] - sr.x) * sr.y; }
                asm volatile("" : "+v"(acc[ai][0][m][0]), "+v"(acc[ai][0][m][1]), "+v"(acc[ai][1][m][0]), "+v"(acc[ai][1][m][1]));
                if (m & 1) asm volatile("" ::: "memory"); }
        const bool bad1 = bad;
        bad = st2.run(acc, u, wr, wc, fr, fq, lds, wid, lane) || bad;
#pragma unroll
        for (int ai = 0; ai < 2; ++ai)
#pragma unroll
            for (int m = 0; m < 4; ++m) { const int r = ai * HALF + wr * 64 + m * 16 + fr; const f32x2v sr = S[r]; const size_t off = (size_t)(u.pm * BM + r) * ldc + col0;
#pragma unroll
                for (int bj = 0; bj < 2; ++bj)
#pragma unroll
                    for (int n = 0; n < 2; ++n) { const f32x4 x1 = acc[ai][bj][m][n]; *(f32x4*)(out + off + bj * HALF + n * 16) = bad1 ? (f32x4){qnan, qnan, qnan, qnan} : x1;
                        const f32x4 o = (x1 - sr.x) * sr.y; u32x2v w; w.x = cvt_pk_bf16(o[0], o[1]); w.y = cvt_pk_bf16(o[2], o[3]);
                        if (bad) { w.x = 0x7fc07fc0u; w.y = 0x7fc07fc0u; } *(u32x2v*)(xn + off + bj * HALF + n * 16) = w; }
                asm volatile("" ::: "memory"); }
    }
};

template <class Epi, class Sched, bool ALIGN_EPI = false, bool SP2 = false>
__device__ __forceinline__ void gemm_phase(PG8_LAS unsigned char* lds, const Gemm g, const Sched& S, const Epi& E) {
    const int tid = threadIdx.x, wid = __builtin_amdgcn_readfirstlane(tid >> 6), lane = tid & 63, wr = wid >> 2, wc = wid & 3, fr = lane & 15, fq = lane >> 4;
    const int K = g.K, nt = K / BK;
    unsigned voffA[2], voffB[2];
#pragma unroll
    for (int i = 0; i < 2; ++i) { int R, C; stage_rc(tid * 16 + i * 8192, R, C); const int Rb = Epi::PERM ? ((R & ~31) + perm32(R & 31)) : R;
        voffA[i] = (unsigned)(R * K + C) * 2u; voffB[i] = (unsigned)(Rb * K + C) * 2u; }
    const size_t kstep = (size_t)(BK * 2);
    const size_t hstep = (size_t)HALF * K * 2;
    const size_t tstep = 2 * hstep;
    const unsigned ldsw = (unsigned)wid * 1024u;
    const int aoff = lds_byte(wr * 64 + fr, fq * 8), boff = lds_byte(wc * 32 + fr, fq * 8);
#define PG8_SA(b, h) (((b) * 2 + (h)) * HTB)
#define PG8_SB(b, h) ((4 + (b) * 2 + (h)) * HTB)
#define PG8_STAGE(bufoff, gbase, voff) do { _Pragma("unroll") for (int _i = 0; _i < 2; ++_i) \
        __builtin_amdgcn_global_load_lds((const unsigned*)((const char*)(gbase) + (voff)[_i]), (PG8_LAS unsigned*)(lds + (bufoff) + ldsw + _i * 8192), 16, 0, 0); } while (0)
#define PG8_LDA(dst, b, h) do { _Pragma("unroll") for (int m = 0; m < 4; ++m) _Pragma("unroll") for (int k = 0; k < 2; ++k) dst[m][k] = *(const PG8_LAS bf16x8*)(lds + PG8_SA(b, h) + aoff + m * 2048 + k * 1024); } while (0)
#define PG8_LDB(dst, b, h) do { _Pragma("unroll") for (int n = 0; n < 2; ++n) _Pragma("unroll") for (int k = 0; k < 2; ++k) dst[n][k] = *(const PG8_LAS bf16x8*)(lds + PG8_SB(b, h) + boff + n * 2048 + k * 1024); } while (0)
#define PG8_MMA(ai, bj, At, Bt) do { __builtin_amdgcn_s_setprio(1); _Pragma("unroll") for (int m = 0; m < 4; ++m) _Pragma("unroll") for (int n = 0; n < 2; ++n) _Pragma("unroll") for (int k = 0; k < 2; ++k) \
        acc[ai][bj][m][n] = __builtin_amdgcn_mfma_f32_16x16x32_bf16(Bt[n][k], At[m][k], acc[ai][bj][m][n], 0, 0, 0); __builtin_amdgcn_s_setprio(0); } while (0)
#define PG8_WAIT_V(n) asm volatile("s_waitcnt vmcnt(" #n ")" ::: "memory")
#define PG8_WAIT_L(n) asm volatile("s_waitcnt lgkmcnt(" #n ")" ::: "memory")
#define PG8_BAR __builtin_amdgcn_s_barrier()
#define PG8_SCHED __builtin_amdgcn_sched_barrier(0)
    Unit cur, nxt; int ui = 0;
    if (!S.next(0, cur)) return;
    f32x4 acc[2][2][4][2];
#pragma unroll
    for (int a = 0; a < 2; ++a)
#pragma unroll
        for (int b = 0; b < 2; ++b)
#pragma unroll
            for (int m = 0; m < 4; ++m)
#pragma unroll
                for (int n = 0; n < 2; ++n) acc[a][b][m][n] = (f32x4){0.f, 0.f, 0.f, 0.f};
    bf16x8 At[4][2], B0[2][2], B1[2][2];
    const char* cA = (const char*)g.A + (size_t)cur.pm * tstep; const char* cB = (const char*)g.Bt + (size_t)cur.pn * tstep;
    S.a_ready(cur);
    if constexpr (SP2) {
        PG8_STAGE(PG8_SB(0, 0), cB, voffB); PG8_STAGE(PG8_SB(0, 1), cB + hstep, voffB); PG8_STAGE(PG8_SA(0, 0), cA, voffA); PG8_STAGE(PG8_SA(0, 1), cA + hstep, voffA);
        if (wr == 1) PG8_BAR;
        PG8_WAIT_V(2); PG8_BAR;
        PG8_STAGE(PG8_SB(1, 0), cB + kstep, voffB); PG8_STAGE(PG8_SA(1, 0), cA + kstep, voffA); PG8_STAGE(PG8_SB(1, 1), cB + hstep + kstep, voffB);
        PG8_WAIT_V(6); PG8_BAR;
    } else {
        PG8_STAGE(PG8_SB(0, 0), cB, voffB); PG8_STAGE(PG8_SA(0, 0), cA, voffA); PG8_STAGE(PG8_SB(0, 1), cB + hstep, voffB); PG8_STAGE(PG8_SA(0, 1), cA + hstep, voffA);
        if (wr == 1) PG8_BAR;
        PG8_WAIT_V(4); PG8_BAR;
        PG8_STAGE(PG8_SB(1, 0), cB + kstep, voffB); PG8_STAGE(PG8_SA(1, 0), cA + kstep, voffA); PG8_STAGE(PG8_SB(1, 1), cB + hstep + kstep, voffB);
        PG8_WAIT_V(6); PG8_BAR;
    }
    for (;;) {
        const bool has_next = S.next(ui + 1, nxt);
        const char* nA = has_next ? (const char*)g.A + (size_t)nxt.pm * tstep : cA; const char* nB = has_next ? (const char*)g.Bt + (size_t)nxt.pn * tstep : cB;
        for (int t = 0; t < nt; t += 2) {
            const bool last = (t == nt - 2);
            const char* a1 = cA + (size_t)(t + 1) * kstep;
            const char* a2 = last ? nA : cA + (size_t)(t + 2) * kstep; const char* b2 = last ? nB : cB + (size_t)(t + 2) * kstep;
            const char* a3 = a2 + kstep; const char* b3 = b2 + kstep;
            if (last && has_next) S.a_ready(nxt);
            if constexpr (SP2) {
            PG8_LDB(B0, 0, 0); PG8_LDB(B1, 0, 1); PG8_SCHED; PG8_LDA(At, 0, 0); PG8_STAGE(PG8_SA(1, 1), a1 + hstep, voffA);
            PG8_WAIT_V(8); PG8_WAIT_L(0); PG8_BAR; PG8_MMA(0, 0, At, B0); PG8_MMA(0, 1, At, B1); PG8_BAR; PG8_SCHED;
            PG8_LDA(At, 0, 1); PG8_STAGE(PG8_SB(0, 0), b2, voffB); PG8_STAGE(PG8_SB(0, 1), b2 + hstep, voffB); PG8_STAGE(PG8_SA(0, 0), a2, voffA);
            PG8_WAIT_V(8); PG8_WAIT_L(0); PG8_BAR; PG8_MMA(1, 0, At, B0); PG8_MMA(1, 1, At, B1); PG8_BAR; PG8_SCHED;
            PG8_LDB(B0, 1, 0); PG8_LDB(B1, 1, 1); PG8_SCHED; PG8_LDA(At, 1, 0); PG8_STAGE(PG8_SA(0, 1), a2 + hstep, voffA);
            PG8_WAIT_V(8); PG8_WAIT_L(0); PG8_BAR; PG8_MMA(0, 0, At, B0); PG8_MMA(0, 1, At, B1); PG8_BAR; PG8_SCHED;
            PG8_LDA(At, 1, 1); PG8_STAGE(PG8_SB(1, 0), b3, voffB); PG8_STAGE(PG8_SB(1, 1), b3 + hstep, voffB); PG8_STAGE(PG8_SA(1, 0), a3, voffA);
            PG8_WAIT_V(8); PG8_WAIT_L(0); PG8_BAR; PG8_MMA(1, 0, At, B0); PG8_MMA(1, 1, At, B1); PG8_BAR; PG8_SCHED;
            } else {
            PG8_LDB(B0, 0, 0); PG8_SCHED; PG8_LDA(At, 0, 0); PG8_STAGE(PG8_SA(1, 1), a1 + hstep, voffA);
            PG8_WAIT_L(8); PG8_BAR; PG8_WAIT_L(0); PG8_MMA(0, 0, At, B0); PG8_BAR; PG8_SCHED;
            PG8_LDB(B1, 0, 1); PG8_STAGE(PG8_SB(0, 0), b2, voffB);
            PG8_BAR; PG8_WAIT_L(0); PG8_MMA(0, 1, At, B1); PG8_BAR;
            PG8_LDA(At, 0, 1); PG8_STAGE(PG8_SA(0, 0), a2, voffA);
            PG8_BAR; PG8_WAIT_L(0); PG8_MMA(1, 0, At, B0); PG8_BAR; PG8_SCHED;
            PG8_STAGE(PG8_SB(0, 1), b2 + hstep, voffB);
            PG8_WAIT_V(6); PG8_BAR; PG8_MMA(1, 1, At, B1); PG8_BAR;
            PG8_LDB(B0, 1, 0); PG8_SCHED; PG8_LDA(At, 1, 0); PG8_STAGE(PG8_SA(0, 1), a2 + hstep, voffA);
            PG8_WAIT_L(8); PG8_BAR; PG8_WAIT_L(0); PG8_MMA(0, 0, At, B0); PG8_BAR; PG8_SCHED;
            PG8_LDB(B1, 1, 1); PG8_STAGE(PG8_SB(1, 0), b3, voffB);
            PG8_BAR; PG8_WAIT_L(0); PG8_MMA(0, 1, At, B1); PG8_BAR;
            PG8_LDA(At, 1, 1); PG8_STAGE(PG8_SA(1, 0), a3, voffA);
            PG8_BAR; PG8_WAIT_L(0); PG8_MMA(1, 0, At, B0); PG8_BAR; PG8_SCHED;
            PG8_STAGE(PG8_SB(1, 1), b3 + hstep, voffB);
            PG8_WAIT_V(6); PG8_BAR; PG8_MMA(1, 1, At, B1); PG8_BAR;
            }
        }
        if constexpr (ALIGN_EPI) { if (wr == 0) PG8_BAR; }
        if constexpr (!Epi::AFTER_DRAIN) { E(acc, cur, wr, wc, fr, fq); S.done(cur); }
        if (!has_next) break;
#pragma unroll
        for (int a = 0; a < 2; ++a)
#pragma unroll
            for (int b = 0; b < 2; ++b)
#pragma unroll
                for (int m = 0; m < 4; ++m)
#pragma unroll
                    for (int n = 0; n < 2; ++n) acc[a][b][m][n] = (f32x4){0.f, 0.f, 0.f, 0.f};
        cur = nxt; cA = nA; cB = nB; ++ui;
        if constexpr (ALIGN_EPI) { if (wr == 1) PG8_BAR; }
    }
    PG8_WAIT_V(0);
    if constexpr (!ALIGN_EPI) { if (wr == 0) PG8_BAR; }
    PG8_BAR;
    if constexpr (Epi::AFTER_DRAIN) { E.fused(acc, cur, wr, wc, fr, fq, lds, wid, lane); S.done(cur); }
#undef PG8_SA
#undef PG8_SB
#undef PG8_STAGE
#undef PG8_LDA
#undef PG8_LDB
#undef PG8_MMA
#undef PG8_WAIT_V
#undef PG8_WAIT_L
#undef PG8_BAR
#undef PG8_SCHED
}
}
#ifndef PG8_SP2
#define PG8_SP2 true
#endif
#ifndef PG8_ALIGN
#define PG8_ALIGN true
#endif
constexpr int NWAVES = 8;
#ifndef MK_N_LAUNCHES
#define MK_N_LAUNCHES 1
#endif
constexpr int N_PHASES = 9;
constexpr int N_LAUNCHES = MK_N_LAUNCHES;

constexpr int DM = 1024, SEQ = 8192, NBATCH = 2, MP = NBATCH * SEQ, DBATCH = 128, DSEQ = 4, MS = DBATCH * DSEQ, M = MP + MS;
constexpr int NIN = 9344, NH = 9472;
constexpr int RW = 512, SHIFTC = 1664;
constexpr int C_R = 0, C_K = 512, C_V = 1024, C_WD = 1536, C_AD = 1600, C_ZR = 1792, C_AQ = 2304, C_AK = 3840, C_AV = 5376, C_ZA = 6912, C_GR = 7424, C_GA = 8448;
constexpr float LN_EPS = 1e-5f, GN_EPS = 64e-5f;
constexpr float ALPHA = 1.189207115002721f;
constexpr float ATT_SCALE = 0.08838834764831845f;
constexpr size_t O_YP = 0, O_YS = O_YP + (size_t)MP * DM, O_KV1P = O_YS + (size_t)MS * DM, O_KV1S = O_KV1P + (size_t)2 * 128 * 1024, O_KV2P = O_KV1S + (size_t)MS * 1024,
                 O_KV2S = O_KV2P + (size_t)2 * 512 * 1024, O_KV3P = O_KV2S + (size_t)MS * 1024, O_KV3S = O_KV3P + (size_t)2 * 2048 * 1024, O_WKVP = O_KV3S + (size_t)MS * 1024,
                 O_WKVS = O_WKVP + (size_t)2 * 8 * 64 * 64, O_SHP = O_WKVS + (size_t)128 * 8 * 64 * 64, O_SHS = O_SHP + (size_t)2 * SHIFTC, O_END = O_SHS + (size_t)128 * SHIFTC;
static_assert(O_END == 28855552, "d_out size");

constexpr size_t MiB = 1u << 20;
constexpr size_t WS_CTL = 0, CTL_ZERO_BYTES = 1 * MiB;
constexpr size_t WS_WIN = 2 * MiB, WS_WOA = 22 * MiB, WS_WOB = 23 * MiB, WS_WOUT = 24 * MiB;
constexpr size_t WS_XB = 32 * MiB, WS_H = 96 * MiB, WS_YR = 416 * MiB, WS_YA = 448 * MiB, WS_MIX = 480 * MiB, WS_MIXF = 528 * MiB, WS_PRE = 608 * MiB;
constexpr size_t WS_RR = 704 * MiB, WS_DEC = 744 * MiB, WS_K2 = 784 * MiB, WS_VV = 824 * MiB, WS_KK = 864 * MiB, WS_KA = 904 * MiB, WS_OO = 944 * MiB;
constexpr size_t WS_W2T = 26 * MiB, WS_A2T = 27 * MiB;
constexpr size_t WS_QE = 984 * MiB, WS_PT = 1000 * MiB, WS_S0B = 1016 * MiB, WS_OL = 1032 * MiB, WS_SL = 1064 * MiB, WS_VMX = 1096 * MiB, WS_BON = 1112 * MiB, WS_AO = 1120 * MiB  , WS_LSE = 1170 * MiB  , WS_END = 1172 * MiB;
static_assert(WS_WIN + (size_t)NH * DM * 2 <= WS_WOA && WS_XB + (size_t)M * DM * 2 <= WS_H && WS_H + (size_t)M * NH * 2 <= WS_YR, "ws map");
constexpr int CW_TMO = 0, CW_CODE = 1, CW_Q = 2048, CW_BAR = 4096;

constexpr int RING_OFF = 0, RING_BYTES = 131072;
constexpr int LDSCTL_OFF = 146432, MISC_OFF = LDSCTL_OFF + 320;
constexpr int LDS_BYTES = 147456;
#define GAS __attribute__((address_space(1)))
#define LAS __attribute__((address_space(3)))
typedef unsigned short bf16;
typedef unsigned v4u __attribute__((ext_vector_type(4)));
typedef float f32x4 __attribute__((ext_vector_type(4)));
typedef short bf16x8 __attribute__((ext_vector_type(8)));
typedef GAS unsigned gu32;
typedef GAS unsigned long long gu64;
#define RLX_AGENT __ATOMIC_RELAXED, __HIP_MEMORY_SCOPE_AGENT
#define LDS_WAIT() asm volatile("s_waitcnt lgkmcnt(0)" ::: "memory")
#define VM_WAIT() asm volatile("s_waitcnt vmcnt(0)" ::: "memory")
__device__ __forceinline__ unsigned long long rt() { return __builtin_amdgcn_s_memrealtime(); }
__device__ __forceinline__ unsigned f2bf(float f) { unsigned u = __builtin_bit_cast(unsigned, f); return (u + 0x7fffu + ((u >> 16) & 1u)) >> 16; }
__device__ __forceinline__ unsigned pk2(float lo, float hi) { return f2bf(lo) | (f2bf(hi) << 16); }

#define XB_TMO      128
#define XB_XCNT(j)  (256  + 64 * (j))
#define XB_XSUB(j)  (1280 + 64 * (j))
#define XB_XGEN(j)  (2304 + 64 * (j))
#define XB_TOP      3328
#define XB_TOPGEN   3392
#define XCD_BAR_WORDS 3456
#define XB_SPIN_CAP (1u << 18)

__device__ __forceinline__ unsigned xb_ld(unsigned* p)              { return __hip_atomic_load(p, __ATOMIC_RELAXED, __HIP_MEMORY_SCOPE_AGENT); }
__device__ __forceinline__ unsigned xb_add(unsigned* p, unsigned v) { return __hip_atomic_fetch_add(p, v, __ATOMIC_RELAXED, __HIP_MEMORY_SCOPE_AGENT); }
__device__ __forceinline__ unsigned xb_xcc_id() { return (unsigned)__builtin_amdgcn_s_getreg((3 << 11) | 20) & 0xFu; }
#define XB_SPIN(cond, bar) do { unsigned _sp = 0; while (cond) { __builtin_amdgcn_s_sleep(1); \
    if ((++_sp & 255u) == 0u) { if (xb_ld(&(bar)[XB_TMO])) break; if (_sp > XB_SPIN_CAP) { atomicAdd(&(bar)[XB_TMO], 1u); break; } } } } while (0)

struct XcdBarrier {
    unsigned* bar; unsigned x;
    volatile LAS unsigned* st;
};

__device__ __forceinline__ XcdBarrier xcd_barrier_post(unsigned* bar, volatile LAS unsigned* st) {
    XcdBarrier b; b.bar = bar; b.x = xb_xcc_id(); b.st = st;
    if (threadIdx.x == 0) (void)xb_add(&bar[XB_XCNT(b.x)], 1u);
    return b;
}
__device__ __forceinline__ void xcd_barrier_complete(unsigned* bar, unsigned x, unsigned& nloc, unsigned& nx) {
    const unsigned G = gridDim.x * gridDim.y * gridDim.z;
    unsigned sum, cnt, mine, sp = 0u;
    for (;;) {
        sum = 0u; cnt = 0u; mine = 0u;
#pragma unroll
        for (unsigned j = 0; j < 16; ++j) { const unsigned c = xb_ld(&bar[XB_XCNT(j)]); sum += c; cnt += (c > 0u) ? 1u : 0u; mine = (j == x) ? c : mine; }
        if (sum == G) break;
        __builtin_amdgcn_s_sleep(1);
        if ((++sp & 255u) == 0u) { if (xb_ld(&bar[XB_TMO])) break; if (sp > XB_SPIN_CAP) { atomicAdd(&bar[XB_TMO], 1u); break; } }
    }
    nloc = mine > 0u ? mine : 1u; nx = cnt > 0u ? cnt : 1u;
}

__device__ __forceinline__ void xcd_barrier(const XcdBarrier& b) {
    asm volatile("s_waitcnt vmcnt(0)" ::: "memory");
    __syncthreads();
    if (threadIdx.x == 0) {
        unsigned* bar = b.bar;
        __builtin_amdgcn_s_waitcnt(0);
        unsigned nloc = b.st[0], nx = b.st[1];
        if (nloc == 0u) { xcd_barrier_complete(bar, b.x, nloc, nx); b.st[0] = nloc; b.st[1] = nx; }
        const unsigned old = xb_add(&bar[XB_XSUB(b.x)], 1u);
        const unsigned gen = old / nloc;
        if (old + 1u == (gen + 1u) * nloc) {
            __builtin_amdgcn_fence(__ATOMIC_RELEASE, "agent");
            asm volatile("s_waitcnt vmcnt(0)" ::: "memory");
            const unsigned og = xb_add(&bar[XB_TOP], 1u);
            const unsigned tg = og / nx;
            if (og + 1u == (tg + 1u) * nx) xb_add(&bar[XB_TOPGEN], 1u);
            else XB_SPIN(xb_ld(&bar[XB_TOPGEN]) == tg, bar);
            __builtin_amdgcn_fence(__ATOMIC_ACQUIRE, "agent");
            xb_add(&bar[XB_XGEN(b.x)], 1u);
            asm volatile("s_waitcnt vmcnt(0)" ::: "memory");
        } else {
            XB_SPIN(xb_ld(&bar[XB_XGEN(b.x)]) == gen, bar);
            __builtin_amdgcn_fence(__ATOMIC_ACQUIRE, "agent");
            asm volatile("s_waitcnt vmcnt(0)" ::: "memory");
        }
    }
    __syncthreads();
}

typedef unsigned u32x2 __attribute__((ext_vector_type(2)));
__device__ __forceinline__ float bf2f(unsigned b) { return __builtin_bit_cast(float, b << 16); }
__device__ __forceinline__ float wave_sum(float v) {
#pragma unroll
    for (int o = 1; o < 64; o <<= 1) v += __shfl_xor(v, o);
    return v;
}
__device__ __forceinline__ float wave_max(float v) {
#pragma unroll
    for (int o = 1; o < 64; o <<= 1) v = fmaxf(v, __shfl_xor(v, o));
    return v;
}
__device__ __forceinline__ float sigmoidf_(float x) { return 1.0f / (1.0f + __expf(-x)); }
__device__ __forceinline__ float siluf_(float x) { return x / (1.0f + __expf(-x)); }

namespace pg8 {
struct EpiH {
    static constexpr bool PERM = true, AFTER_DRAIN = false;
    bf16_t* H; const float* bgate; float* out;
    __device__ __forceinline__ void operator()(const f32x4 (&acc)[2][2][4][2], const Unit& u, int wr, int wc, int fr, int fq) const {
        const int pn = u.pn;
        const int row0 = u.pm * BM + wr * 64 + fr, cw = wc * 32 + 8 * fq;
        const int mode = (pn >= 29) ? 2 : ((pn == 7 || pn == 8 || pn == 27 || pn == 28) ? 1 : 0);
        const bool is_zs = pn <= 6, is_kv = (pn >= 15 && pn <= 26);
        int kvsel = 0, g = 0, hcb = 0;
        if (is_kv) { int q = pn - 15; kvsel = q >= 6 ? 1 : 0; q = q >= 6 ? q - 6 : q; g = q >> 1; hcb = (q & 1) * 256; }
        const int keep = 128 << (2 * g);
        float* kvp = out + (g == 0 ? O_KV1P : (g == 1 ? O_KV2P : O_KV3P));
        float* kvs = out + (g == 0 ? O_KV1S : (g == 1 ? O_KV2S : O_KV3S));
        f32x4 bv[2][2];
#pragma unroll
        for (int bj = 0; bj < 2; ++bj)
#pragma unroll
            for (int n = 0; n < 2; ++n) bv[bj][n] = (mode == 2) ? *(const f32x4*)(bgate + (pn * BM + bj * HALF + cw - C_GR) + 4 * n) : (f32x4){0.f, 0.f, 0.f, 0.f};
#pragma unroll
        for (int ai = 0; ai < 2; ++ai)
#pragma unroll
            for (int m = 0; m < 4; ++m) {
                const int row = row0 + ai * HALF + m * 16;
                bf16_t* rowp = H + (size_t)row * NH + pn * BM + cw;
#pragma unroll
                for (int bj = 0; bj < 2; ++bj) {
                    f32x4 v0 = acc[ai][bj][m][0], v1 = acc[ai][bj][m][1];
                    const int col = pn * BM + bj * HALF + cw;
                    if (is_zs && col < SHIFTC) {
                        float* dst = nullptr;
                        if (row < MP) { if ((row & (SEQ - 1)) == SEQ - 1) dst = out + O_SHP + (size_t)(row >> 13) * SHIFTC + col; }
                        else if (((row - MP) & 3) == 3) dst = out + O_SHS + (size_t)((row - MP) >> 2) * SHIFTC + col;
                        if (dst) { *(f32x4*)dst = v0; *(f32x4*)(dst + 4) = v1; }
                    }
                    if (is_kv) {
                        const int hc = hcb + bj * HALF + cw;
                        float* dst = nullptr;
                        if (row < MP) { const int t = row & (SEQ - 1), b = row >> 13; if (t >= SEQ - keep) dst = kvp + ((size_t)(b * keep + t - (SEQ - keep)) * 2 + kvsel) * 512 + hc; }
                        else dst = kvs + ((size_t)(row - MP) * 2 + kvsel) * 512 + hc;
                        if (dst) { *(f32x4*)dst = v0; *(f32x4*)(dst + 4) = v1; }
                    }
                    if (mode == 1) {
#pragma unroll
                        for (int j = 0; j < 4; ++j) { v0[j] = siluf_(v0[j]); v1[j] = siluf_(v1[j]); }
                    } else if (mode == 2) {
                        v0 = v0 + bv[bj][0]; v1 = v1 + bv[bj][1];
#pragma unroll
                        for (int j = 0; j < 4; ++j) { v0[j] = sigmoidf_(v0[j]); v1[j] = sigmoidf_(v1[j]); }
                    }
                    u32x4 w; w.x = cvt_pk_bf16(v0[0], v0[1]); w.y = cvt_pk_bf16(v0[2], v0[3]); w.z = cvt_pk_bf16(v1[0], v1[1]); w.w = cvt_pk_bf16(v1[2], v1[3]);
                    *(u32x4*)(rowp + bj * HALF) = w;
                }
            }
    }
};
struct EpiMixA {
    static constexpr bool PERM = false, AFTER_DRAIN = false;
    const bf16_t* H; float* MIXF;
    __device__ __forceinline__ void operator()(const f32x4 (&acc)[2][2][4][2], const Unit& u, int wr, int wc, int fr, int fq) const {
        const int row0 = u.pm * BM + wr * 64 + fr, col0 = u.pn * BM + wc * 32 + 4 * fq;
#pragma unroll
        for (int ai = 0; ai < 2; ++ai)
#pragma unroll
            for (int m = 0; m < 4; ++m) { const int row = row0 + ai * HALF + m * 16;
#pragma unroll
                for (int bj = 0; bj < 2; ++bj)
#pragma unroll
                    for (int n = 0; n < 2; ++n) { const int c = col0 + bj * HALF + n * 16;
                        const u32x2 gb = *(const u32x2*)(H + (size_t)row * NH + C_GR + c);
                        f32x4 gt = {bf2f(gb.x & 0xffffu), bf2f(gb.x >> 16), bf2f(gb.y & 0xffffu), bf2f(gb.y >> 16)};
                        *(f32x4*)(MIXF + (size_t)row * DM + c) = gt * acc[ai][bj][m][n]; } }
    }
};
struct EpiMixB {
    static constexpr bool PERM = false, AFTER_DRAIN = false;
    const bf16_t* H; const float* MIXF; bf16_t* MIX;
    __device__ __forceinline__ void operator()(const f32x4 (&acc)[2][2][4][2], const Unit& u, int wr, int wc, int fr, int fq) const {
        const int row0 = u.pm * BM + wr * 64 + fr, col0 = u.pn * BM + wc * 32 + 4 * fq;
#pragma unroll
        for (int ai = 0; ai < 2; ++ai)
#pragma unroll
            for (int m = 0; m < 4; ++m) { const int row = row0 + ai * HALF + m * 16;
#pragma unroll
                for (int bj = 0; bj < 2; ++bj)
#pragma unroll
                    for (int n = 0; n < 2; ++n) { const int c = col0 + bj * HALF + n * 16;
                        const u32x2 gb = *(const u32x2*)(H + (size_t)row * NH + C_GA + c);
                        f32x4 gt = {bf2f(gb.x & 0xffffu), bf2f(gb.x >> 16), bf2f(gb.y & 0xffffu), bf2f(gb.y >> 16)};
                        const f32x4 v = *(const f32x4*)(MIXF + (size_t)row * DM + c) + gt * acc[ai][bj][m][n];
                        u32x2 w; w.x = cvt_pk_bf16(v[0], v[1]); w.y = cvt_pk_bf16(v[2], v[3]);
                        *(u32x2*)(MIX + (size_t)row * DM + c) = w; } }
    }
};
struct EpiPre {
    static constexpr bool PERM = false, AFTER_DRAIN = false;
    const float* xp; const float* xs; float* PRE;
    __device__ __forceinline__ void operator()(const f32x4 (&acc)[2][2][4][2], const Unit& u, int wr, int wc, int fr, int fq) const {
        const int row0 = u.pm * BM + wr * 64 + fr, col0 = u.pn * BM + wc * 32 + 4 * fq;
#pragma unroll
        for (int ai = 0; ai < 2; ++ai)
#pragma unroll
            for (int m = 0; m < 4; ++m) { const int row = row0 + ai * HALF + m * 16;
                const float* xr = row < MP ? xp + (size_t)row * DM : xs + (size_t)(row - MP) * DM;
#pragma unroll
                for (int bj = 0; bj < 2; ++bj)
#pragma unroll
                    for (int n = 0; n < 2; ++n) { const int c = col0 + bj * HALF + n * 16;
                        *(f32x4*)(PRE + (size_t)row * DM + c) = *(const f32x4*)(xr + c) * ALPHA + acc[ai][bj][m][n]; } }
    }
};
}

struct Args { const float* in[24]; float* out; unsigned char* ws; int ph_lo, ph_hi; };
struct Frame {
    LAS unsigned char* lds;
    volatile LAS unsigned* MISC;
    gu32* ctl;
    int tid, lane, wave, G;
};
#define XP_(A) ((A).in[0])
#define XS_(A) ((A).in[1])
#define C1_(A) ((A).in[2])
#define C2_(A) ((A).in[3])
#define C3_(A) ((A).in[4])
#define WKV0_(A) ((A).in[5])
#define SHIFT0_(A) ((A).in[6])
#define W_IN_(A) ((A).in[7])
#define B_GATE_(A) ((A).in[8])
#define MU_(A) ((A).in[9])
#define W0_(A) ((A).in[10])
#define W_W2_(A) ((A).in[11])
#define A0_(A) ((A).in[12])
#define W_A2_(A) ((A).in[13])
#define K_K_(A) ((A).in[14])
#define K_A_(A) ((A).in[15])
#define R_K_(A) ((A).in[16])
#define LNX_G_(A) ((A).in[17])
#define LNX_B_(A) ((A).in[18])
#define W_OA_(A) ((A).in[19])
#define W_OB_(A) ((A).in[20])
#define W_OUT_(A) ((A).in[21])
#define LN_G_(A) ((A).in[22])
#define LN_B_(A) ((A).in[23])
#define WSB_(A, off) ((bf16*)((A).ws + (off)))
#define WSF_(A, off) ((float*)((A).ws + (off)))

__device__ __forceinline__ void p0_transpose_item(const float* W, int K, int N, bf16* WT, int split_at, int split_add, LAS float* scr, int item, int lane) {
    const int nblk = N / 32, kb = item / nblk, nb = item % nblk, k0 = 64 * kb, n0 = 32 * nb;
    const int radd = n0 >= split_at ? split_add : 0;
#pragma unroll 8
    for (int i = 0; i < 32; ++i) { const int kk = 2 * i + (lane >> 5); scr[kk * 33 + (lane & 31)] = W[(size_t)(k0 + kk) * N + n0 + (lane & 31)]; }
    LDS_WAIT(); asm volatile("" ::: "memory");
    const int c = lane & 7;
#pragma unroll
    for (int j = 0; j < 4; ++j) { const int n = (lane >> 3) + 8 * j; const LAS float* s = scr + (8 * c) * 33 + n;
        v4u o; o.x = pk2(s[0 * 33], s[1 * 33]); o.y = pk2(s[2 * 33], s[3 * 33]); o.z = pk2(s[4 * 33], s[5 * 33]); o.w = pk2(s[6 * 33], s[7 * 33]);
        *(GAS v4u*)(WT + (size_t)(radd + n0 + n) * K + k0 + 8 * c) = o; }
    LDS_WAIT(); asm volatile("" ::: "memory");
}
__device__ __forceinline__ void p0_prologue(Frame& F, const Args& A) {
    LAS float* scr = (LAS float*)(F.lds + RING_OFF + F.wave * 16384);
    const int gw = blockIdx.x * NWAVES + F.wave, NGW = F.G * NWAVES;
    constexpr int I_IN = (DM / 64) * (NIN / 32), I_OA = (RW / 64) * (DM / 32), I_OUT = (DM / 64) * (DM / 32);
    constexpr int I_LR = (RW / 32);
    constexpr int NITEMS = I_IN + 2 * I_OA + I_OUT + 2 * I_LR;
    for (int it = gw; it < NITEMS; it += NGW) {
        int r = it;
        if (r < I_IN) { p0_transpose_item(W_IN_(A), DM, NIN, WSB_(A, WS_WIN), SHIFTC, 128, scr, r, F.lane); continue; } r -= I_IN;
        if (r < I_OA) { p0_transpose_item(W_OA_(A), RW, DM, WSB_(A, WS_WOA), 1 << 30, 0, scr, r, F.lane); continue; } r -= I_OA;
        if (r < I_OA) { p0_transpose_item(W_OB_(A), RW, DM, WSB_(A, WS_WOB), 1 << 30, 0, scr, r, F.lane); continue; } r -= I_OA;
        if (r < I_OUT) { p0_transpose_item(W_OUT_(A), DM, DM, WSB_(A, WS_WOUT), 1 << 30, 0, scr, r, F.lane); continue; } r -= I_OUT;
        if (r < I_LR) { p0_transpose_item(W_W2_(A), 64, RW, WSB_(A, WS_W2T), 1 << 30, 0, scr, r, F.lane); continue; } r -= I_LR;
        p0_transpose_item(W_A2_(A), 64, RW, WSB_(A, WS_A2T), 1 << 30, 0, scr, r, F.lane);
    }
    const size_t gt = (size_t)blockIdx.x * 512 + F.tid, GT = (size_t)F.G * 512;
    for (size_t i = gt; i < (size_t)128 * DM / 8; i += GT) *(GAS v4u*)(WSB_(A, WS_WIN) + (size_t)SHIFTC * DM + i * 8) = (v4u){0u, 0u, 0u, 0u};
    for (size_t i = gt; i < (size_t)M * DM / 8; i += GT) {
        const size_t e = i * 8; const float* src = e < (size_t)MP * DM ? XP_(A) + e : XS_(A) + (e - (size_t)MP * DM);
        const f32x4 a = *(const GAS f32x4*)src, b = *(const GAS f32x4*)(src + 4);
        v4u o; o.x = pk2(a.x, a.y); o.y = pk2(a.z, a.w); o.z = pk2(b.x, b.y); o.w = pk2(b.z, b.w);
        *(GAS v4u*)(WSB_(A, WS_XB) + e) = o;
    }
}

__device__ __forceinline__ void ld8bf(const bf16* p, float (&v)[8]) {
    const v4u w = *(const GAS v4u*)p;
    v[0] = bf2f(w.x & 0xffffu); v[1] = bf2f(w.x >> 16); v[2] = bf2f(w.y & 0xffffu); v[3] = bf2f(w.y >> 16);
    v[4] = bf2f(w.z & 0xffffu); v[5] = bf2f(w.z >> 16); v[6] = bf2f(w.w & 0xffffu); v[7] = bf2f(w.w >> 16);
}
__device__ __forceinline__ void ld8f(const float* p, float (&v)[8]) {
    const f32x4 a = *(const GAS f32x4*)p, b = *(const GAS f32x4*)(p + 4);
    v[0] = a.x; v[1] = a.y; v[2] = a.z; v[3] = a.w; v[4] = b.x; v[5] = b.y; v[6] = b.z; v[7] = b.w;
}
__device__ __forceinline__ void st8f(float* p, const float (&v)[8]) {
    *(GAS f32x4*)p = (f32x4){v[0], v[1], v[2], v[3]}; *(GAS f32x4*)(p + 4) = (f32x4){v[4], v[5], v[6], v[7]};
}
__device__ __forceinline__ void mixed8(Frame& F, const Args& A, int m, int c0, float (&z)[8]) {
    ld8bf(WSB_(A, WS_H) + (size_t)m * NH + c0, z);
    float p[8], mu[8];
    bool first; int sb = 0;
    if (m < MP) first = (m & (SEQ - 1)) == 0; else { first = ((m - MP) & 3) == 0; sb = (m - MP) >> 2; }
    if (!first) ld8bf(WSB_(A, WS_H) + (size_t)(m - 1) * NH + c0, p);
    else if (m < MP) {
#pragma unroll
        for (int j = 0; j < 8; ++j) p[j] = 0.f;
    } else ld8f(SHIFT0_(A) + (size_t)sb * SHIFTC + c0, p);
    ld8f(MU_(A) + c0, mu);
#pragma unroll
    for (int j = 0; j < 8; ++j) z[j] = z[j] + mu[j] * (p[j] - z[j]);
}
__device__ __forceinline__ void rwkv_prep_row(Frame& F, const Args& A, int m) {
    const int lane = F.lane, c0 = lane * 8;
    float r[8], k[8], v[8];
    mixed8(F, A, m, C_R + c0, r); mixed8(F, A, m, C_K + c0, k); mixed8(F, A, m, C_V + c0, v);
    float wa8[8];
#pragma unroll
    for (int j = 0; j < 8; ++j) wa8[j] = 0.f;
    if (lane < 16) mixed8(F, A, m, C_WD + c0, wa8);
    float wdl = 0.f, adl = 0.f;
#pragma unroll
    for (int j = 0; j < 8; ++j) { const float a = __shfl(wa8[j], lane >> 3), b = __shfl(wa8[j], 8 + (lane >> 3)); if ((lane & 7) == j) { wdl = a; adl = b; } }
    wdl = tanhf(wdl);
    float wp[8], ap[8];
#pragma unroll
    for (int j = 0; j < 8; ++j) { wp[j] = 0.f; ap[j] = 0.f; }
    for (int j = 0; j < 64; ++j) {
        const float tw = __shfl(wdl, j), ta = __shfl(adl, j);
        float w2[8], a2[8]; ld8f(W_W2_(A) + (size_t)j * RW + c0, w2); ld8f(W_A2_(A) + (size_t)j * RW + c0, a2);
#pragma unroll
        for (int q = 0; q < 8; ++q) { wp[q] += tw * w2[q]; ap[q] += ta * a2[q]; }
    }
    float w0[8], a0[8], kkc[8], kac[8];
    ld8f(W0_(A) + c0, w0); ld8f(A0_(A) + c0, a0); ld8f(K_K_(A) + c0, kkc); ld8f(K_A_(A) + c0, kac);
    float dec[8], kk[8], ka[8], k2[8]; float ss = 0.f;
#pragma unroll
    for (int j = 0; j < 8; ++j) {
        const float x = -(w0[j] + wp[j]);
        const float sp = fmaxf(x, 0.f) + log1pf(__expf(-fabsf(x)));
        const float w = -sp - 0.5f;
        dec[j] = __expf(-__expf(w));
        const float a = sigmoidf_(a0[j] + ap[j]);
        kk[j] = k[j] * kkc[j]; ss += kk[j] * kk[j];
        k2[j] = k[j] * (1.0f + (a - 1.0f) * kac[j]);
        ka[j] = a;
    }
    ss += __shfl_xor(ss, 1); ss += __shfl_xor(ss, 2); ss += __shfl_xor(ss, 4);
    const float inv = 1.0f / fmaxf(sqrtf(ss), 1e-12f);
#pragma unroll
    for (int j = 0; j < 8; ++j) { kk[j] *= inv; ka[j] *= kk[j]; }
    const size_t o = (size_t)m * RW + c0;
    st8f(WSF_(A, WS_RR) + o, r); st8f(WSF_(A, WS_DEC) + o, dec); st8f(WSF_(A, WS_K2) + o, k2); st8f(WSF_(A, WS_VV) + o, v); st8f(WSF_(A, WS_KK) + o, kk); st8f(WSF_(A, WS_KA) + o, ka);
}

template <bool PROMPT>
__device__ __forceinline__ void attn_item(Frame& F, const Args& A, int m, int h, LAS float* sq, LAS float* sp) {
    const int lane = F.lane;
    int b, t; if (PROMPT) { b = m >> 13; t = m & (SEQ - 1); } else { b = (m - MP) >> 2; t = (m - MP) & 3; }
    float og[3][2], lse[3];
#pragma unroll
    for (int g = 0; g < 3; ++g) {
        const int d = 1 << (2 * g), Wb = 128 << (2 * g);
        const float* cache = g == 0 ? C1_(A) : (g == 1 ? C2_(A) : C3_(A));
        const int hoff = g * 512 + h * 128;
        { const unsigned qq = *(const GAS unsigned*)(WSB_(A, WS_H) + (size_t)m * NH + C_AQ + hoff + 2 * lane); sq[2 * lane] = bf2f(qq & 0xffffu); sq[2 * lane + 1] = bf2f(qq >> 16); }
        LDS_WAIT(); asm volatile("" ::: "memory");
        float s[3];
#pragma unroll
        for (int kx = 0; kx < 3; ++kx) {
            const int j = lane + 64 * kx; float sc = -1e30f;
            if (kx < 2 || lane == 0) {
                const bf16* kr = nullptr; const float* kf = nullptr;
                if (PROMPT) { const int tk = t - j * d; if (tk >= 0) kr = WSB_(A, WS_H) + (size_t)(b * SEQ + tk) * NH + C_AK + hoff; }
                else { const int idx = Wb + t - j * d; if (idx >= Wb) kr = WSB_(A, WS_H) + (size_t)(MP + b * DSEQ + idx - Wb) * NH + C_AK + hoff; else kf = cache + ((size_t)(b * Wb + idx) * 2 + 0) * 512 + h * 128; }
                if (kr) { float a = 0.f;
                    for (int e = 0; e < 128; e += 8) { float kv[8]; ld8bf(kr + e, kv);
#pragma unroll
                        for (int q = 0; q < 8; ++q) a += sq[e + q] * kv[q]; }
                    sc = a * ATT_SCALE; }
                else if (kf) { float a = 0.f;
                    for (int e = 0; e < 128; e += 8) { float kv[8]; ld8f(kf + e, kv);
#pragma unroll
                        for (int q = 0; q < 8; ++q) a += sq[e + q] * kv[q]; }
                    sc = a * ATT_SCALE; }
            }
            s[kx] = sc;
        }
        const float mx = wave_max(fmaxf(fmaxf(s[0], s[1]), s[2]));
        float p[3]; float ls = 0.f;
#pragma unroll
        for (int kx = 0; kx < 3; ++kx) { p[kx] = s[kx] > -1e29f ? __expf(s[kx] - mx) : 0.f; ls += p[kx]; }
        const float l = wave_sum(ls);
        sp[lane] = p[0]; sp[lane + 64] = p[1]; if (lane == 0) sp[128] = p[2];
        LDS_WAIT(); asm volatile("" ::: "memory");
        float a0 = 0.f, a1 = 0.f;
        for (int j = 0; j < 129; ++j) {
            const float pj = sp[j];
            if (PROMPT) { const int tk = t - j * d; if (tk >= 0) { const unsigned vv = *(const GAS unsigned*)(WSB_(A, WS_H) + (size_t)(b * SEQ + tk) * NH + C_AV + hoff + 2 * lane); a0 += pj * bf2f(vv & 0xffffu); a1 += pj * bf2f(vv >> 16); } }
            else { const int idx = Wb + t - j * d;
                if (idx >= Wb) { const unsigned vv = *(const GAS unsigned*)(WSB_(A, WS_H) + (size_t)(MP + b * DSEQ + idx - Wb) * NH + C_AV + hoff + 2 * lane); a0 += pj * bf2f(vv & 0xffffu); a1 += pj * bf2f(vv >> 16); }
                else { const float* vf = cache + ((size_t)(b * Wb + idx) * 2 + 1) * 512 + h * 128 + 2 * lane; a0 += pj * vf[0]; a1 += pj * vf[1]; } }
        }
        const float il = 1.0f / l;
        og[g][0] = a0 * il; og[g][1] = a1 * il; lse[g] = mx + __logf(l);
        LDS_WAIT(); asm volatile("" ::: "memory");
    }
    const float ml = fmaxf(fmaxf(lse[0], lse[1]), lse[2]);
    const float w0 = __expf(lse[0] - ml), w1 = __expf(lse[1] - ml), w2 = __expf(lse[2] - ml), iw = 1.0f / (w0 + w1 + w2);
    const unsigned zz = *(const GAS unsigned*)(WSB_(A, WS_H) + (size_t)m * NH + C_ZA + h * 128 + 2 * lane);
    const float y0 = (w0 * og[0][0] + w1 * og[1][0] + w2 * og[2][0]) * iw * bf2f(zz & 0xffffu);
    const float y1 = (w0 * og[0][1] + w1 * og[1][1] + w2 * og[2][1]) * iw * bf2f(zz >> 16);
    *(GAS unsigned*)(WSB_(A, WS_YA) + (size_t)m * RW + h * 128 + 2 * lane) = pk2(y0, y1);
}

__device__ __forceinline__ void scan_item(Frame& F, const Args& A, int item) {
    const int lane = F.lane;
    int T, row0, h; float* sout; const float* s0 = nullptr;
    if (item < 16) { const int b = item >> 3; h = item & 7; T = SEQ; row0 = b * SEQ; sout = A.out + O_WKVP + ((size_t)(b * 8 + h) * 64 + lane) * 64; }
    else { const int s = item - 16, b = s >> 3; h = s & 7; T = DSEQ; row0 = MP + b * DSEQ; sout = A.out + O_WKVS + ((size_t)(b * 8 + h) * 64 + lane) * 64; s0 = WKV0_(A) + ((size_t)(b * 8 + h) * 64 + lane) * 64; }
    float S[64];
#pragma unroll
    for (int k = 0; k < 64; k += 4) { f32x4 v = s0 ? *(const GAS f32x4*)(s0 + k) : (f32x4){0.f, 0.f, 0.f, 0.f}; S[k] = v.x; S[k + 1] = v.y; S[k + 2] = v.z; S[k + 3] = v.w; }
    for (int t = 0; t < T; ++t) {
        const size_t base = (size_t)(row0 + t) * RW + h * 64;
        const float vi = WSF_(A, WS_VV)[base + lane];
        float sa = 0.f;
#pragma unroll
        for (int k = 0; k < 64; k += 4) { const f32x4 q = *(const GAS f32x4*)(WSF_(A, WS_KK) + base + k); sa -= S[k] * q.x; sa -= S[k + 1] * q.y; sa -= S[k + 2] * q.z; sa -= S[k + 3] * q.w; if ((k & 15) == 12) asm volatile("" ::: "memory"); }
        float o = 0.f;
#pragma unroll
        for (int k = 0; k < 64; k += 4) {
            const f32x4 dc = *(const GAS f32x4*)(WSF_(A, WS_DEC) + base + k), ka = *(const GAS f32x4*)(WSF_(A, WS_KA) + base + k), k2 = *(const GAS f32x4*)(WSF_(A, WS_K2) + base + k), rr = *(const GAS f32x4*)(WSF_(A, WS_RR) + base + k);
            S[k] = S[k] * dc.x + sa * ka.x + vi * k2.x; S[k + 1] = S[k + 1] * dc.y + sa * ka.y + vi * k2.y; S[k + 2] = S[k + 2] * dc.z + sa * ka.z + vi * k2.z; S[k + 3] = S[k + 3] * dc.w + sa * ka.w + vi * k2.w;
            o += S[k] * rr.x; o += S[k + 1] * rr.y; o += S[k + 2] * rr.z; o += S[k + 3] * rr.w;
            if ((k & 7) == 4) asm volatile("" ::: "memory");
        }
        WSF_(A, WS_OO)[base + lane] = o;
    }
#pragma unroll
    for (int k = 0; k < 64; k += 4) *(GAS f32x4*)(sout + k) = (f32x4){S[k], S[k + 1], S[k + 2], S[k + 3]};
}

__device__ __forceinline__ void rwkv_post_row(Frame& F, const Args& A, int m) {
    const int lane = F.lane, c0 = lane * 8; const size_t o = (size_t)m * RW + c0;
    float ov[8], r[8], k2[8], v[8], rk[8], g[8], bb[8], z[8];
    ld8f(WSF_(A, WS_OO) + o, ov); ld8f(WSF_(A, WS_RR) + o, r); ld8f(WSF_(A, WS_K2) + o, k2); ld8f(WSF_(A, WS_VV) + o, v); ld8f(R_K_(A) + c0, rk); ld8f(LNX_G_(A) + c0, g); ld8f(LNX_B_(A) + c0, bb);
    ld8bf(WSB_(A, WS_H) + (size_t)m * NH + C_ZR + c0, z);
    float s = 0.f, bs = 0.f;
#pragma unroll
    for (int j = 0; j < 8; ++j) { s += ov[j]; bs += r[j] * k2[j] * rk[j]; }
    s += __shfl_xor(s, 1); s += __shfl_xor(s, 2); s += __shfl_xor(s, 4);
    bs += __shfl_xor(bs, 1); bs += __shfl_xor(bs, 2); bs += __shfl_xor(bs, 4);
    const float mean = s * (1.0f / 64.0f); float q = 0.f;
#pragma unroll
    for (int j = 0; j < 8; ++j) { const float dlt = ov[j] - mean; q += dlt * dlt; }
    q += __shfl_xor(q, 1); q += __shfl_xor(q, 2); q += __shfl_xor(q, 4);
    const float rstd = 1.0f / sqrtf(q * (1.0f / 64.0f) + GN_EPS);
    float y[8];
#pragma unroll
    for (int j = 0; j < 8; ++j) y[j] = ((ov[j] - mean) * rstd * g[j] + bb[j] + bs * v[j]) * z[j];
    v4u w; w.x = pk2(y[0], y[1]); w.y = pk2(y[2], y[3]); w.z = pk2(y[4], y[5]); w.w = pk2(y[6], y[7]);
    *(GAS v4u*)(WSB_(A, WS_YR) + o) = w;
}

typedef short s16x4 __attribute__((ext_vector_type(4)));
typedef short v4i16_t __attribute__((ext_vector_type(4)));
constexpr int LDP = 72;
constexpr int ARRB = 64 * LDP * 2;
enum { A_AT = 0, A_BH, A_KH, A_RT, A_VQ, A_XA, A_XB, A_TA, A_TB, A_MAK, A_MRB, A_MRK, A_NARR };
constexpr int A_SMALL = A_NARR * ARRB;
static_assert(A_SMALL + 4096 <= RING_BYTES, "phase A LDS");
constexpr int NUNITS = 16 * 128;

__device__ __forceinline__ f32x4 mfma16(bf16x8 a, bf16x8 b, f32x4 c) { return __builtin_amdgcn_mfma_f32_16x16x32_bf16(a, b, c, 0, 0, 0); }
__device__ __forceinline__ bf16x8 frag_rows(const LAS bf16* X, int row0, int k0, int lane) { return *(const LAS bf16x8*)(X + (row0 + (lane & 15)) * LDP + k0 + 8 * (lane >> 4)); }
__device__ __forceinline__ bf16x8 frag_tr(const LAS bf16* X, int k0, int col0, int lane) {
    const int g = lane >> 4, i = lane & 15;
    const LAS bf16* a0 = X + (k0 + 8 * g + (i >> 2)) * LDP + col0 + 4 * (i & 3);
    const s16x4 lo = __builtin_bit_cast(s16x4, __builtin_amdgcn_ds_read_tr16_b64_v4i16((LAS v4i16_t*)a0));
    const s16x4 hi = __builtin_bit_cast(s16x4, __builtin_amdgcn_ds_read_tr16_b64_v4i16((LAS v4i16_t*)(a0 + 4 * LDP)));
    return __builtin_shufflevector(lo, hi, 0, 1, 2, 3, 4, 5, 6, 7);
}
__device__ __forceinline__ u32x2 pk4(f32x4 v) { u32x2 w; w.x = pk2(v[0], v[1]); w.y = pk2(v[2], v[3]); return w; }
__device__ __forceinline__ f32x4 up4(u32x2 w) { return (f32x4){bf2f(w.x & 0xffffu), bf2f(w.x >> 16), bf2f(w.y & 0xffffu), bf2f(w.y >> 16)}; }
__device__ __forceinline__ void st4(LAS bf16* X, int row, int col, f32x4 v) { *(LAS u32x2*)(X + row * LDP + col) = pk4(v); }
__device__ __forceinline__ f32x4 ld4(const LAS bf16* X, int row, int col) { return up4(*(const LAS u32x2*)(X + row * LDP + col)); }
__device__ __forceinline__ float dpp_shr(float x, int n) {
    const int iv = __builtin_bit_cast(int, x); int r;
    switch (n) { case 1: r = __builtin_amdgcn_update_dpp(0, iv, 0x111, 0xf, 0xf, true); break; case 2: r = __builtin_amdgcn_update_dpp(0, iv, 0x112, 0xf, 0xf, true); break;
                 case 4: r = __builtin_amdgcn_update_dpp(0, iv, 0x114, 0xf, 0xf, true); break; default: r = __builtin_amdgcn_update_dpp(0, iv, 0x118, 0xf, 0xf, true); break; }
    return __builtin_bit_cast(float, r);
}
__device__ __forceinline__ float row_scan(float x) { x += dpp_shr(x, 1); x += dpp_shr(x, 2); x += dpp_shr(x, 4); x += dpp_shr(x, 8); return x; }
__device__ __forceinline__ f32x4 mixed4(const bf16* H, const float* mu, int m, int col, bool first) {
    const f32x4 z = up4(*(const GAS u32x2*)(H + (size_t)m * NH + col));
    f32x4 p = {0.f, 0.f, 0.f, 0.f};
    if (!first) p = up4(*(const GAS u32x2*)(H + (size_t)(m - 1) * NH + col));
    const f32x4 mv = *(const GAS f32x4*)(mu + col);
    return z + mv * (p - z);
}
__device__ __forceinline__ void pq2(const LAS bf16* P, const LAS bf16* Q, int tt, int hf, int lane, f32x4 (&acc)[2]) {
#pragma unroll
    for (int ks = 0; ks < 2; ++ks) { const bf16x8 bp = frag_rows(P, 16 * tt, 32 * ks, lane);
#pragma unroll
        for (int j = 0; j < 2; ++j) acc[j] = mfma16(frag_tr(Q, 32 * ks, 16 * (2 * hf + j), lane), bp, acc[j]); }
}
#define WG_BAR() do { asm volatile("s_waitcnt vmcnt(0) lgkmcnt(0)" ::: "memory"); __builtin_amdgcn_s_barrier(); asm volatile("" ::: "memory"); } while (0)

__device__ __forceinline__ void rwkvA_unit(Frame& F, const Args& A, int unit) {
    const int lane = F.lane, w = F.wave, tt = w & 3, hf = w >> 2, i = lane & 15, g = lane >> 4;
    const int bh = unit >> 7, c = unit & 127, b = bh >> 3, h = bh & 7;
    const int t = 16 * tt + i, m = b * SEQ + c * 64 + t;
    const bool first = (c == 0) && (t == 0);
    LAS unsigned char* L = F.lds + RING_OFF;
#define ARR(k) ((LAS bf16*)(L + (k) * ARRB))
    LAS float* tot = (LAS float*)(L + A_SMALL); LAS float* gcl = tot + 256; LAS float* pss = gcl + 64; LAS float* pbn = pss + 128;
    const bf16* H = WSB_(A, WS_H);
    const float z4[4] = {0.f, 0.f, 0.f, 0.f}; (void)z4;
    f32x4 rv[2], kv[2], vv[2];
#pragma unroll
    for (int j = 0; j < 2; ++j) { const int cb = 16 * (2 * hf + j) + 4 * g;
        rv[j] = mixed4(H, MU_(A), m, C_R + h * 64 + cb, first); kv[j] = mixed4(H, MU_(A), m, C_K + h * 64 + cb, first); vv[j] = mixed4(H, MU_(A), m, C_V + h * 64 + cb, first);
        f32x4 wd = mixed4(H, MU_(A), m, C_WD + cb, first); const f32x4 ad = mixed4(H, MU_(A), m, C_AD + cb, first);
#pragma unroll
        for (int r = 0; r < 4; ++r) wd[r] = tanhf(wd[r]);
        st4(ARR(A_XA), t, cb, wd); st4(ARR(A_XB), t, cb, ad); }
    WG_BAR();
    f32x4 aw[2] = {{0.f, 0.f, 0.f, 0.f}, {0.f, 0.f, 0.f, 0.f}}, aa[2] = {{0.f, 0.f, 0.f, 0.f}, {0.f, 0.f, 0.f, 0.f}};
#pragma unroll
    for (int ks = 0; ks < 2; ++ks) { const bf16x8 btw = frag_rows(ARR(A_XA), 16 * tt, 32 * ks, lane), bad = frag_rows(ARR(A_XB), 16 * tt, 32 * ks, lane);
#pragma unroll
        for (int j = 0; j < 2; ++j) { const size_t wo = (size_t)(h * 64 + 16 * (2 * hf + j) + i) * 64 + 32 * ks + 8 * g;
            const bf16x8 a_w = *(const GAS bf16x8*)(WSB_(A, WS_W2T) + wo), a_a = *(const GAS bf16x8*)(WSB_(A, WS_A2T) + wo);
            aw[j] = mfma16(a_w, btw, aw[j]); aa[j] = mfma16(a_a, bad, aa[j]); } }
    f32x4 ld[2], av[2], kkr[2], k2[2], cum[2]; float ssq = 0.f, bon = 0.f;
#pragma unroll
    for (int j = 0; j < 2; ++j) { const int hc = h * 64 + 16 * (2 * hf + j) + 4 * g;
        const f32x4 w0 = *(const GAS f32x4*)(W0_(A) + hc), a0 = *(const GAS f32x4*)(A0_(A) + hc), kkc = *(const GAS f32x4*)(K_K_(A) + hc), kac = *(const GAS f32x4*)(K_A_(A) + hc), rkc = *(const GAS f32x4*)(R_K_(A) + hc);
#pragma unroll
        for (int r = 0; r < 4; ++r) {
            const float x = -(w0[r] + aw[j][r]); const float sp = fmaxf(x, 0.f) + log1pf(__expf(-fabsf(x)));
            ld[j][r] = -__expf(-sp - 0.5f);
            const float a = sigmoidf_(a0[r] + aa[j][r]); av[j][r] = a;
            kkr[j][r] = kv[j][r] * kkc[r]; ssq += kkr[j][r] * kkr[j][r];
            k2[j][r] = kv[j][r] * (1.0f + (a - 1.0f) * kac[r]);
            bon += rv[j][r] * k2[j][r] * rkc[r];
            cum[j][r] = row_scan(ld[j][r]);
        }
        if (i == 15) *(LAS f32x4*)(tot + tt * 64 + 16 * (2 * hf + j) + 4 * g) = cum[j]; }
    ssq += __shfl_xor(ssq, 16); ssq += __shfl_xor(ssq, 32); bon += __shfl_xor(bon, 16); bon += __shfl_xor(bon, 32);
    if (g == 0) { pss[w * 16 + i] = ssq; pbn[w * 16 + i] = bon; }
    WG_BAR();
    ssq = pss[w * 16 + i] + pss[(w ^ 4) * 16 + i]; bon = pbn[w * 16 + i] + pbn[(w ^ 4) * 16 + i];
    const float inv = 1.0f / fmaxf(sqrtf(ssq), 1e-12f);
#pragma unroll
    for (int j = 0; j < 2; ++j) { const int cb = 16 * (2 * hf + j) + 4 * g;
        f32x4 off = {0.f, 0.f, 0.f, 0.f}, all = {0.f, 0.f, 0.f, 0.f};
#pragma unroll
        for (int q = 0; q < 4; ++q) { const f32x4 tq = *(const LAS f32x4*)(tot + q * 64 + cb); all = all + tq; if (q < tt) off = off + tq; }
        f32x4 at, bhv, khv, rt;
#pragma unroll
        for (int r = 0; r < 4; ++r) { const float cm = cum[j][r] + off[r]; const float ep = __expf(cm), em = __expf(-cm), epv = __expf(cm - ld[j][r]); const float kk = kkr[j][r] * inv;
            at[r] = -kk * epv; bhv[r] = kk * av[j][r] * em; khv[r] = k2[j][r] * em; rt[r] = rv[j][r] * ep; }
        st4(ARR(A_AT), t, cb, at); st4(ARR(A_BH), t, cb, bhv); st4(ARR(A_KH), t, cb, khv); st4(ARR(A_RT), t, cb, rt); st4(ARR(A_VQ), t, cb, vv[j]);
        *(GAS u32x2*)(WSB_(A, WS_VMX) + (size_t)m * RW + h * 64 + cb) = pk4(vv[j]);
        if (tt == 0 && i == 0) { f32x4 gc; for (int r = 0; r < 4; ++r) gc[r] = __expf(all[r]); *(LAS f32x4*)(gcl + cb) = gc; } }
    if (hf == 0 && g == 0) WSF_(A, WS_BON)[(size_t)m * 8 + h] = bon;
    WG_BAR();
#pragma unroll
    for (int j = 0; j < 2; ++j) { const int mt = 2 * hf + j;
        f32x4 ab = {0.f, 0.f, 0.f, 0.f}, ak = ab, rb = ab, rk = ab;
        if (mt <= tt) {
#pragma unroll
            for (int ks = 0; ks < 2; ++ks) { const bf16x8 abh = frag_rows(ARR(A_BH), 16 * mt, 32 * ks, lane), akh = frag_rows(ARR(A_KH), 16 * mt, 32 * ks, lane), bat = frag_rows(ARR(A_AT), 16 * tt, 32 * ks, lane), brt = frag_rows(ARR(A_RT), 16 * tt, 32 * ks, lane);
                ab = mfma16(abh, bat, ab); ak = mfma16(akh, bat, ak); rb = mfma16(abh, brt, rb); rk = mfma16(akh, brt, rk); } }
        f32x4 t1;
#pragma unroll
        for (int r = 0; r < 4; ++r) { const int s = 16 * mt + 4 * g + r; const bool lt = s < t, le = s <= t;
            ab[r] = lt ? ab[r] : 0.f; ak[r] = lt ? ak[r] : 0.f; rb[r] = le ? rb[r] : 0.f; rk[r] = le ? rk[r] : 0.f; t1[r] = ab[r] + (s == t ? 1.0f : 0.f); }
        const int cb = 16 * mt + 4 * g;
        st4(ARR(A_XA), t, cb, ab); st4(ARR(A_TA), t, cb, t1); st4(ARR(A_MAK), t, cb, ak); st4(ARR(A_MRB), t, cb, rb); st4(ARR(A_MRK), t, cb, rk); }
    WG_BAR();
    const int cb0 = 16 * (2 * hf) + 4 * g, cb1 = cb0 + 16;
#define SQ_STAGE(XC, XN) do { f32x4 z[2] = {{0.f, 0.f, 0.f, 0.f}, {0.f, 0.f, 0.f, 0.f}}; pq2(ARR(XC), ARR(XC), tt, hf, lane, z); st4(ARR(XN), t, cb0, z[0]); st4(ARR(XN), t, cb1, z[1]); } while (0)
#define T_STAGE(TC, TN, XC) do { f32x4 z[2]; z[0] = ld4(ARR(TC), t, cb0); z[1] = ld4(ARR(TC), t, cb1); pq2(ARR(TC), ARR(XC), tt, hf, lane, z); st4(ARR(TN), t, cb0, z[0]); st4(ARR(TN), t, cb1, z[1]); } while (0)
    SQ_STAGE(A_XA, A_XB); WG_BAR();
    SQ_STAGE(A_XB, A_XA); T_STAGE(A_TA, A_TB, A_XB); WG_BAR();
    SQ_STAGE(A_XA, A_XB); T_STAGE(A_TB, A_TA, A_XA); WG_BAR();
    SQ_STAGE(A_XB, A_XA); T_STAGE(A_TA, A_TB, A_XB); WG_BAR();
    SQ_STAGE(A_XA, A_XB); T_STAGE(A_TB, A_TA, A_XA); WG_BAR();
    T_STAGE(A_TA, A_TB, A_XB); WG_BAR();
    { f32x4 z[2] = {{0.f, 0.f, 0.f, 0.f}, {0.f, 0.f, 0.f, 0.f}}; pq2(ARR(A_TB), ARR(A_AT), tt, hf, lane, z); st4(ARR(A_XA), t, cb0, z[0]); st4(ARR(A_XA), t, cb1, z[1]); }
    { f32x4 z[2] = {{0.f, 0.f, 0.f, 0.f}, {0.f, 0.f, 0.f, 0.f}}; pq2(ARR(A_MAK), ARR(A_VQ), tt, hf, lane, z); st4(ARR(A_TA), t, cb0, z[0]); st4(ARR(A_TA), t, cb1, z[1]); }
    WG_BAR();
    { f32x4 z[2] = {{0.f, 0.f, 0.f, 0.f}, {0.f, 0.f, 0.f, 0.f}}; pq2(ARR(A_TB), ARR(A_TA), tt, hf, lane, z); st4(ARR(A_XB), t, cb0, z[0]); st4(ARR(A_XB), t, cb1, z[1]); }
    WG_BAR();
    { f32x4 z[2]; z[0] = ld4(ARR(A_RT), t, cb0); z[1] = ld4(ARR(A_RT), t, cb1); pq2(ARR(A_MRB), ARR(A_XA), tt, hf, lane, z);
      bf16* qe = WSB_(A, WS_QE) + ((size_t)unit * 64 + t) * 64; *(GAS u32x2*)(qe + cb0) = pk4(z[0]); *(GAS u32x2*)(qe + cb1) = pk4(z[1]); }
    { f32x4 z[2] = {{0.f, 0.f, 0.f, 0.f}, {0.f, 0.f, 0.f, 0.f}}; pq2(ARR(A_MRB), ARR(A_XB), tt, hf, lane, z); pq2(ARR(A_MRK), ARR(A_VQ), tt, hf, lane, z);
      float* ol = WSF_(A, WS_OL) + ((size_t)unit * 64 + t) * 64; *(GAS f32x4*)(ol + cb0) = z[0]; *(GAS f32x4*)(ol + cb1) = z[1]; }
    {
      f32x4 p[2] = {{0.f, 0.f, 0.f, 0.f}, {0.f, 0.f, 0.f, 0.f}}, s[2] = {{0.f, 0.f, 0.f, 0.f}, {0.f, 0.f, 0.f, 0.f}};
#pragma unroll
      for (int ks = 0; ks < 2; ++ks) { const bf16x8 bbh = frag_tr(ARR(A_BH), 32 * ks, 16 * tt, lane), bul = frag_tr(ARR(A_XB), 32 * ks, 16 * tt, lane), bvq = frag_tr(ARR(A_VQ), 32 * ks, 16 * tt, lane);
#pragma unroll
          for (int j = 0; j < 2; ++j) { const int mt = 2 * hf + j;
              p[j] = mfma16(frag_tr(ARR(A_XA), 32 * ks, 16 * mt, lane), bbh, p[j]);
              s[j] = mfma16(frag_tr(ARR(A_BH), 32 * ks, 16 * mt, lane), bul, s[j]);
              s[j] = mfma16(frag_tr(ARR(A_KH), 32 * ks, 16 * mt, lane), bvq, s[j]); } }
      const float gkp = gcl[16 * tt + i];
      bf16* pt = WSB_(A, WS_PT) + ((size_t)unit * 64 + 16 * tt + i) * 64; float* sl = WSF_(A, WS_SL) + ((size_t)unit * 64 + 16 * tt + i) * 64;
#pragma unroll
      for (int j = 0; j < 2; ++j) { const int cb = 16 * (2 * hf + j) + 4 * g; const f32x4 gq = *(const LAS f32x4*)(gcl + cb);
#pragma unroll
          for (int r = 0; r < 4; ++r) { p[j][r] = gkp * (p[j][r] + ((cb + r) == (16 * tt + i) ? 1.0f : 0.f)); s[j][r] *= gq[r]; }
          *(GAS u32x2*)(pt + cb) = pk4(p[j]); *(GAS f32x4*)(sl + cb) = s[j]; } }
    WG_BAR();
#undef SQ_STAGE
#undef T_STAGE
#undef ARR
}

__device__ __forceinline__ void rwkv_carry(Frame& F, const Args& A, int bh) {
    const int lane = F.lane, w = F.wave, i = lane & 15, g = lane >> 4;
    if (w >= 4) return;
    const int v = 16 * w + i;
    f32x4 acc[4];
#pragma unroll
    for (int mt = 0; mt < 4; ++mt) acc[mt] = (f32x4){0.f, 0.f, 0.f, 0.f};
    u32x2 pa[4][2][2]; f32x4 sl[4];
    const bf16* PT = WSB_(A, WS_PT) + (size_t)bh * 128 * 4096; const float* SL = WSF_(A, WS_SL) + (size_t)bh * 128 * 4096; bf16* S0B = WSB_(A, WS_S0B) + (size_t)bh * 128 * 4096;
#define CARRY_LOAD(cc) do { const bf16* pp = PT + (size_t)(cc) * 4096; const float* ss = SL + (size_t)(cc) * 4096 + v * 64 + 4 * g; \
        _Pragma("unroll") for (int mt = 0; mt < 4; ++mt) { sl[mt] = *(const GAS f32x4*)(ss + 16 * mt); \
            _Pragma("unroll") for (int ks = 0; ks < 2; ++ks) { pa[mt][ks][0] = *(const GAS u32x2*)(pp + (16 * mt + i) * 64 + 32 * ks + 4 * g); pa[mt][ks][1] = *(const GAS u32x2*)(pp + (16 * mt + i) * 64 + 32 * ks + 16 + 4 * g); } } } while (0)
    CARRY_LOAD(0);
    for (int c = 0; c < 128; ++c) {
        u32x2 pc[4][2][2]; f32x4 sc[4];
#pragma unroll
        for (int mt = 0; mt < 4; ++mt) { sc[mt] = sl[mt];
#pragma unroll
            for (int ks = 0; ks < 2; ++ks) { pc[mt][ks][0] = pa[mt][ks][0]; pc[mt][ks][1] = pa[mt][ks][1]; } }
        if (c + 1 < 128) CARRY_LOAD(c + 1);
        bf16* s0 = S0B + (size_t)c * 4096 + v * 64 + 4 * g;
        u32x2 pk[4];
#pragma unroll
        for (int mt = 0; mt < 4; ++mt) { pk[mt] = pk4(acc[mt]); *(GAS u32x2*)(s0 + 16 * mt) = pk[mt]; }
#pragma unroll
        for (int ks = 0; ks < 2; ++ks) { const v4u bw = {pk[2 * ks].x, pk[2 * ks].y, pk[2 * ks + 1].x, pk[2 * ks + 1].y}; const bf16x8 bf = __builtin_bit_cast(bf16x8, bw);
#pragma unroll
            for (int mt = 0; mt < 4; ++mt) { const v4u aw4 = {pc[mt][ks][0].x, pc[mt][ks][0].y, pc[mt][ks][1].x, pc[mt][ks][1].y}; sc[mt] = mfma16(__builtin_bit_cast(bf16x8, aw4), bf, sc[mt]); } }
#pragma unroll
        for (int mt = 0; mt < 4; ++mt) acc[mt] = sc[mt];
    }
#undef CARRY_LOAD
    float* so = A.out + O_WKVP + ((size_t)bh * 64 + v) * 64 + 4 * g;
#pragma unroll
    for (int mt = 0; mt < 4; ++mt) *(GAS f32x4*)(so + 16 * mt) = acc[mt];
}

__device__ __forceinline__ void rwkvC_unit(Frame& F, const Args& A, int unit) {
    const int lane = F.lane, tt = F.wave & 3, i = lane & 15, g = lane >> 4;
    const int bh = unit >> 7, c = unit & 127, b = bh >> 3, h = bh & 7;
    const int t = 16 * tt + i, m = b * SEQ + c * 64 + t;
    const bf16* QE = WSB_(A, WS_QE) + (size_t)unit * 4096; const bf16* S0 = WSB_(A, WS_S0B) + (size_t)unit * 4096; const float* OL = WSF_(A, WS_OL) + (size_t)unit * 4096;
    f32x4 acc[4];
#pragma unroll
    for (int mt = 0; mt < 4; ++mt) acc[mt] = *(const GAS f32x4*)(OL + t * 64 + 16 * mt + 4 * g);
#pragma unroll
    for (int ks = 0; ks < 2; ++ks) { const bf16x8 bq = *(const GAS bf16x8*)(QE + t * 64 + 32 * ks + 8 * g);
#pragma unroll
        for (int mt = 0; mt < 4; ++mt) acc[mt] = mfma16(*(const GAS bf16x8*)(S0 + (16 * mt + i) * 64 + 32 * ks + 8 * g), bq, acc[mt]); }
    float s = 0.f;
#pragma unroll
    for (int mt = 0; mt < 4; ++mt) s += (acc[mt][0] + acc[mt][1]) + (acc[mt][2] + acc[mt][3]);
    s += __shfl_xor(s, 16); s += __shfl_xor(s, 32);
    const float mean = s * (1.0f / 64.0f); float q = 0.f;
#pragma unroll
    for (int mt = 0; mt < 4; ++mt)
#pragma unroll
        for (int r = 0; r < 4; ++r) { const float d = acc[mt][r] - mean; q += d * d; }
    q += __shfl_xor(q, 16); q += __shfl_xor(q, 32);
    const float rstd = 1.0f / sqrtf(q * (1.0f / 64.0f) + GN_EPS);
    const float bon = WSF_(A, WS_BON)[(size_t)m * 8 + h];
#pragma unroll
    for (int mt = 0; mt < 4; ++mt) { const int hc = h * 64 + 16 * mt + 4 * g;
        const f32x4 gg = *(const GAS f32x4*)(LNX_G_(A) + hc), bb = *(const GAS f32x4*)(LNX_B_(A) + hc);
        const f32x4 vm = up4(*(const GAS u32x2*)(WSB_(A, WS_VMX) + (size_t)m * RW + hc)), zr = up4(*(const GAS u32x2*)(WSB_(A, WS_H) + (size_t)m * NH + C_ZR + hc));
        f32x4 y;
#pragma unroll
        for (int r = 0; r < 4; ++r) y[r] = ((acc[mt][r] - mean) * rstd * gg[r] + bb[r] + bon * vm[r]) * zr[r];
        *(GAS u32x2*)(WSB_(A, WS_YR) + (size_t)m * RW + hc) = pk4(y); }
}

constexpr int AT_K = 0, AT_V = 65536, AT_VROWS = 272;
constexpr int NATT_UNITS = 3 * 512;
__device__ __forceinline__ int at_off(int row, int e) { return row * 256 + ((((e) >> 3) ^ (row & 15)) << 4) + ((e) & 7) * 2; }
__device__ __forceinline__ void attnP_unit(Frame& F, const Args& A, int unit) {
    const int lane = F.lane, qt = F.wave, i = lane & 15, gq = lane >> 4, tid = F.tid;
    const int g = unit >> 9, r0 = unit & 511, sh = 2 * g, d = 1 << sh, nblk = 64 >> sh;
    const int n = r0 % nblk, x = r0 / nblk, rho = x & (d - 1), y = x >> sh, h = y & 3, b = y >> 2;
    LAS unsigned char* L = F.lds + RING_OFF;
    const bf16* H = WSB_(A, WS_H);
    const int hoff = g * 512 + h * 128;
    for (int idx = tid; idx < 256 * 16; idx += 512) {
        const int kl = idx >> 4, ch = idx & 15, pos = 128 * (n - 1) + kl;
        v4u kq = {0u, 0u, 0u, 0u}, vq = {0u, 0u, 0u, 0u};
        if (pos >= 0) { const bf16* rp = H + (size_t)(b * SEQ + rho + d * pos) * NH + hoff + ch * 8; kq = *(const GAS v4u*)(rp + C_AK); vq = *(const GAS v4u*)(rp + C_AV); }
        const int o = kl * 256 + ((ch ^ (kl & 15)) << 4);
        *(LAS v4u*)(L + AT_K + o) = kq; *(LAS v4u*)(L + AT_V + o) = vq;
    }
    if (tid < 256) { const int kl = 256 + (tid >> 4), ch = tid & 15; *(LAS v4u*)(L + AT_V + kl * 256 + ((ch ^ (kl & 15)) << 4)) = (v4u){0u, 0u, 0u, 0u}; }
    const int ql = 16 * qt + i;
    const size_t qrow = (size_t)(b * SEQ + rho + d * (128 * n + ql));
    bf16x8 qf[4];
#pragma unroll
    for (int ks = 0; ks < 4; ++ks) qf[ks] = *(const GAS bf16x8*)(H + qrow * NH + C_AQ + hoff + 32 * ks + 8 * gq);
    WG_BAR();
    f32x4 sc[9];
#pragma unroll
    for (int kk = 0; kk < 9; ++kk) { const int krow = 16 * (qt + kk) + i; f32x4 acc = {0.f, 0.f, 0.f, 0.f};
#pragma unroll
        for (int ks = 0; ks < 4; ++ks) acc = mfma16(*(const LAS bf16x8*)(L + AT_K + krow * 256 + (((4 * ks + gq) ^ (krow & 15)) << 4)), qf[ks], acc);
        sc[kk] = acc; }
    const float NEG = -__builtin_inff();
    const bool nofirst = n > 0;
#pragma unroll
    for (int r = 0; r < 4; ++r) { if (4 * gq + r < i) sc[0][r] = NEG; if (4 * gq + r > i) sc[8][r] = NEG; }
    if (!nofirst) {
#pragma unroll
        for (int kk = 0; kk < 9; ++kk) { if (16 * (qt + kk) < 128) sc[kk] = (f32x4){NEG, NEG, NEG, NEG}; }
    }
    float mx = -1e30f;
#pragma unroll
    for (int kk = 0; kk < 9; ++kk) mx = fmaxf(mx, fmaxf(fmaxf(sc[kk][0], sc[kk][1]), fmaxf(sc[kk][2], sc[kk][3])));
    mx = fmaxf(mx, __shfl_xor(mx, 16)); mx = fmaxf(mx, __shfl_xor(mx, 32));
    constexpr float C2 = ATT_SCALE * 1.4426950408889634f;
    float l = 0.f;
#pragma unroll
    for (int kk = 0; kk < 9; ++kk)
#pragma unroll
        for (int r = 0; r < 4; ++r) { const float p = __builtin_amdgcn_exp2f((sc[kk][r] - mx) * C2); sc[kk][r] = p; l += p; }
    l += __shfl_xor(l, 16); l += __shfl_xor(l, 32);
    f32x4 oa[8];
#pragma unroll
    for (int et = 0; et < 8; ++et) oa[et] = (f32x4){0.f, 0.f, 0.f, 0.f};
#pragma unroll
    for (int s = 0; s < 5; ++s) {
        const u32x2 plo = pk4(sc[2 * s]); const u32x2 phi = (2 * s + 1 < 9) ? pk4(sc[(2 * s + 1 < 9) ? 2 * s + 1 : 8]) : (u32x2){0u, 0u};
        const v4u pw = {plo.x, plo.y, phi.x, phi.y}; const bf16x8 pf = __builtin_bit_cast(bf16x8, pw);
        const int rlo = 16 * (qt + 2 * s) + 4 * gq + (i >> 2), rhi = rlo + 16;
#pragma unroll
        for (int et = 0; et < 8; ++et) { const int e = 16 * et + 4 * (i & 3);
            const s16x4 lo = __builtin_bit_cast(s16x4, __builtin_amdgcn_ds_read_tr16_b64_v4i16((LAS v4i16_t*)(L + AT_V + at_off(rlo, e))));
            const s16x4 hi = __builtin_bit_cast(s16x4, __builtin_amdgcn_ds_read_tr16_b64_v4i16((LAS v4i16_t*)(L + AT_V + at_off(rhi, e))));
            oa[et] = mfma16(__builtin_shufflevector(lo, hi, 0, 1, 2, 3, 4, 5, 6, 7), pf, oa[et]); }
    }
    const float il = 1.0f / l;
    bf16* ao = WSB_(A, WS_AO) + ((size_t)g * MP + qrow) * RW + h * 128 + 4 * gq;
#pragma unroll
    for (int et = 0; et < 8; ++et) *(GAS u32x2*)(ao + 16 * et) = pk4(oa[et] * il);
    if (gq == 0) WSF_(A, WS_LSE)[((size_t)g * MP + qrow) * 4 + h] = mx * ATT_SCALE + __logf(l);
    WG_BAR();
}
__device__ __forceinline__ void attn_combine_row(Frame& F, const Args& A, int m) {
    const int lane = F.lane, c0 = lane * 8, h = lane >> 4;
    float o[3][8], ls[3];
#pragma unroll
    for (int g = 0; g < 3; ++g) { ld8bf(WSB_(A, WS_AO) + ((size_t)g * MP + m) * RW + c0, o[g]); ls[g] = WSF_(A, WS_LSE)[((size_t)g * MP + m) * 4 + h]; }
    const float ml = fmaxf(fmaxf(ls[0], ls[1]), ls[2]);
    const float w0 = __expf(ls[0] - ml), w1 = __expf(ls[1] - ml), w2 = __expf(ls[2] - ml), iw = 1.0f / (w0 + w1 + w2);
    float z[8]; ld8bf(WSB_(A, WS_H) + (size_t)m * NH + C_ZA + c0, z);
    float yv[8];
#pragma unroll
    for (int j = 0; j < 8; ++j) yv[j] = (w0 * o[0][j] + w1 * o[1][j] + w2 * o[2][j]) * iw * z[j];
    v4u w; w.x = pk2(yv[0], yv[1]); w.y = pk2(yv[2], yv[3]); w.z = pk2(yv[4], yv[5]); w.w = pk2(yv[6], yv[7]);
    *(GAS v4u*)(WSB_(A, WS_YA) + (size_t)m * RW + c0) = w;
}

__device__ __forceinline__ void ln_row(Frame& F, const Args& A, int m) {
    const GAS f32x4* xr = (const GAS f32x4*)(WSF_(A, WS_PRE) + (size_t)m * DM) + F.lane;
    f32x4 v[4]; float s = 0.f;
#pragma unroll
    for (int j = 0; j < 4; ++j) { v[j] = xr[64 * j]; s += (v[j].x + v[j].y) + (v[j].z + v[j].w); }
    const float mean = wave_sum(s) * (1.f / DM); float s2 = 0.f;
#pragma unroll
    for (int j = 0; j < 4; ++j) { v[j] = v[j] - mean; s2 += (v[j].x * v[j].x + v[j].y * v[j].y) + (v[j].z * v[j].z + v[j].w * v[j].w); }
    const float rstd = 1.f / sqrtf(wave_sum(s2) * (1.f / DM) + LN_EPS);
    GAS f32x4* o = (GAS f32x4*)(A.out + (size_t)m * DM) + F.lane;
#pragma unroll
    for (int j = 0; j < 4; ++j) { const f32x4 g = *((const GAS f32x4*)LN_G_(A) + F.lane + 64 * j), bta = *((const GAS f32x4*)LN_B_(A) + F.lane + 64 * j); o[64 * j] = v[j] * rstd * g + bta; }
}

__global__ void __launch_bounds__(NWAVES * 64, 2) mega_fwd(Args args) {
    extern __shared__ __attribute__((aligned(16))) unsigned char lds[];
    Frame F;
    F.lds = (LAS unsigned char*)lds;
    F.MISC = (volatile LAS unsigned*)(F.lds + MISC_OFF);
    F.tid = threadIdx.x; F.lane = F.tid & 63; F.wave = __builtin_amdgcn_readfirstlane(F.tid >> 6);
    F.G = gridDim.x;
    F.ctl = (gu32*)(args.ws + WS_CTL);
    for (int u = F.tid; u < (LDS_BYTES - LDSCTL_OFF) / 4; u += NWAVES * 64) ((LAS unsigned*)(F.lds + LDSCTL_OFF))[u] = 0u;
    __syncthreads();
    XcdBarrier bar; bar.bar = (unsigned*)(F.ctl + CW_BAR); bar.x = 0; bar.st = nullptr;
    if (N_LAUNCHES == 1) bar = xcd_barrier_post((unsigned*)(F.ctl + CW_BAR), F.MISC + 8);
#define GRID_BAR() do { if (N_LAUNCHES == 1) xcd_barrier(bar); } while (0)
    const int lo = args.ph_lo, hi = args.ph_hi;
#ifndef PH_MASK
#define PH_MASK 0xFFFF
#endif
#define IN(k) ((((PH_MASK) >> (k)) & 1) && lo <= (k) && (k) < hi)
#define BOTH(k) (IN(k) && IN((k) + 1))
    const int gw = blockIdx.x * NWAVES + F.wave, NGW = F.G * NWAVES;

    if (IN(0)) { p0_prologue(F, args); if (BOTH(0)) GRID_BAR(); }
    if (IN(1)) {
        pg8::Gemm g{WSB_(args, WS_XB), WSB_(args, WS_WIN), M, NH, DM}; pg8::StaticOrder S; S.init(M, NH, F.G, (int)blockIdx.x);
        pg8::EpiH E{WSB_(args, WS_H), B_GATE_(args), args.out};
        pg8::gemm_phase<pg8::EpiH, pg8::StaticOrder, PG8_ALIGN, PG8_SP2>(F.lds + RING_OFF, g, S, E);
        if (BOTH(1)) GRID_BAR();
    }
    if (IN(2)) {
        for (int m = MP + gw; m < M; m += NGW) rwkv_prep_row(F, args, m);
        for (int u = blockIdx.x; u < NUNITS; u += F.G) rwkvA_unit(F, args, u);
        if (BOTH(2)) GRID_BAR();
    }
    if (IN(3)) {
        if (blockIdx.x < 16) rwkv_carry(F, args, (int)blockIdx.x);
        for (int it = 16 + gw; it < 16 + DBATCH * 8; it += NGW) scan_item(F, args, it);
        LAS float* sq = (LAS float*)(F.lds + RING_OFF + F.wave * 2048); LAS float* sp = sq + 128;
        for (int it = gw; it < MS * 4; it += NGW) { const int m = MP + (it >> 2), h = it & 3; attn_item<false>(F, args, m, h, sq, sp); }
        WG_BAR();
        {
            volatile LAS int* qslot = (volatile LAS int*)(F.lds + LDSCTL_OFF);
            for (;;) {
                if (F.tid == 0) qslot[0] = (int)__hip_atomic_fetch_add((unsigned*)(F.ctl + CW_Q), 1u, __ATOMIC_RELAXED, __HIP_MEMORY_SCOPE_AGENT);
                WG_BAR();
                const int u = qslot[0];
                WG_BAR();
                if (u >= NATT_UNITS) break;
                attnP_unit(F, args, u);
            }
        }
        if (BOTH(3)) GRID_BAR();
    }
    if (IN(4)) {
        for (int u2 = blockIdx.x; u2 < NUNITS / 2; u2 += F.G) rwkvC_unit(F, args, 2 * u2 + (F.wave >> 2));
        for (int m = MP + gw; m < M; m += NGW) rwkv_post_row(F, args, m);
        for (int m = gw; m < MP; m += NGW) attn_combine_row(F, args, m);
        if (BOTH(4)) GRID_BAR();
    }
    if (IN(5)) {
        pg8::Gemm g{WSB_(args, WS_YR), WSB_(args, WS_WOA), M, DM, RW}; pg8::StaticOrder S; S.init(M, DM, F.G, (int)blockIdx.x);
        pg8::EpiMixA E{WSB_(args, WS_H), WSF_(args, WS_MIXF)};
        pg8::gemm_phase<pg8::EpiMixA, pg8::StaticOrder, PG8_ALIGN, PG8_SP2>(F.lds + RING_OFF, g, S, E);
        if (BOTH(5)) GRID_BAR();
    }
    if (IN(6)) {
        pg8::Gemm g{WSB_(args, WS_YA), WSB_(args, WS_WOB), M, DM, RW}; pg8::StaticOrder S; S.init(M, DM, F.G, (int)blockIdx.x);
        pg8::EpiMixB E{WSB_(args, WS_H), WSF_(args, WS_MIXF), WSB_(args, WS_MIX)};
        pg8::gemm_phase<pg8::EpiMixB, pg8::StaticOrder, PG8_ALIGN, PG8_SP2>(F.lds + RING_OFF, g, S, E);
        if (BOTH(6)) GRID_BAR();
    }
    if (IN(7)) {
        pg8::Gemm g{WSB_(args, WS_MIX), WSB_(args, WS_WOUT), M, DM, DM}; pg8::StaticOrder S; S.init(M, DM, F.G, (int)blockIdx.x);
        pg8::EpiPre E{XP_(args), XS_(args), WSF_(args, WS_PRE)};
        pg8::gemm_phase<pg8::EpiPre, pg8::StaticOrder, PG8_ALIGN, PG8_SP2>(F.lds + RING_OFF, g, S, E);
        if (BOTH(7)) GRID_BAR();
    }
    if (IN(8)) {
        for (int m = gw; m < M; m += NGW) ln_row(F, args, m);
    }
#undef IN
#undef BOTH
}

extern "C" void kernel_launch(void* const* d_in, const int* in_sizes, int n_in, void* d_out, int out_size, void* d_ws, size_t ws_size, hipStream_t stream) {
    static int grid = 0;
    if (grid == 0) {
        if (n_in != 24 || in_sizes[0] != MP * DM || (size_t)out_size != O_END || ws_size < WS_END) { fprintf(stderr, "kernel_launch: unexpected shapes (n_in %d, in0 %d, out %d, ws %zu); nothing launched\n", n_in, n_in > 0 ? in_sizes[0] : -1, out_size, ws_size); grid = -1; return; }
        int dev = 0, cus = 0, per_cu = 0;
        if (hipGetDevice(&dev) != hipSuccess || hipDeviceGetAttribute(&cus, hipDeviceAttributeMultiprocessorCount, dev) != hipSuccess) { grid = -1; return; }
        if (hipFuncSetAttribute((const void*)mega_fwd, hipFuncAttributeMaxDynamicSharedMemorySize, LDS_BYTES) != hipSuccess) { fprintf(stderr, "kernel_launch: hipFuncSetAttribute failed\n"); grid = -1; return; }
        if (hipOccupancyMaxActiveBlocksPerMultiprocessor(&per_cu, (const void*)mega_fwd, NWAVES * 64, LDS_BYTES) != hipSuccess || per_cu < 1) fprintf(stderr, "kernel_launch: occupancy query reports %d\n", per_cu);
        (void)hipGetLastError();
        grid = cus;
    }
    if (grid < 0) return;
    if (hipMemsetAsync((char*)d_ws + WS_CTL, 0, CTL_ZERO_BYTES, stream) != hipSuccess) return;
    Args a{};
    for (int i = 0; i < 24; ++i) a.in[i] = (const float*)d_in[i];
    a.out = (float*)d_out; a.ws = (unsigned char*)d_ws;
    if (N_LAUNCHES == 1) { a.ph_lo = 0; a.ph_hi = N_PHASES; hipLaunchKernelGGL(mega_fwd, dim3(grid), dim3(NWAVES * 64), LDS_BYTES, stream, a); }
    else for (int li = 0; li < N_PHASES; ++li) { a.ph_lo = li; a.ph_hi = li + 1; hipLaunchKernelGGL(mega_fwd, dim3(grid), dim3(NWAVES * 64), LDS_BYTES, stream, a); }
}
```

```cpp
#include <hip/hip_runtime.h>
#include <cstdio>
#include <cstdint>
namespace pg8 {
#define PG8_LAS __attribute__((address_space(3)))
typedef unsigned short bf16_t;
typedef short bf16x8 __attribute__((ext_vector_type(8)));
typedef float f32x4 __attribute__((ext_vector_type(4)));
typedef unsigned u32x4 __attribute__((ext_vector_type(4)));
constexpr int BM = 256, BK = 64, HALF = 128, HTB = HALF * BK * 2  , STAGE_BYTES = 8 * HTB, NXCD = 8, WGM = 8;

__host__ __device__ __forceinline__ int lds_byte(int r, int c) { const int st = (r >> 4) * 2 + (c >> 5), rr = r & 15, cc = c & 31, ob = rr * 64 + cc * 2; return st * 1024 + (ob ^ (((ob >> 9) & 1) << 5)); }
__host__ __device__ __forceinline__ void stage_rc(int b, int& R, int& C) { const int st = b / 1024, sb = b % 1024, swz = sb ^ (((sb >> 9) & 1) << 5); R = (st >> 1) * 16 + swz / 64; C = (st & 1) * 32 + (swz % 64) / 2; }
__host__ __device__ __forceinline__ int perm32(int rho) { const int n = rho >> 4, i = rho & 15; return 8 * (i >> 2) + 4 * n + (i & 3); }

struct Unit { int pm, pn; };
struct Gemm { const bf16_t* A; const bf16_t* Bt; int M, N, K; };

struct StaticOrder {
    int nM, nN, nwg, G, c;
    __host__ __device__ void init(int M, int N, int G_, int c_) { nM = M / BM; nN = N / BM; nwg = nM * nN; G = G_; c = c_; }
    __host__ __device__ bool next(int i, Unit& u) const {
        const long L = (long)i * G + c; if (L >= nwg) return false;
        int wgid = (int)L; { const int q = nwg / NXCD, r = nwg % NXCD, xcd = wgid % NXCD, off = wgid / NXCD; wgid = (xcd < r ? xcd * (q + 1) : r * (q + 1) + (xcd - r) * q) + off; }
        const int nig = WGM * nN, gid = wgid / nig, fm = gid * WGM, gsz = (nM - fm) < WGM ? (nM - fm) : WGM;
        u.pm = fm + ((wgid % nig) % gsz); u.pn = (wgid % nig) / gsz; return true;
    }
    __device__ __forceinline__ void a_ready(const Unit&) const {}
    __device__ __forceinline__ void done(const Unit&) const {}
};

__device__ __forceinline__ unsigned cvt_pk_bf16(float lo, float hi) { unsigned r; asm volatile("v_cvt_pk_bf16_f32 %0, %1, %2" : "=v"(r) : "v"(lo), "v"(hi)); return r; }
typedef float f32x2 __attribute__((ext_vector_type(2)));
__device__ __forceinline__ f32x2 gelu_pk(f32x2 v) {
    const f32x2 av = __builtin_elementwise_abs(v), d = av * 0.2316418882f + 1.0f;
    f32x2 t; t.x = __builtin_amdgcn_rcpf(d.x); t.y = __builtin_amdgcn_rcpf(d.y);
    f32x2 q = t * 0.5307027145f + (-0.7265760135f); q = q * t + 0.7107068705f; q = q * t + (-0.142248368f); q = q * t + 0.127414796f; q = q * t;
    const f32x2 s = (v * v) * (-0.72134752044f);
    f32x2 e; e.x = __builtin_amdgcn_exp2f(s.x); e.y = __builtin_amdgcn_exp2f(s.y);
    const f32x2 m = v * (q * e), r = v - m;
    f32x2 o; o.x = v.x < 0.f ? m.x : r.x; o.y = v.y < 0.f ? m.y : r.y; return o;
}

template <int ACT  > struct EpiBf16 {
    static constexpr bool PERM = true, AFTER_DRAIN = false; static_assert(ACT == 0 || ACT == 1, "EpiBf16: ACT is 0 (none) or 1 (gelu_pk)");
    bf16_t* O; int ldc; const float* bias; int split_cols; size_t split_stride; float scale0;
    __device__ __forceinline__ void operator()(const f32x4 (&acc)[2][2][4][2], const Unit& u, int wr, int wc, int fr, int fq) const {
        const int row0 = u.pm * BM + wr * 64 + fr; int colt = u.pn * BM; bf16_t* base = O;
        float sc = 1.f; if (split_cols) { const int t = colt / split_cols; base += (size_t)t * split_stride; colt -= t * split_cols; if (t == 0) sc = scale0; }
        const int col0 = colt + wc * 32 + 8 * fq, bcol0 = u.pn * BM + wc * 32 + 8 * fq;
        f32x4 bv[2][2];
#pragma unroll
        for (int bj = 0; bj < 2; ++bj)
#pragma unroll
            for (int n = 0; n < 2; ++n) bv[bj][n] = bias ? *(const f32x4*)(bias + bcol0 + bj * HALF + 4 * n) : (f32x4){0.f, 0.f, 0.f, 0.f};
#pragma unroll
        for (int ai = 0; ai < 2; ++ai)
#pragma unroll
            for (int m = 0; m < 4; ++m) { bf16_t* rowp = base + (size_t)(row0 + ai * HALF + m * 16) * ldc + col0;
#pragma unroll
                for (int bj = 0; bj < 2; ++bj) { f32x4 v0 = acc[ai][bj][m][0] + bv[bj][0], v1 = acc[ai][bj][m][1] + bv[bj][1];
                    if (ACT == 1) { f32x2 a = gelu_pk((f32x2){v0[0], v0[1]}), b = gelu_pk((f32x2){v0[2], v0[3]}), c = gelu_pk((f32x2){v1[0], v1[1]}), d = gelu_pk((f32x2){v1[2], v1[3]});
                        v0 = (f32x4){a.x, a.y, b.x, b.y}; v1 = (f32x4){c.x, c.y, d.x, d.y}; }
                    v0 = v0 * sc; v1 = v1 * sc; u32x4 w; w.x = cvt_pk_bf16(v0[0], v0[1]); w.y = cvt_pk_bf16(v0[2], v0[3]); w.z = cvt_pk_bf16(v1[0], v1[1]); w.w = cvt_pk_bf16(v1[2], v1[3]);
                    *(u32x4*)(rowp + bj * HALF) = w; } }
    }
};

struct PanelStats {
    unsigned* xbuf;
    unsigned* cnt;
    unsigned* tmo;
    int ntn; float eps;
    unsigned code;
    __device__ __forceinline__ bool run(const f32x4 (&v)[2][2][4][2], const Unit& u, int wr, int wc, int fr, int fq, PG8_LAS unsigned char* lds, int wid, int lane) const {
        typedef float f32x2v __attribute__((ext_vector_type(2)));
        PG8_LAS f32x2v* P = (PG8_LAS f32x2v*)lds;
        PG8_LAS f32x2v* S = (PG8_LAS f32x2v*)(lds + 8192);
        PG8_LAS unsigned* flag = (PG8_LAS unsigned*)(lds + 8192 + 2048);
#pragma unroll
        for (int ai = 0; ai < 2; ++ai)
#pragma unroll
            for (int m = 0; m < 4; ++m) {
                float s = 0.f;
#pragma unroll
                for (int bj = 0; bj < 2; ++bj)
#pragma unroll
                    for (int n = 0; n < 2; ++n) { const f32x4 x = v[ai][bj][m][n]; s += (x[0] + x[1]) + (x[2] + x[3]); }
                s += __shfl_xor(s, 16); s += __shfl_xor(s, 32);
                const float mw = s * (1.0f / 64.0f); float q = 0.f;
#pragma unroll
                for (int bj = 0; bj < 2; ++bj)
#pragma unroll
                    for (int n = 0; n < 2; ++n) { const f32x4 d = v[ai][bj][m][n] - mw; q += (d[0] * d[0] + d[1] * d[1]) + (d[2] * d[2] + d[3] * d[3]); }
                q += __shfl_xor(q, 16); q += __shfl_xor(q, 32);
                if (fq == 0) P[(ai * HALF + wr * 64 + m * 16 + fr) * 4 + wc] = (f32x2v){mw, q};
            }
        asm volatile("s_waitcnt lgkmcnt(0)" ::: "memory"); __builtin_amdgcn_s_barrier(); asm volatile("" ::: "memory");
#if defined(BROKEN_EXCHANGE_NO_WAIT)
#warning BROKEN CONTROL BUILD: the row-statistics exchange does not wait; results are wrong by design
        if (blockIdx.x >= 64) { const long long t0_ = clock64(); while (clock64() - t0_ < 60000) __builtin_amdgcn_s_sleep(8); }
#endif
        const int row = wid * 32 + (lane & 31);
        if (lane < 32) {
            const f32x2v a = P[row * 4 + 0], b = P[row * 4 + 1], c = P[row * 4 + 2], d = P[row * 4 + 3];
            const float mt = (a.x + b.x + c.x + d.x) * 0.25f;
            const float da = a.x - mt, db = b.x - mt, dc = c.x - mt, dd = d.x - mt;
            const float m2 = (a.y + b.y) + (c.y + d.y) + 64.0f * ((da * da + db * db) + (dc * dc + dd * dd));
            unsigned long long* slot = (unsigned long long*)xbuf + ((size_t)(u.pm * BM + row) * 4 + u.pn);
            __hip_atomic_store(slot, ((unsigned long long)__float_as_uint(m2) << 32) | __float_as_uint(mt), __ATOMIC_RELAXED, __HIP_MEMORY_SCOPE_AGENT);
        }
        asm volatile("s_waitcnt vmcnt(0)" ::: "memory");
        if (lane == 0) __hip_atomic_fetch_add(cnt + 64 * u.pm, 1u, __ATOMIC_RELAXED, __HIP_MEMORY_SCOPE_AGENT);
        if (wid == 0) {
            bool dead = false; const unsigned long long t0 = __builtin_amdgcn_s_memrealtime(); const unsigned want = 8u * (unsigned)ntn;
            for (;;) {
#if defined(BROKEN_EXCHANGE_NO_WAIT)
                break;
#endif
                if ((unsigned)__builtin_amdgcn_readfirstlane(__hip_atomic_load(cnt + 64 * u.pm, __ATOMIC_RELAXED, __HIP_MEMORY_SCOPE_AGENT)) >= want) break;
                if (__builtin_amdgcn_s_memrealtime() - t0 > 2000000ull) {
                    if (lane == 0) { unsigned expect = 0u; __hip_atomic_compare_exchange_strong(tmo + 1, &expect, code | (unsigned)(u.pm & 0xff), __ATOMIC_RELAXED, __ATOMIC_RELAXED, __HIP_MEMORY_SCOPE_AGENT);
                                     __hip_atomic_store(tmo, 1u, __ATOMIC_RELAXED, __HIP_MEMORY_SCOPE_AGENT); }
                    dead = true; break; }
                __builtin_amdgcn_s_sleep(2);
            }
            __builtin_amdgcn_fence(__ATOMIC_ACQUIRE, "agent");
            if (lane == 0) flag[0] = dead ? 1u : 0u;
        }
        asm volatile("s_waitcnt vmcnt(0) lgkmcnt(0)" ::: "memory"); __builtin_amdgcn_s_barrier(); asm volatile("" ::: "memory");
        const bool bad = flag[0] != 0u;
        if (lane < 32) {
            const unsigned long long* slot = (const unsigned long long*)xbuf + (size_t)(u.pm * BM + row) * 4; float mt[4], m2[4]; float ms = 0.f;
#pragma unroll
            for (int t = 0; t < 4; ++t) { if (t < ntn) { const unsigned long long w = __hip_atomic_load(slot + t, __ATOMIC_RELAXED, __HIP_MEMORY_SCOPE_AGENT); mt[t] = __uint_as_float((unsigned)w); m2[t] = __uint_as_float((unsigned)(w >> 32)); } else { mt[t] = 0.f; m2[t] = 0.f; } ms += mt[t]; }
            const float mean = ms / (float)ntn; float q = 0.f;
#pragma unroll
            for (int t = 0; t < 4; ++t) if (t < ntn) { const float dm = mt[t] - mean; q += m2[t] + 256.0f * dm * dm; }
            S[row] = (f32x2v){mean, 1.0f / sqrtf(q / (256.0f * (float)ntn) + eps)};
        }
        asm volatile("s_waitcnt lgkmcnt(0)" ::: "memory"); __builtin_amdgcn_s_barrier(); asm volatile("" ::: "memory");
        return bad;
    }
};
struct EpiLnRes {
    static constexpr bool PERM = false, AFTER_DRAIN = true;
    const float* base; float* out; int ldc; const float* bias; PanelStats st; unsigned poison;
    __device__ __forceinline__ void fused(f32x4 (&acc)[2][2][4][2], const Unit& u, int wr, int wc, int fr, int fq, PG8_LAS unsigned char* lds, int wid, int lane) const {
        typedef float f32x2v __attribute__((ext_vector_type(2)));
        const PG8_LAS f32x2v* S = (const PG8_LAS f32x2v*)(lds + 8192);
        const int col0 = u.pn * BM + wc * 32 + 4 * fq;
#pragma unroll
        for (int bj = 0; bj < 2; ++bj)
#pragma unroll
            for (int n = 0; n < 2; ++n) { const f32x4 bv = bias ? *(const f32x4*)(bias + col0 + bj * HALF + n * 16) : (f32x4){0.f, 0.f, 0.f, 0.f};
#pragma unroll
                for (int ai = 0; ai < 2; ++ai)
#pragma unroll
                    for (int m = 0; m < 4; ++m) acc[ai][bj][m][n] += bv; }
        f32x4 pre[4][2][2];
#pragma unroll
        for (int m = 0; m < 4; ++m) { const size_t off = (size_t)(u.pm * BM + wr * 64 + m * 16 + fr) * ldc + col0;
#pragma unroll
            for (int bj = 0; bj < 2; ++bj)
#pragma unroll
                for (int n = 0; n < 2; ++n) pre[m][bj][n] = *(const f32x4*)(base + off + bj * HALF + n * 16); }
        const bool bad = st.run(acc, u, wr, wc, fr, fq, lds, wid, lane) || poison != 0u;
        const float qnan = __builtin_nanf("");
#pragma unroll
        for (int ai = 0; ai < 2; ++ai)
#pragma unroll
            for (int m = 0; m < 4; ++m) { const int r = ai * HALF + wr * 64 + m * 16 + fr; const f32x2v sr = S[r]; const size_t off = (size_t)(u.pm * BM + r) * ldc + col0;
#pragma unroll
                for (int bj = 0; bj < 2; ++bj)
#pragma unroll
                    for (int n = 0; n < 2; ++n) { const f32x4 bs = ai == 0 ? pre[m][bj][n] : *(const f32x4*)(base + off + bj * HALF + n * 16); f32x4 o = bs + (acc[ai][bj][m][n] - sr.x) * sr.y;
                        if (bad) o = (f32x4){qnan, qnan, qnan, qnan}; *(f32x4*)(out + off + bj * HALF + n * 16) = o; }
                if (m & 1) asm volatile("" ::: "memory"); }
    }
};
struct EpiLnResLn {
    static constexpr bool PERM = false, AFTER_DRAIN = true;
    const float* base; float* out; bf16_t* xn; int ldc; const float* bias; PanelStats st1, st2; unsigned poison;
    __device__ __forceinline__ void fused(f32x4 (&acc)[2][2][4][2], const Unit& u, int wr, int wc, int fr, int fq, PG8_LAS unsigned char* lds, int wid, int lane) const {
        typedef float f32x2v __attribute__((ext_vector_type(2))); typedef unsigned u32x2v __attribute__((ext_vector_type(2)));
        const PG8_LAS f32x2v* S = (const PG8_LAS f32x2v*)(lds + 8192);
        const int col0 = u.pn * BM + wc * 32 + 4 * fq;
#pragma unroll
        for (int bj = 0; bj < 2; ++bj)
#pragma unroll
            for (int n = 0; n < 2; ++n) { const f32x4 bv = bias ? *(const f32x4*)(bias + col0 + bj * HALF + n * 16) : (f32x4){0.f, 0.f, 0.f, 0.f};
#pragma unroll
                for (int ai = 0; ai < 2; ++ai)
#pragma unroll
                    for (int m = 0; m < 4; ++m) acc[ai][bj][m][n] += bv; }
        bool bad = st1.run(acc, u, wr, wc, fr, fq, lds, wid, lane) || poison != 0u;
        const float qnan = __builtin_nanf("");
#pragma unroll
        for (int ai = 0; ai < 2; ++ai)
#pragma unroll
            for (int m = 0; m < 4; ++m) { const int r = ai * HALF + wr * 64 + m * 16 + fr; const f32x2v sr = S[r]; const size_t off = (size_t)(u.pm * BM + r) * ldc + col0;
#pragma unroll
                for (int bj = 0; bj < 2; ++bj)
#pragma unroll
                    for (int n = 0; n < 2; ++n) { const f32x4 bs = *(const f32x4*)(base + off + bj * HALF + n * 16); acc[ai][bj][m][n] = bs + (acc[ai][bj][m][n] - sr.x) * sr.y; }
                asm volatile("" : "+v"(acc[ai][0][m][0]), "+v"(acc[ai][0][m][1]), "+v"(acc[ai][1][m][0]), "+v"(acc[ai][1][m][1]));
                if (m & 1) asm volatile("" ::: "memory"); }
        const bool bad1 = bad;
        bad = st2.run(acc, u, wr, wc, fr, fq, lds, wid, lane) || bad;
#pragma unroll
        for (int ai = 0; ai < 2; ++ai)
#pragma unroll
            for (int m = 0; m < 4; ++m) { const int r = ai * HALF + wr * 64 + m * 16 + fr; const f32x2v sr = S[r]; const size_t off = (size_t)(u.pm * BM + r) * ldc + col0;
#pragma unroll
                for (int bj = 0; bj < 2; ++bj)
#pragma unroll
                    for (int n = 0; n < 2; ++n) { const f32x4 x1 = acc[ai][bj][m][n]; *(f32x4*)(out + off + bj * HALF + n * 16) = bad1 ? (f32x4){qnan, qnan, qnan, qnan} : x1;
                        const f32x4 o = (x1 - sr.x) * sr.y; u32x2v w; w.x = cvt_pk_bf16(o[0], o[1]); w.y = cvt_pk_bf16(o[2], o[3]);
                        if (bad) { w.x = 0x7fc07fc0u; w.y = 0x7fc07fc0u; } *(u32x2v*)(xn + off + bj * HALF + n * 16) = w; }
                asm volatile("" ::: "memory"); }
    }
};

template <class Epi, class Sched, bool ALIGN_EPI = false, bool SP2 = false>
__device__ __forceinline__ void gemm_phase(PG8_LAS unsigned char* lds, const Gemm g, const Sched& S, const Epi& E) {
    const int tid = threadIdx.x, wid = __builtin_amdgcn_readfirstlane(tid >> 6), lane = tid & 63, wr = wid >> 2, wc = wid & 3, fr = lane & 15, fq = lane >> 4;
    const int K = g.K, nt = K / BK;
    unsigned voffA[2], voffB[2];
#pragma unroll
    for (int i = 0; i < 2; ++i) { int R, C; stage_rc(tid * 16 + i * 8192, R, C); const int Rb = Epi::PERM ? ((R & ~31) + perm32(R & 31)) : R;
        voffA[i] = (unsigned)(R * K + C) * 2u; voffB[i] = (unsigned)(Rb * K + C) * 2u; }
    const size_t kstep = (size_t)(BK * 2);
    const size_t hstep = (size_t)HALF * K * 2;
    const size_t tstep = 2 * hstep;
    const unsigned ldsw = (unsigned)wid * 1024u;
    const int aoff = lds_byte(wr * 64 + fr, fq * 8), boff = lds_byte(wc * 32 + fr, fq * 8);
#define PG8_SA(b, h) (((b) * 2 + (h)) * HTB)
#define PG8_SB(b, h) ((4 + (b) * 2 + (h)) * HTB)
#define PG8_STAGE(bufoff, gbase, voff) do { _Pragma("unroll") for (int _i = 0; _i < 2; ++_i) \
        __builtin_amdgcn_global_load_lds((const unsigned*)((const char*)(gbase) + (voff)[_i]), (PG8_LAS unsigned*)(lds + (bufoff) + ldsw + _i * 8192), 16, 0, 0); } while (0)
#define PG8_LDA(dst, b, h) do { _Pragma("unroll") for (int m = 0; m < 4; ++m) _Pragma("unroll") for (int k = 0; k < 2; ++k) dst[m][k] = *(const PG8_LAS bf16x8*)(lds + PG8_SA(b, h) + aoff + m * 2048 + k * 1024); } while (0)
#define PG8_LDB(dst, b, h) do { _Pragma("unroll") for (int n = 0; n < 2; ++n) _Pragma("unroll") for (int k = 0; k < 2; ++k) dst[n][k] = *(const PG8_LAS bf16x8*)(lds + PG8_SB(b, h) + boff + n * 2048 + k * 1024); } while (0)
#define PG8_MMA(ai, bj, At, Bt) do { __builtin_amdgcn_s_setprio(1); _Pragma("unroll") for (int m = 0; m < 4; ++m) _Pragma("unroll") for (int n = 0; n < 2; ++n) _Pragma("unroll") for (int k = 0; k < 2; ++k) \
        acc[ai][bj][m][n] = __builtin_amdgcn_mfma_f32_16x16x32_bf16(Bt[n][k], At[m][k], acc[ai][bj][m][n], 0, 0, 0); __builtin_amdgcn_s_setprio(0); } while (0)
#define PG8_WAIT_V(n) asm volatile("s_waitcnt vmcnt(" #n ")" ::: "memory")
#define PG8_WAIT_L(n) asm volatile("s_waitcnt lgkmcnt(" #n ")" ::: "memory")
#define PG8_BAR __builtin_amdgcn_s_barrier()
#define PG8_SCHED __builtin_amdgcn_sched_barrier(0)
    Unit cur, nxt; int ui = 0;
    if (!S.next(0, cur)) return;
    f32x4 acc[2][2][4][2];
#pragma unroll
    for (int a = 0; a < 2; ++a)
#pragma unroll
        for (int b = 0; b < 2; ++b)
#pragma unroll
            for (int m = 0; m < 4; ++m)
#pragma unroll
                for (int n = 0; n < 2; ++n) acc[a][b][m][n] = (f32x4){0.f, 0.f, 0.f, 0.f};
    bf16x8 At[4][2], B0[2][2], B1[2][2];
    const char* cA = (const char*)g.A + (size_t)cur.pm * tstep; const char* cB = (const char*)g.Bt + (size_t)cur.pn * tstep;
    S.a_ready(cur);
    if constexpr (SP2) {
        PG8_STAGE(PG8_SB(0, 0), cB, voffB); PG8_STAGE(PG8_SB(0, 1), cB + hstep, voffB); PG8_STAGE(PG8_SA(0, 0), cA, voffA); PG8_STAGE(PG8_SA(0, 1), cA + hstep, voffA);
        if (wr == 1) PG8_BAR;
        PG8_WAIT_V(2); PG8_BAR;
        PG8_STAGE(PG8_SB(1, 0), cB + kstep, voffB); PG8_STAGE(PG8_SA(1, 0), cA + kstep, voffA); PG8_STAGE(PG8_SB(1, 1), cB + hstep + kstep, voffB);
        PG8_WAIT_V(6); PG8_BAR;
    } else {
        PG8_STAGE(PG8_SB(0, 0), cB, voffB); PG8_STAGE(PG8_SA(0, 0), cA, voffA); PG8_STAGE(PG8_SB(0, 1), cB + hstep, voffB); PG8_STAGE(PG8_SA(0, 1), cA + hstep, voffA);
        if (wr == 1) PG8_BAR;
        PG8_WAIT_V(4); PG8_BAR;
        PG8_STAGE(PG8_SB(1, 0), cB + kstep, voffB); PG8_STAGE(PG8_SA(1, 0), cA + kstep, voffA); PG8_STAGE(PG8_SB(1, 1), cB + hstep + kstep, voffB);
        PG8_WAIT_V(6); PG8_BAR;
    }
    for (;;) {
        const bool has_next = S.next(ui + 1, nxt);
        const char* nA = has_next ? (const char*)g.A + (size_t)nxt.pm * tstep : cA; const char* nB = has_next ? (const char*)g.Bt + (size_t)nxt.pn * tstep : cB;
        for (int t = 0; t < nt; t += 2) {
            const bool last = (t == nt - 2);
            const char* a1 = cA + (size_t)(t + 1) * kstep;
            const char* a2 = last ? nA : cA + (size_t)(t + 2) * kstep; const char* b2 = last ? nB : cB + (size_t)(t + 2) * kstep;
            const char* a3 = a2 + kstep; const char* b3 = b2 + kstep;
            if (last && has_next) S.a_ready(nxt);
            if constexpr (SP2) {
            PG8_LDB(B0, 0, 0); PG8_LDB(B1, 0, 1); PG8_SCHED; PG8_LDA(At, 0, 0); PG8_STAGE(PG8_SA(1, 1), a1 + hstep, voffA);
            PG8_WAIT_V(8); PG8_WAIT_L(0); PG8_BAR; PG8_MMA(0, 0, At, B0); PG8_MMA(0, 1, At, B1); PG8_BAR; PG8_SCHED;
            PG8_LDA(At, 0, 1); PG8_STAGE(PG8_SB(0, 0), b2, voffB); PG8_STAGE(PG8_SB(0, 1), b2 + hstep, voffB); PG8_STAGE(PG8_SA(0, 0), a2, voffA);
            PG8_WAIT_V(8); PG8_WAIT_L(0); PG8_BAR; PG8_MMA(1, 0, At, B0); PG8_MMA(1, 1, At, B1); PG8_BAR; PG8_SCHED;
            PG8_LDB(B0, 1, 0); PG8_LDB(B1, 1, 1); PG8_SCHED; PG8_LDA(At, 1, 0); PG8_STAGE(PG8_SA(0, 1), a2 + hstep, voffA);
            PG8_WAIT_V(8); PG8_WAIT_L(0); PG8_BAR; PG8_MMA(0, 0, At, B0); PG8_MMA(0, 1, At, B1); PG8_BAR; PG8_SCHED;
            PG8_LDA(At, 1, 1); PG8_STAGE(PG8_SB(1, 0), b3, voffB); PG8_STAGE(PG8_SB(1, 1), b3 + hstep, voffB); PG8_STAGE(PG8_SA(1, 0), a3, voffA);
            PG8_WAIT_V(8); PG8_WAIT_L(0); PG8_BAR; PG8_MMA(1, 0, At, B0); PG8_MMA(1, 1, At, B1); PG8_BAR; PG8_SCHED;
            } else {
            PG8_LDB(B0, 0, 0); PG8_SCHED; PG8_LDA(At, 0, 0); PG8_STAGE(PG8_SA(1, 1), a1 + hstep, voffA);
            PG8_WAIT_L(8); PG8_BAR; PG8_WAIT_L(0); PG8_MMA(0, 0, At, B0); PG8_BAR; PG8_SCHED;
            PG8_LDB(B1, 0, 1); PG8_STAGE(PG8_SB(0, 0), b2, voffB);
            PG8_BAR; PG8_WAIT_L(0); PG8_MMA(0, 1, At, B1); PG8_BAR;
            PG8_LDA(At, 0, 1); PG8_STAGE(PG8_SA(0, 0), a2, voffA);
            PG8_BAR; PG8_WAIT_L(0); PG8_MMA(1, 0, At, B0); PG8_BAR; PG8_SCHED;
            PG8_STAGE(PG8_SB(0, 1), b2 + hstep, voffB);
            PG8_WAIT_V(6); PG8_BAR; PG8_MMA(1, 1, At, B1); PG8_BAR;
            PG8_LDB(B0, 1, 0); PG8_SCHED; PG8_LDA(At, 1, 0); PG8_STAGE(PG8_SA(0, 1), a2 + hstep, voffA);
            PG8_WAIT_L(8); PG8_BAR; PG8_WAIT_L(0); PG8_MMA(0, 0, At, B0); PG8_BAR; PG8_SCHED;
            PG8_LDB(B1, 1, 1); PG8_STAGE(PG8_SB(1, 0), b3, voffB);
            PG8_BAR; PG8_WAIT_L(0); PG8_MMA(0, 1, At, B1); PG8_BAR;
            PG8_LDA(At, 1, 1); PG8_STAGE(PG8_SA(1, 0), a3, voffA);
            PG8_BAR; PG8_WAIT_L(0); PG8_MMA(1, 0, At, B0); PG8_BAR; PG8_SCHED;
            PG8_STAGE(PG8_SB(1, 1), b3 + hstep, voffB);
            PG8_WAIT_V(6); PG8_BAR; PG8_MMA(1, 1, At, B1); PG8_BAR;
            }
        }
        if constexpr (ALIGN_EPI) { if (wr == 0) PG8_BAR; }
        if constexpr (!Epi::AFTER_DRAIN) { E(acc, cur, wr, wc, fr, fq); S.done(cur); }
        if (!has_next) break;
#pragma unroll
        for (int a = 0; a < 2; ++a)
#pragma unroll
            for (int b = 0; b < 2; ++b)
#pragma unroll
                for (int m = 0; m < 4; ++m)
#pragma unroll
                    for (int n = 0; n < 2; ++n) acc[a][b][m][n] = (f32x4){0.f, 0.f, 0.f, 0.f};
        cur = nxt; cA = nA; cB = nB; ++ui;
        if constexpr (ALIGN_EPI) { if (wr == 1) PG8_BAR; }
    }
    PG8_WAIT_V(0);
    if constexpr (!ALIGN_EPI) { if (wr == 0) PG8_BAR; }
    PG8_BAR;
    if constexpr (Epi::AFTER_DRAIN) { E.fused(acc, cur, wr, wc, fr, fq, lds, wid, lane); S.done(cur); }
#undef PG8_SA
#undef PG8_SB
#undef PG8_STAGE
#undef PG8_LDA
#undef PG8_LDB
#undef PG8_MMA
#undef PG8_WAIT_V
#undef PG8_WAIT_L
#undef PG8_BAR
#undef PG8_SCHED
}
}
#ifndef PG8_SP2
#define PG8_SP2 true
#endif
#ifndef PG8_ALIGN
#define PG8_ALIGN true
#endif
constexpr int NWAVES = 8;
#ifndef MK_N_LAUNCHES
#define MK_N_LAUNCHES 1
#endif
constexpr int N_PHASES = 9;
constexpr int N_LAUNCHES = MK_N_LAUNCHES;

constexpr int DM = 1024, SEQ = 8192, NBATCH = 2, MP = NBATCH * SEQ, DBATCH = 128, DSEQ = 4, MS = DBATCH * DSEQ, M = MP + MS;
constexpr int NIN = 9344, NH = 9472;
constexpr int RW = 512, SHIFTC = 1664;
constexpr int C_R = 0, C_K = 512, C_V = 1024, C_WD = 1536, C_AD = 1600, C_ZR = 1792, C_AQ = 2304, C_AK = 3840, C_AV = 5376, C_ZA = 6912, C_GR = 7424, C_GA = 8448;
constexpr float LN_EPS = 1e-5f, GN_EPS = 64e-5f;
constexpr float ALPHA = 1.189207115002721f;
constexpr float ATT_SCALE = 0.08838834764831845f;
constexpr size_t O_YP = 0, O_YS = O_YP + (size_t)MP * DM, O_KV1P = O_YS + (size_t)MS * DM, O_KV1S = O_KV1P + (size_t)2 * 128 * 1024, O_KV2P = O_KV1S + (size_t)MS * 1024,
                 O_KV2S = O_KV2P + (size_t)2 * 512 * 1024, O_KV3P = O_KV2S + (size_t)MS * 1024, O_KV3S = O_KV3P + (size_t)2 * 2048 * 1024, O_WKVP = O_KV3S + (size_t)MS * 1024,
                 O_WKVS = O_WKVP + (size_t)2 * 8 * 64 * 64, O_SHP = O_WKVS + (size_t)128 * 8 * 64 * 64, O_SHS = O_SHP + (size_t)2 * SHIFTC, O_END = O_SHS + (size_t)128 * SHIFTC;
static_assert(O_END == 28855552, "d_out size");

constexpr size_t MiB = 1u << 20;
constexpr size_t WS_CTL = 0, CTL_ZERO_BYTES = 1 * MiB;
constexpr size_t WS_WIN = 2 * MiB, WS_WOA = 22 * MiB, WS_WOB = 23 * MiB, WS_WOUT = 24 * MiB;
constexpr size_t WS_XB = 32 * MiB, WS_H = 96 * MiB, WS_YR = 416 * MiB, WS_YA = 448 * MiB, WS_MIX = 480 * MiB, WS_MIXF = 528 * MiB, WS_PRE = 608 * MiB;
constexpr size_t WS_RR = 704 * MiB, WS_DEC = 744 * MiB, WS_K2 = 784 * MiB, WS_VV = 824 * MiB, WS_KK = 864 * MiB, WS_KA = 904 * MiB, WS_OO = 944 * MiB;
constexpr size_t WS_W2T = 26 * MiB, WS_A2T = 27 * MiB;
constexpr size_t WS_QE = 984 * MiB, WS_PT = 1000 * MiB, WS_S0B = 1016 * MiB, WS_OL = 1032 * MiB, WS_SL = 1064 * MiB, WS_VMX = 1096 * MiB, WS_BON = 1112 * MiB, WS_AO = 1120 * MiB  , WS_LSE = 1172 * MiB  , WS_END = 1174 * MiB;
static_assert(WS_WIN + (size_t)NH * DM * 2 <= WS_WOA && WS_XB + (size_t)M * DM * 2 <= WS_H && WS_H + (size_t)M * NH * 2 <= WS_YR, "ws map");
constexpr int CW_TMO = 0, CW_CODE = 1, CW_Q = 2048, CW_BAR = 4096;

constexpr int RING_OFF = 0, RING_BYTES = 131072;
constexpr int LDSCTL_OFF = 146432, MISC_OFF = LDSCTL_OFF + 320;
constexpr int LDS_BYTES = 147456;
#define GAS __attribute__((address_space(1)))
#define LAS __attribute__((address_space(3)))
typedef unsigned short bf16;
typedef unsigned v4u __attribute__((ext_vector_type(4)));
typedef float f32x4 __attribute__((ext_vector_type(4)));
typedef short bf16x8 __attribute__((ext_vector_type(8)));
typedef GAS unsigned gu32;
typedef GAS unsigned long long gu64;
#define RLX_AGENT __ATOMIC_RELAXED, __HIP_MEMORY_SCOPE_AGENT
#define LDS_WAIT() asm volatile("s_waitcnt lgkmcnt(0)" ::: "memory")
#define VM_WAIT() asm volatile("s_waitcnt vmcnt(0)" ::: "memory")
__device__ __forceinline__ unsigned long long rt() { return __builtin_amdgcn_s_memrealtime(); }
__device__ __forceinline__ unsigned f2bf(float f) { unsigned u = __builtin_bit_cast(unsigned, f); return (u + 0x7fffu + ((u >> 16) & 1u)) >> 16; }
__device__ __forceinline__ unsigned pk2(float lo, float hi) { return f2bf(lo) | (f2bf(hi) << 16); }

#define XB_TMO      128
#define XB_XCNT(j)  (256  + 64 * (j))
#define XB_XSUB(j)  (1280 + 64 * (j))
#define XB_XGEN(j)  (2304 + 64 * (j))
#define XB_TOP      3328
#define XB_TOPGEN   3392
#define XCD_BAR_WORDS 3456
#define XB_SPIN_CAP (1u << 18)

__device__ __forceinline__ unsigned xb_ld(unsigned* p)              { return __hip_atomic_load(p, __ATOMIC_RELAXED, __HIP_MEMORY_SCOPE_AGENT); }
__device__ __forceinline__ unsigned xb_add(unsigned* p, unsigned v) { return __hip_atomic_fetch_add(p, v, __ATOMIC_RELAXED, __HIP_MEMORY_SCOPE_AGENT); }
__device__ __forceinline__ unsigned xb_xcc_id() { return (unsigned)__builtin_amdgcn_s_getreg((3 << 11) | 20) & 0xFu; }
#define XB_SPIN(cond, bar) do { unsigned _sp = 0; while (cond) { __builtin_amdgcn_s_sleep(1); \
    if ((++_sp & 255u) == 0u) { if (xb_ld(&(bar)[XB_TMO])) break; if (_sp > XB_SPIN_CAP) { atomicAdd(&(bar)[XB_TMO], 1u); break; } } } } while (0)

struct XcdBarrier {
    unsigned* bar; unsigned x;
    volatile LAS unsigned* st;
};

__device__ __forceinline__ XcdBarrier xcd_barrier_post(unsigned* bar, volatile LAS unsigned* st) {
    XcdBarrier b; b.bar = bar; b.x = xb_xcc_id(); b.st = st;
    if (threadIdx.x == 0) (void)xb_add(&bar[XB_XCNT(b.x)], 1u);
    return b;
}
__device__ __forceinline__ void xcd_barrier_complete(unsigned* bar, unsigned x, unsigned& nloc, unsigned& nx) {
    const unsigned G = gridDim.x * gridDim.y * gridDim.z;
    unsigned sum, cnt, mine, sp = 0u;
    for (;;) {
        sum = 0u; cnt = 0u; mine = 0u;
#pragma unroll
        for (unsigned j = 0; j < 16; ++j) { const unsigned c = xb_ld(&bar[XB_XCNT(j)]); sum += c; cnt += (c > 0u) ? 1u : 0u; mine = (j == x) ? c : mine; }
        if (sum == G) break;
        __builtin_amdgcn_s_sleep(1);
        if ((++sp & 255u) == 0u) { if (xb_ld(&bar[XB_TMO])) break; if (sp > XB_SPIN_CAP) { atomicAdd(&bar[XB_TMO], 1u); break; } }
    }
    nloc = mine > 0u ? mine : 1u; nx = cnt > 0u ? cnt : 1u;
}

__device__ __forceinline__ void xcd_barrier(const XcdBarrier& b) {
    asm volatile("s_waitcnt vmcnt(0)" ::: "memory");
    __syncthreads();
    if (threadIdx.x == 0) {
        unsigned* bar = b.bar;
        __builtin_amdgcn_s_waitcnt(0);
        unsigned nloc = b.st[0], nx = b.st[1];
        if (nloc == 0u) { xcd_barrier_complete(bar, b.x, nloc, nx); b.st[0] = nloc; b.st[1] = nx; }
        const unsigned old = xb_add(&bar[XB_XSUB(b.x)], 1u);
        const unsigned gen = old / nloc;
        if (old + 1u == (gen + 1u) * nloc) {
            __builtin_amdgcn_fence(__ATOMIC_RELEASE, "agent");
            asm volatile("s_waitcnt vmcnt(0)" ::: "memory");
            const unsigned og = xb_add(&bar[XB_TOP], 1u);
            const unsigned tg = og / nx;
            if (og + 1u == (tg + 1u) * nx) xb_add(&bar[XB_TOPGEN], 1u);
            else XB_SPIN(xb_ld(&bar[XB_TOPGEN]) == tg, bar);
            __builtin_amdgcn_fence(__ATOMIC_ACQUIRE, "agent");
            xb_add(&bar[XB_XGEN(b.x)], 1u);
            asm volatile("s_waitcnt vmcnt(0)" ::: "memory");
        } else {
            XB_SPIN(xb_ld(&bar[XB_XGEN(b.x)]) == gen, bar);
            __builtin_amdgcn_fence(__ATOMIC_ACQUIRE, "agent");
            asm volatile("s_waitcnt vmcnt(0)" ::: "memory");
        }
    }
    __syncthreads();
}

typedef unsigned u32x2 __attribute__((ext_vector_type(2)));
__device__ __forceinline__ float bf2f(unsigned b) { return __builtin_bit_cast(float, b << 16); }
__device__ __forceinline__ float wave_sum(float v) {
#pragma unroll
    for (int o = 1; o < 64; o <<= 1) v += __shfl_xor(v, o);
    return v;
}
__device__ __forceinline__ float wave_max(float v) {
#pragma unroll
    for (int o = 1; o < 64; o <<= 1) v = fmaxf(v, __shfl_xor(v, o));
    return v;
}
__device__ __forceinline__ float sigmoidf_(float x) { return 1.0f / (1.0f + __expf(-x)); }
__device__ __forceinline__ float siluf_(float x) { return x / (1.0f + __expf(-x)); }

namespace pg8 {
struct EpiH {
    static constexpr bool PERM = true, AFTER_DRAIN = false;
    bf16_t* H; const float* bgate; float* out;
    __device__ __forceinline__ void operator()(const f32x4 (&acc)[2][2][4][2], const Unit& u, int wr, int wc, int fr, int fq) const {
        const int pn = u.pn;
        const int row0 = u.pm * BM + wr * 64 + fr, cw = wc * 32 + 8 * fq;
        const int mode = (pn >= 29) ? 2 : ((pn == 7 || pn == 8 || pn == 27 || pn == 28) ? 1 : 0);
        const bool is_zs = pn <= 6, is_kv = (pn >= 15 && pn <= 26);
        int kvsel = 0, g = 0, hcb = 0;
        if (is_kv) { int q = pn - 15; kvsel = q >= 6 ? 1 : 0; q = q >= 6 ? q - 6 : q; g = q >> 1; hcb = (q & 1) * 256; }
        const int keep = 128 << (2 * g);
        float* kvp = out + (g == 0 ? O_KV1P : (g == 1 ? O_KV2P : O_KV3P));
        float* kvs = out + (g == 0 ? O_KV1S : (g == 1 ? O_KV2S : O_KV3S));
        f32x4 bv[2][2];
#pragma unroll
        for (int bj = 0; bj < 2; ++bj)
#pragma unroll
            for (int n = 0; n < 2; ++n) bv[bj][n] = (mode == 2) ? *(const f32x4*)(bgate + (pn * BM + bj * HALF + cw - C_GR) + 4 * n) : (f32x4){0.f, 0.f, 0.f, 0.f};
#pragma unroll
        for (int ai = 0; ai < 2; ++ai)
#pragma unroll
            for (int m = 0; m < 4; ++m) {
                const int row = row0 + ai * HALF + m * 16;
                bf16_t* rowp = H + (size_t)row * NH + pn * BM + cw;
#pragma unroll
                for (int bj = 0; bj < 2; ++bj) {
                    f32x4 v0 = acc[ai][bj][m][0], v1 = acc[ai][bj][m][1];
                    const int col = pn * BM + bj * HALF + cw;
                    if (is_zs && col < SHIFTC) {
                        float* dst = nullptr;
                        if (row < MP) { if ((row & (SEQ - 1)) == SEQ - 1) dst = out + O_SHP + (size_t)(row >> 13) * SHIFTC + col; }
                        else if (((row - MP) & 3) == 3) dst = out + O_SHS + (size_t)((row - MP) >> 2) * SHIFTC + col;
                        if (dst) { *(f32x4*)dst = v0; *(f32x4*)(dst + 4) = v1; }
                    }
                    if (is_kv) {
                        const int hc = hcb + bj * HALF + cw;
                        float* dst = nullptr;
                        if (row < MP) { const int t = row & (SEQ - 1), b = row >> 13; if (t >= SEQ - keep) dst = kvp + ((size_t)(b * keep + t - (SEQ - keep)) * 2 + kvsel) * 512 + hc; }
                        else dst = kvs + ((size_t)(row - MP) * 2 + kvsel) * 512 + hc;
                        if (dst) { *(f32x4*)dst = v0; *(f32x4*)(dst + 4) = v1; }
                    }
                    if (mode == 1) {
#pragma unroll
                        for (int j = 0; j < 4; ++j) { v0[j] = siluf_(v0[j]); v1[j] = siluf_(v1[j]); }
                    } else if (mode == 2) {
                        v0 = v0 + bv[bj][0]; v1 = v1 + bv[bj][1];
#pragma unroll
                        for (int j = 0; j < 4; ++j) { v0[j] = sigmoidf_(v0[j]); v1[j] = sigmoidf_(v1[j]); }
                    }
                    u32x4 w; w.x = cvt_pk_bf16(v0[0], v0[1]); w.y = cvt_pk_bf16(v0[2], v0[3]); w.z = cvt_pk_bf16(v1[0], v1[1]); w.w = cvt_pk_bf16(v1[2], v1[3]);
                    *(u32x4*)(rowp + bj * HALF) = w;
                }
            }
    }
};
struct EpiMixA {
    static constexpr bool PERM = false, AFTER_DRAIN = false;
    const bf16_t* H; float* MIXF;
    __device__ __forceinline__ void operator()(const f32x4 (&acc)[2][2][4][2], const Unit& u, int wr, int wc, int fr, int fq) const {
        const int row0 = u.pm * BM + wr * 64 + fr, col0 = u.pn * BM + wc * 32 + 4 * fq;
#pragma unroll
        for (int ai = 0; ai < 2; ++ai)
#pragma unroll
            for (int m = 0; m < 4; ++m) { const int row = row0 + ai * HALF + m * 16;
#pragma unroll
                for (int bj = 0; bj < 2; ++bj)
#pragma unroll
                    for (int n = 0; n < 2; ++n) { const int c = col0 + bj * HALF + n * 16;
                        const u32x2 gb = *(const u32x2*)(H + (size_t)row * NH + C_GR + c);
                        f32x4 gt = {bf2f(gb.x & 0xffffu), bf2f(gb.x >> 16), bf2f(gb.y & 0xffffu), bf2f(gb.y >> 16)};
                        *(f32x4*)(MIXF + (size_t)row * DM + c) = gt * acc[ai][bj][m][n]; } }
    }
};
struct EpiMixB {
    static constexpr bool PERM = false, AFTER_DRAIN = false;
    const bf16_t* H; const float* MIXF; bf16_t* MIX;
    __device__ __forceinline__ void operator()(const f32x4 (&acc)[2][2][4][2], const Unit& u, int wr, int wc, int fr, int fq) const {
        const int row0 = u.pm * BM + wr * 64 + fr, col0 = u.pn * BM + wc * 32 + 4 * fq;
#pragma unroll
        for (int ai = 0; ai < 2; ++ai)
#pragma unroll
            for (int m = 0; m < 4; ++m) { const int row = row0 + ai * HALF + m * 16;
#pragma unroll
                for (int bj = 0; bj < 2; ++bj)
#pragma unroll
                    for (int n = 0; n < 2; ++n) { const int c = col0 + bj * HALF + n * 16;
                        const u32x2 gb = *(const u32x2*)(H + (size_t)row * NH + C_GA + c);
                        f32x4 gt = {bf2f(gb.x & 0xffffu), bf2f(gb.x >> 16), bf2f(gb.y & 0xffffu), bf2f(gb.y >> 16)};
                        const f32x4 v = *(const f32x4*)(MIXF + (size_t)row * DM + c) + gt * acc[ai][bj][m][n];
                        u32x2 w; w.x = cvt_pk_bf16(v[0], v[1]); w.y = cvt_pk_bf16(v[2], v[3]);
                        *(u32x2*)(MIX + (size_t)row * DM + c) = w; } }
    }
};
struct EpiPre {
    static constexpr bool PERM = false, AFTER_DRAIN = false;
    const float* xp; const float* xs; float* PRE;
    __device__ __forceinline__ void operator()(const f32x4 (&acc)[2][2][4][2], const Unit& u, int wr, int wc, int fr, int fq) const {
        const int row0 = u.pm * BM + wr * 64 + fr, col0 = u.pn * BM + wc * 32 + 4 * fq;
#pragma unroll
        for (int ai = 0; ai < 2; ++ai)
#pragma unroll
            for (int m = 0; m < 4; ++m) { const int row = row0 + ai * HALF + m * 16;
                const float* xr = row < MP ? xp + (size_t)row * DM : xs + (size_t)(row - MP) * DM;
#pragma unroll
                for (int bj = 0; bj < 2; ++bj)
#pragma unroll
                    for (int n = 0; n < 2; ++n) { const int c = col0 + bj * HALF + n * 16;
                        *(f32x4*)(PRE + (size_t)row * DM + c) = *(const f32x4*)(xr + c) * ALPHA + acc[ai][bj][m][n]; } }
    }
};
}

struct Args { const float* in[24]; float* out; unsigned char* ws; int ph_lo, ph_hi; };
struct Frame {
    LAS unsigned char* lds;
    volatile LAS unsigned* MISC;
    gu32* ctl;
    int tid, lane, wave, G;
};
#define XP_(A) ((A).in[0])
#define XS_(A) ((A).in[1])
#define C1_(A) ((A).in[2])
#define C2_(A) ((A).in[3])
#define C3_(A) ((A).in[4])
#define WKV0_(A) ((A).in[5])
#define SHIFT0_(A) ((A).in[6])
#define W_IN_(A) ((A).in[7])
#define B_GATE_(A) ((A).in[8])
#define MU_(A) ((A).in[9])
#define W0_(A) ((A).in[10])
#define W_W2_(A) ((A).in[11])
#define A0_(A) ((A).in[12])
#define W_A2_(A) ((A).in[13])
#define K_K_(A) ((A).in[14])
#define K_A_(A) ((A).in[15])
#define R_K_(A) ((A).in[16])
#define LNX_G_(A) ((A).in[17])
#define LNX_B_(A) ((A).in[18])
#define W_OA_(A) ((A).in[19])
#define W_OB_(A) ((A).in[20])
#define W_OUT_(A) ((A).in[21])
#define LN_G_(A) ((A).in[22])
#define LN_B_(A) ((A).in[23])
#define WSB_(A, off) ((bf16*)((A).ws + (off)))
#define WSF_(A, off) ((float*)((A).ws + (off)))

__device__ __forceinline__ void p0_transpose_item(const float* W, int K, int N, bf16* WT, int split_at, int split_add, LAS float* scr, int item, int lane) {
    const int nblk = N / 32, kb = item / nblk, nb = item % nblk, k0 = 64 * kb, n0 = 32 * nb;
    const int radd = n0 >= split_at ? split_add : 0;
#pragma unroll 8
    for (int i = 0; i < 32; ++i) { const int kk = 2 * i + (lane >> 5); scr[kk * 33 + (lane & 31)] = W[(size_t)(k0 + kk) * N + n0 + (lane & 31)]; }
    LDS_WAIT(); asm volatile("" ::: "memory");
    const int c = lane & 7;
#pragma unroll
    for (int j = 0; j < 4; ++j) { const int n = (lane >> 3) + 8 * j; const LAS float* s = scr + (8 * c) * 33 + n;
        v4u o; o.x = pk2(s[0 * 33], s[1 * 33]); o.y = pk2(s[2 * 33], s[3 * 33]); o.z = pk2(s[4 * 33], s[5 * 33]); o.w = pk2(s[6 * 33], s[7 * 33]);
        *(GAS v4u*)(WT + (size_t)(radd + n0 + n) * K + k0 + 8 * c) = o; }
    LDS_WAIT(); asm volatile("" ::: "memory");
}
__device__ __forceinline__ void p0_prologue(Frame& F, const Args& A) {
    LAS float* scr = (LAS float*)(F.lds + RING_OFF + F.wave * 16384);
    const int gw = blockIdx.x * NWAVES + F.wave, NGW = F.G * NWAVES;
    constexpr int I_IN = (DM / 64) * (NIN / 32), I_OA = (RW / 64) * (DM / 32), I_OUT = (DM / 64) * (DM / 32);
    constexpr int I_LR = (RW / 32);
    constexpr int NITEMS = I_IN + 2 * I_OA + I_OUT + 2 * I_LR;
    for (int it = gw; it < NITEMS; it += NGW) {
        int r = it;
        if (r < I_IN) { p0_transpose_item(W_IN_(A), DM, NIN, WSB_(A, WS_WIN), SHIFTC, 128, scr, r, F.lane); continue; } r -= I_IN;
        if (r < I_OA) { p0_transpose_item(W_OA_(A), RW, DM, WSB_(A, WS_WOA), 1 << 30, 0, scr, r, F.lane); continue; } r -= I_OA;
        if (r < I_OA) { p0_transpose_item(W_OB_(A), RW, DM, WSB_(A, WS_WOB), 1 << 30, 0, scr, r, F.lane); continue; } r -= I_OA;
        if (r < I_OUT) { p0_transpose_item(W_OUT_(A), DM, DM, WSB_(A, WS_WOUT), 1 << 30, 0, scr, r, F.lane); continue; } r -= I_OUT;
        if (r < I_LR) { p0_transpose_item(W_W2_(A), 64, RW, WSB_(A, WS_W2T), 1 << 30, 0, scr, r, F.lane); continue; } r -= I_LR;
        p0_transpose_item(W_A2_(A), 64, RW, WSB_(A, WS_A2T), 1 << 30, 0, scr, r, F.lane);
    }
    const size_t gt = (size_t)blockIdx.x * 512 + F.tid, GT = (size_t)F.G * 512;
    for (size_t i = gt; i < (size_t)128 * DM / 8; i += GT) *(GAS v4u*)(WSB_(A, WS_WIN) + (size_t)SHIFTC * DM + i * 8) = (v4u){0u, 0u, 0u, 0u};
    for (size_t i = gt; i < (size_t)M * DM / 8; i += GT) {
        const size_t e = i * 8; const float* src = e < (size_t)MP * DM ? XP_(A) + e : XS_(A) + (e - (size_t)MP * DM);
        const f32x4 a = *(const GAS f32x4*)src, b = *(const GAS f32x4*)(src + 4);
        v4u o; o.x = pk2(a.x, a.y); o.y = pk2(a.z, a.w); o.z = pk2(b.x, b.y); o.w = pk2(b.z, b.w);
        *(GAS v4u*)(WSB_(A, WS_XB) + e) = o;
    }
}

__device__ __forceinline__ void ld8bf(const bf16* p, float (&v)[8]) {
    const v4u w = *(const GAS v4u*)p;
    v[0] = bf2f(w.x & 0xffffu); v[1] = bf2f(w.x >> 16); v[2] = bf2f(w.y & 0xffffu); v[3] = bf2f(w.y >> 16);
    v[4] = bf2f(w.z & 0xffffu); v[5] = bf2f(w.z >> 16); v[6] = bf2f(w.w & 0xffffu); v[7] = bf2f(w.w >> 16);
}
__device__ __forceinline__ void ld8f(const float* p, float (&v)[8]) {
    const f32x4 a = *(const GAS f32x4*)p, b = *(const GAS f32x4*)(p + 4);
    v[0] = a.x; v[1] = a.y; v[2] = a.z; v[3] = a.w; v[4] = b.x; v[5] = b.y; v[6] = b.z; v[7] = b.w;
}
__device__ __forceinline__ void st8f(float* p, const float (&v)[8]) {
    *(GAS f32x4*)p = (f32x4){v[0], v[1], v[2], v[3]}; *(GAS f32x4*)(p + 4) = (f32x4){v[4], v[5], v[6], v[7]};
}
__device__ __forceinline__ void mixed8(Frame& F, const Args& A, int m, int c0, float (&z)[8]) {
    ld8bf(WSB_(A, WS_H) + (size_t)m * NH + c0, z);
    float p[8], mu[8];
    bool first; int sb = 0;
    if (m < MP) first = (m & (SEQ - 1)) == 0; else { first = ((m - MP) & 3) == 0; sb = (m - MP) >> 2; }
    if (!first) ld8bf(WSB_(A, WS_H) + (size_t)(m - 1) * NH + c0, p);
    else if (m < MP) {
#pragma unroll
        for (int j = 0; j < 8; ++j) p[j] = 0.f;
    } else ld8f(SHIFT0_(A) + (size_t)sb * SHIFTC + c0, p);
    ld8f(MU_(A) + c0, mu);
#pragma unroll
    for (int j = 0; j < 8; ++j) z[j] = z[j] + mu[j] * (p[j] - z[j]);
}
__device__ __forceinline__ void rwkv_prep_row(Frame& F, const Args& A, int m) {
    const int lane = F.lane, c0 = lane * 8;
    float r[8], k[8], v[8];
    mixed8(F, A, m, C_R + c0, r); mixed8(F, A, m, C_K + c0, k); mixed8(F, A, m, C_V + c0, v);
    float wa8[8];
#pragma unroll
    for (int j = 0; j < 8; ++j) wa8[j] = 0.f;
    if (lane < 16) mixed8(F, A, m, C_WD + c0, wa8);
    float wdl = 0.f, adl = 0.f;
#pragma unroll
    for (int j = 0; j < 8; ++j) { const float a = __shfl(wa8[j], lane >> 3), b = __shfl(wa8[j], 8 + (lane >> 3)); if ((lane & 7) == j) { wdl = a; adl = b; } }
    wdl = tanhf(wdl);
    float wp[8], ap[8];
#pragma unroll
    for (int j = 0; j < 8; ++j) { wp[j] = 0.f; ap[j] = 0.f; }
    for (int j = 0; j < 64; ++j) {
        const float tw = __shfl(wdl, j), ta = __shfl(adl, j);
        float w2[8], a2[8]; ld8f(W_W2_(A) + (size_t)j * RW + c0, w2); ld8f(W_A2_(A) + (size_t)j * RW + c0, a2);
#pragma unroll
        for (int q = 0; q < 8; ++q) { wp[q] += tw * w2[q]; ap[q] += ta * a2[q]; }
    }
    float w0[8], a0[8], kkc[8], kac[8];
    ld8f(W0_(A) + c0, w0); ld8f(A0_(A) + c0, a0); ld8f(K_K_(A) + c0, kkc); ld8f(K_A_(A) + c0, kac);
    float dec[8], kk[8], ka[8], k2[8]; float ss = 0.f;
#pragma unroll
    for (int j = 0; j < 8; ++j) {
        const float x = -(w0[j] + wp[j]);
        const float sp = fmaxf(x, 0.f) + log1pf(__expf(-fabsf(x)));
        const float w = -sp - 0.5f;
        dec[j] = __expf(-__expf(w));
        const float a = sigmoidf_(a0[j] + ap[j]);
        kk[j] = k[j] * kkc[j]; ss += kk[j] * kk[j];
        k2[j] = k[j] * (1.0f + (a - 1.0f) * kac[j]);
        ka[j] = a;
    }
    ss += __shfl_xor(ss, 1); ss += __shfl_xor(ss, 2); ss += __shfl_xor(ss, 4);
    const float inv = 1.0f / fmaxf(sqrtf(ss), 1e-12f);
#pragma unroll
    for (int j = 0; j < 8; ++j) { kk[j] *= inv; ka[j] *= kk[j]; }
    const size_t o = (size_t)m * RW + c0;
    st8f(WSF_(A, WS_RR) + o, r); st8f(WSF_(A, WS_DEC) + o, dec); st8f(WSF_(A, WS_K2) + o, k2); st8f(WSF_(A, WS_VV) + o, v); st8f(WSF_(A, WS_KK) + o, kk); st8f(WSF_(A, WS_KA) + o, ka);
}

template <bool PROMPT>
__device__ __forceinline__ void attn_item(Frame& F, const Args& A, int m, int h, LAS float* sq, LAS float* sp) {
    const int lane = F.lane;
    int b, t; if (PROMPT) { b = m >> 13; t = m & (SEQ - 1); } else { b = (m - MP) >> 2; t = (m - MP) & 3; }
    float og[3][2], lse[3];
#pragma unroll
    for (int g = 0; g < 3; ++g) {
        const int d = 1 << (2 * g), Wb = 128 << (2 * g);
        const float* cache = g == 0 ? C1_(A) : (g == 1 ? C2_(A) : C3_(A));
        const int hoff = g * 512 + h * 128;
        { const unsigned qq = *(const GAS unsigned*)(WSB_(A, WS_H) + (size_t)m * NH + C_AQ + hoff + 2 * lane); sq[2 * lane] = bf2f(qq & 0xffffu); sq[2 * lane + 1] = bf2f(qq >> 16); }
        LDS_WAIT(); asm volatile("" ::: "memory");
        float s[3];
#pragma unroll
        for (int kx = 0; kx < 3; ++kx) {
            const int j = lane + 64 * kx; float sc = -1e30f;
            if (kx < 2 || lane == 0) {
                const bf16* kr = nullptr; const float* kf = nullptr;
                if (PROMPT) { const int tk = t - j * d; if (tk >= 0) kr = WSB_(A, WS_H) + (size_t)(b * SEQ + tk) * NH + C_AK + hoff; }
                else { const int idx = Wb + t - j * d; if (idx >= Wb) kr = WSB_(A, WS_H) + (size_t)(MP + b * DSEQ + idx - Wb) * NH + C_AK + hoff; else kf = cache + ((size_t)(b * Wb + idx) * 2 + 0) * 512 + h * 128; }
                if (kr) { float a = 0.f;
                    for (int e = 0; e < 128; e += 8) { float kv[8]; ld8bf(kr + e, kv);
#pragma unroll
                        for (int q = 0; q < 8; ++q) a += sq[e + q] * kv[q]; }
                    sc = a * ATT_SCALE; }
                else if (kf) { float a = 0.f;
                    for (int e = 0; e < 128; e += 8) { float kv[8]; ld8f(kf + e, kv);
#pragma unroll
                        for (int q = 0; q < 8; ++q) a += sq[e + q] * kv[q]; }
                    sc = a * ATT_SCALE; }
            }
            s[kx] = sc;
        }
        const float mx = wave_max(fmaxf(fmaxf(s[0], s[1]), s[2]));
        float p[3]; float ls = 0.f;
#pragma unroll
        for (int kx = 0; kx < 3; ++kx) { p[kx] = s[kx] > -1e29f ? __expf(s[kx] - mx) : 0.f; ls += p[kx]; }
        const float l = wave_sum(ls);
        sp[lane] = p[0]; sp[lane + 64] = p[1]; if (lane == 0) sp[128] = p[2];
        LDS_WAIT(); asm volatile("" ::: "memory");
        float a0 = 0.f, a1 = 0.f;
        for (int j = 0; j < 129; ++j) {
            const float pj = sp[j];
            if (PROMPT) { const int tk = t - j * d; if (tk >= 0) { const unsigned vv = *(const GAS unsigned*)(WSB_(A, WS_H) + (size_t)(b * SEQ + tk) * NH + C_AV + hoff + 2 * lane); a0 += pj * bf2f(vv & 0xffffu); a1 += pj * bf2f(vv >> 16); } }
            else { const int idx = Wb + t - j * d;
                if (idx >= Wb) { const unsigned vv = *(const GAS unsigned*)(WSB_(A, WS_H) + (size_t)(MP + b * DSEQ + idx - Wb) * NH + C_AV + hoff + 2 * lane); a0 += pj * bf2f(vv & 0xffffu); a1 += pj * bf2f(vv >> 16); }
                else { const float* vf = cache + ((size_t)(b * Wb + idx) * 2 + 1) * 512 + h * 128 + 2 * lane; a0 += pj * vf[0]; a1 += pj * vf[1]; } }
        }
        const float il = 1.0f / l;
        og[g][0] = a0 * il; og[g][1] = a1 * il; lse[g] = mx + __logf(l);
        LDS_WAIT(); asm volatile("" ::: "memory");
    }
    const float ml = fmaxf(fmaxf(lse[0], lse[1]), lse[2]);
    const float w0 = __expf(lse[0] - ml), w1 = __expf(lse[1] - ml), w2 = __expf(lse[2] - ml), iw = 1.0f / (w0 + w1 + w2);
    const unsigned zz = *(const GAS unsigned*)(WSB_(A, WS_H) + (size_t)m * NH + C_ZA + h * 128 + 2 * lane);
    const float y0 = (w0 * og[0][0] + w1 * og[1][0] + w2 * og[2][0]) * iw * bf2f(zz & 0xffffu);
    const float y1 = (w0 * og[0][1] + w1 * og[1][1] + w2 * og[2][1]) * iw * bf2f(zz >> 16);
    *(GAS unsigned*)(WSB_(A, WS_YA) + (size_t)m * RW + h * 128 + 2 * lane) = pk2(y0, y1);
}

__device__ __forceinline__ void scan_item(Frame& F, const Args& A, int item) {
    const int lane = F.lane;
    int T, row0, h; float* sout; const float* s0 = nullptr;
    if (item < 16) { const int b = item >> 3; h = item & 7; T = SEQ; row0 = b * SEQ; sout = A.out + O_WKVP + ((size_t)(b * 8 + h) * 64 + lane) * 64; }
    else { const int s = item - 16, b = s >> 3; h = s & 7; T = DSEQ; row0 = MP + b * DSEQ; sout = A.out + O_WKVS + ((size_t)(b * 8 + h) * 64 + lane) * 64; s0 = WKV0_(A) + ((size_t)(b * 8 + h) * 64 + lane) * 64; }
    float S[64];
#pragma unroll
    for (int k = 0; k < 64; k += 4) { f32x4 v = s0 ? *(const GAS f32x4*)(s0 + k) : (f32x4){0.f, 0.f, 0.f, 0.f}; S[k] = v.x; S[k + 1] = v.y; S[k + 2] = v.z; S[k + 3] = v.w; }
    for (int t = 0; t < T; ++t) {
        const size_t base = (size_t)(row0 + t) * RW + h * 64;
        const float vi = WSF_(A, WS_VV)[base + lane];
        float sa = 0.f;
#pragma unroll
        for (int k = 0; k < 64; k += 4) { const f32x4 q = *(const GAS f32x4*)(WSF_(A, WS_KK) + base + k); sa -= S[k] * q.x; sa -= S[k + 1] * q.y; sa -= S[k + 2] * q.z; sa -= S[k + 3] * q.w; if ((k & 15) == 12) asm volatile("" ::: "memory"); }
        float o = 0.f;
#pragma unroll
        for (int k = 0; k < 64; k += 4) {
            const f32x4 dc = *(const GAS f32x4*)(WSF_(A, WS_DEC) + base + k), ka = *(const GAS f32x4*)(WSF_(A, WS_KA) + base + k), k2 = *(const GAS f32x4*)(WSF_(A, WS_K2) + base + k), rr = *(const GAS f32x4*)(WSF_(A, WS_RR) + base + k);
            S[k] = S[k] * dc.x + sa * ka.x + vi * k2.x; S[k + 1] = S[k + 1] * dc.y + sa * ka.y + vi * k2.y; S[k + 2] = S[k + 2] * dc.z + sa * ka.z + vi * k2.z; S[k + 3] = S[k + 3] * dc.w + sa * ka.w + vi * k2.w;
            o += S[k] * rr.x; o += S[k + 1] * rr.y; o += S[k + 2] * rr.z; o += S[k + 3] * rr.w;
            if ((k & 7) == 4) asm volatile("" ::: "memory");
        }
        WSF_(A, WS_OO)[base + lane] = o;
    }
#pragma unroll
    for (int k = 0; k < 64; k += 4) *(GAS f32x4*)(sout + k) = (f32x4){S[k], S[k + 1], S[k + 2], S[k + 3]};
}

__device__ __forceinline__ void rwkv_post_row(Frame& F, const Args& A, int m) {
    const int lane = F.lane, c0 = lane * 8; const size_t o = (size_t)m * RW + c0;
    float ov[8], r[8], k2[8], v[8], rk[8], g[8], bb[8], z[8];
    ld8f(WSF_(A, WS_OO) + o, ov); ld8f(WSF_(A, WS_RR) + o, r); ld8f(WSF_(A, WS_K2) + o, k2); ld8f(WSF_(A, WS_VV) + o, v); ld8f(R_K_(A) + c0, rk); ld8f(LNX_G_(A) + c0, g); ld8f(LNX_B_(A) + c0, bb);
    ld8bf(WSB_(A, WS_H) + (size_t)m * NH + C_ZR + c0, z);
    float s = 0.f, bs = 0.f;
#pragma unroll
    for (int j = 0; j < 8; ++j) { s += ov[j]; bs += r[j] * k2[j] * rk[j]; }
    s += __shfl_xor(s, 1); s += __shfl_xor(s, 2); s += __shfl_xor(s, 4);
    bs += __shfl_xor(bs, 1); bs += __shfl_xor(bs, 2); bs += __shfl_xor(bs, 4);
    const float mean = s * (1.0f / 64.0f); float q = 0.f;
#pragma unroll
    for (int j = 0; j < 8; ++j) { const float dlt = ov[j] - mean; q += dlt * dlt; }
    q += __shfl_xor(q, 1); q += __shfl_xor(q, 2); q += __shfl_xor(q, 4);
    const float rstd = 1.0f / sqrtf(q * (1.0f / 64.0f) + GN_EPS);
    float y[8];
#pragma unroll
    for (int j = 0; j < 8; ++j) y[j] = ((ov[j] - mean) * rstd * g[j] + bb[j] + bs * v[j]) * z[j];
    v4u w; w.x = pk2(y[0], y[1]); w.y = pk2(y[2], y[3]); w.z = pk2(y[4], y[5]); w.w = pk2(y[6], y[7]);
    *(GAS v4u*)(WSB_(A, WS_YR) + o) = w;
}

typedef short s16x4 __attribute__((ext_vector_type(4)));
typedef short v4i16_t __attribute__((ext_vector_type(4)));
constexpr int LDP = 72;
constexpr int ARRB = 64 * LDP * 2;
enum { A_AT = 0, A_BH, A_KH, A_RT, A_VQ, A_XA, A_XB, A_TA, A_TB, A_MAK, A_MRB, A_MRK, A_NARR };
constexpr int A_SMALL = A_NARR * ARRB;
static_assert(A_SMALL + 4096 <= RING_BYTES, "phase A LDS");
constexpr int NUNITS = 16 * 128;

__device__ __forceinline__ f32x4 mfma16(bf16x8 a, bf16x8 b, f32x4 c) { return __builtin_amdgcn_mfma_f32_16x16x32_bf16(a, b, c, 0, 0, 0); }
__device__ __forceinline__ bf16x8 frag_rows(const LAS bf16* X, int row0, int k0, int lane) { return *(const LAS bf16x8*)(X + (row0 + (lane & 15)) * LDP + k0 + 8 * (lane >> 4)); }
__device__ __forceinline__ bf16x8 frag_tr(const LAS bf16* X, int k0, int col0, int lane) {
    const int g = lane >> 4, i = lane & 15;
    const LAS bf16* a0 = X + (k0 + 8 * g + (i >> 2)) * LDP + col0 + 4 * (i & 3);
    const s16x4 lo = __builtin_bit_cast(s16x4, __builtin_amdgcn_ds_read_tr16_b64_v4i16((LAS v4i16_t*)a0));
    const s16x4 hi = __builtin_bit_cast(s16x4, __builtin_amdgcn_ds_read_tr16_b64_v4i16((LAS v4i16_t*)(a0 + 4 * LDP)));
    return __builtin_shufflevector(lo, hi, 0, 1, 2, 3, 4, 5, 6, 7);
}
__device__ __forceinline__ u32x2 pk4(f32x4 v) { u32x2 w; w.x = pk2(v[0], v[1]); w.y = pk2(v[2], v[3]); return w; }
__device__ __forceinline__ f32x4 up4(u32x2 w) { return (f32x4){bf2f(w.x & 0xffffu), bf2f(w.x >> 16), bf2f(w.y & 0xffffu), bf2f(w.y >> 16)}; }
__device__ __forceinline__ void st4(LAS bf16* X, int row, int col, f32x4 v) { *(LAS u32x2*)(X + row * LDP + col) = pk4(v); }
__device__ __forceinline__ f32x4 ld4(const LAS bf16* X, int row, int col) { return up4(*(const LAS u32x2*)(X + row * LDP + col)); }
__device__ __forceinline__ float dpp_shr(float x, int n) {
    const int iv = __builtin_bit_cast(int, x); int r;
    switch (n) { case 1: r = __builtin_amdgcn_update_dpp(0, iv, 0x111, 0xf, 0xf, true); break; case 2: r = __builtin_amdgcn_update_dpp(0, iv, 0x112, 0xf, 0xf, true); break;
                 case 4: r = __builtin_amdgcn_update_dpp(0, iv, 0x114, 0xf, 0xf, true); break; default: r = __builtin_amdgcn_update_dpp(0, iv, 0x118, 0xf, 0xf, true); break; }
    return __builtin_bit_cast(float, r);
}
__device__ __forceinline__ float row_scan(float x) { x += dpp_shr(x, 1); x += dpp_shr(x, 2); x += dpp_shr(x, 4); x += dpp_shr(x, 8); return x; }
__device__ __forceinline__ f32x4 mixed4(const bf16* H, const float* mu, int m, int col, bool first) {
    const f32x4 z = up4(*(const GAS u32x2*)(H + (size_t)m * NH + col));
    f32x4 p = {0.f, 0.f, 0.f, 0.f};
    if (!first) p = up4(*(const GAS u32x2*)(H + (size_t)(m - 1) * NH + col));
    const f32x4 mv = *(const GAS f32x4*)(mu + col);
    return z + mv * (p - z);
}
__device__ __forceinline__ void pq2(const LAS bf16* P, const LAS bf16* Q, int tt, int hf, int lane, f32x4 (&acc)[2]) {
#pragma unroll
    for (int ks = 0; ks < 2; ++ks) { const bf16x8 bp = frag_rows(P, 16 * tt, 32 * ks, lane);
#pragma unroll
        for (int j = 0; j < 2; ++j) acc[j] = mfma16(frag_tr(Q, 32 * ks, 16 * (2 * hf + j), lane), bp, acc[j]); }
}
#define WG_BAR() do { asm volatile("s_waitcnt vmcnt(0) lgkmcnt(0)" ::: "memory"); __builtin_amdgcn_s_barrier(); asm volatile("" ::: "memory"); } while (0)

__device__ __forceinline__ void rwkvA_unit(Frame& F, const Args& A, int unit) {
    const int lane = F.lane, w = F.wave, tt = w & 3, hf = w >> 2, i = lane & 15, g = lane >> 4;
    const int bh = unit >> 7, c = unit & 127, b = bh >> 3, h = bh & 7;
    const int t = 16 * tt + i, m = b * SEQ + c * 64 + t;
    const bool first = (c == 0) && (t == 0);
    LAS unsigned char* L = F.lds + RING_OFF;
#define ARR(k) ((LAS bf16*)(L + (k) * ARRB))
    LAS float* tot = (LAS float*)(L + A_SMALL); LAS float* gcl = tot + 256; LAS float* pss = gcl + 64; LAS float* pbn = pss + 128;
    const bf16* H = WSB_(A, WS_H);
    const float z4[4] = {0.f, 0.f, 0.f, 0.f}; (void)z4;
    f32x4 rv[2], kv[2], vv[2];
#pragma unroll
    for (int j = 0; j < 2; ++j) { const int cb = 16 * (2 * hf + j) + 4 * g;
        rv[j] = mixed4(H, MU_(A), m, C_R + h * 64 + cb, first); kv[j] = mixed4(H, MU_(A), m, C_K + h * 64 + cb, first); vv[j] = mixed4(H, MU_(A), m, C_V + h * 64 + cb, first);
        f32x4 wd = mixed4(H, MU_(A), m, C_WD + cb, first); const f32x4 ad = mixed4(H, MU_(A), m, C_AD + cb, first);
#pragma unroll
        for (int r = 0; r < 4; ++r) wd[r] = tanhf(wd[r]);
        st4(ARR(A_XA), t, cb, wd); st4(ARR(A_XB), t, cb, ad); }
    WG_BAR();
    f32x4 aw[2] = {{0.f, 0.f, 0.f, 0.f}, {0.f, 0.f, 0.f, 0.f}}, aa[2] = {{0.f, 0.f, 0.f, 0.f}, {0.f, 0.f, 0.f, 0.f}};
#pragma unroll
    for (int ks = 0; ks < 2; ++ks) { const bf16x8 btw = frag_rows(ARR(A_XA), 16 * tt, 32 * ks, lane), bad = frag_rows(ARR(A_XB), 16 * tt, 32 * ks, lane);
#pragma unroll
        for (int j = 0; j < 2; ++j) { const size_t wo = (size_t)(h * 64 + 16 * (2 * hf + j) + i) * 64 + 32 * ks + 8 * g;
            const bf16x8 a_w = *(const GAS bf16x8*)(WSB_(A, WS_W2T) + wo), a_a = *(const GAS bf16x8*)(WSB_(A, WS_A2T) + wo);
            aw[j] = mfma16(a_w, btw, aw[j]); aa[j] = mfma16(a_a, bad, aa[j]); } }
    f32x4 ld[2], av[2], kkr[2], k2[2], cum[2]; float ssq = 0.f, bon = 0.f;
#pragma unroll
    for (int j = 0; j < 2; ++j) { const int hc = h * 64 + 16 * (2 * hf + j) + 4 * g;
        const f32x4 w0 = *(const GAS f32x4*)(W0_(A) + hc), a0 = *(const GAS f32x4*)(A0_(A) + hc), kkc = *(const GAS f32x4*)(K_K_(A) + hc), kac = *(const GAS f32x4*)(K_A_(A) + hc), rkc = *(const GAS f32x4*)(R_K_(A) + hc);
#pragma unroll
        for (int r = 0; r < 4; ++r) {
            const float x = -(w0[r] + aw[j][r]); const float sp = fmaxf(x, 0.f) + log1pf(__expf(-fabsf(x)));
            ld[j][r] = -__expf(-sp - 0.5f);
            const float a = sigmoidf_(a0[r] + aa[j][r]); av[j][r] = a;
            kkr[j][r] = kv[j][r] * kkc[r]; ssq += kkr[j][r] * kkr[j][r];
            k2[j][r] = kv[j][r] * (1.0f + (a - 1.0f) * kac[r]);
            bon += rv[j][r] * k2[j][r] * rkc[r];
            cum[j][r] = row_scan(ld[j][r]);
        }
        if (i == 15) *(LAS f32x4*)(tot + tt * 64 + 16 * (2 * hf + j) + 4 * g) = cum[j]; }
    ssq += __shfl_xor(ssq, 16); ssq += __shfl_xor(ssq, 32); bon += __shfl_xor(bon, 16); bon += __shfl_xor(bon, 32);
    if (g == 0) { pss[w * 16 + i] = ssq; pbn[w * 16 + i] = bon; }
    WG_BAR();
    ssq = pss[w * 16 + i] + pss[(w ^ 4) * 16 + i]; bon = pbn[w * 16 + i] + pbn[(w ^ 4) * 16 + i];
    const float inv = 1.0f / fmaxf(sqrtf(ssq), 1e-12f);
#pragma unroll
    for (int j = 0; j < 2; ++j) { const int cb = 16 * (2 * hf + j) + 4 * g;
        f32x4 off = {0.f, 0.f, 0.f, 0.f}, all = {0.f, 0.f, 0.f, 0.f};
#pragma unroll
        for (int q = 0; q < 4; ++q) { const f32x4 tq = *(const LAS f32x4*)(tot + q * 64 + cb); all = all + tq; if (q < tt) off = off + tq; }
        f32x4 at, bhv, khv, rt;
#pragma unroll
        for (int r = 0; r < 4; ++r) { const float cm = cum[j][r] + off[r]; const float ep = __expf(cm), em = __expf(-cm), epv = __expf(cm - ld[j][r]); const float kk = kkr[j][r] * inv;
            at[r] = -kk * epv; bhv[r] = kk * av[j][r] * em; khv[r] = k2[j][r] * em; rt[r] = rv[j][r] * ep; }
        st4(ARR(A_AT), t, cb, at); st4(ARR(A_BH), t, cb, bhv); st4(ARR(A_KH), t, cb, khv); st4(ARR(A_RT), t, cb, rt); st4(ARR(A_VQ), t, cb, vv[j]);
        *(GAS u32x2*)(WSB_(A, WS_VMX) + (size_t)m * RW + h * 64 + cb) = pk4(vv[j]);
        if (tt == 0 && i == 0) { f32x4 gc; for (int r = 0; r < 4; ++r) gc[r] = __expf(all[r]); *(LAS f32x4*)(gcl + cb) = gc; } }
    if (hf == 0 && g == 0) WSF_(A, WS_BON)[(size_t)m * 8 + h] = bon;
    WG_BAR();
#pragma unroll
    for (int j = 0; j < 2; ++j) { const int mt = 2 * hf + j;
        f32x4 ab = {0.f, 0.f, 0.f, 0.f}, ak = ab, rb = ab, rk = ab;
        if (mt <= tt) {
#pragma unroll
            for (int ks = 0; ks < 2; ++ks) { const bf16x8 abh = frag_rows(ARR(A_BH), 16 * mt, 32 * ks, lane), akh = frag_rows(ARR(A_KH), 16 * mt, 32 * ks, lane), bat = frag_rows(ARR(A_AT), 16 * tt, 32 * ks, lane), brt = frag_rows(ARR(A_RT), 16 * tt, 32 * ks, lane);
                ab = mfma16(abh, bat, ab); ak = mfma16(akh, bat, ak); rb = mfma16(abh, brt, rb); rk = mfma16(akh, brt, rk); } }
        f32x4 t1;
#pragma unroll
        for (int r = 0; r < 4; ++r) { const int s = 16 * mt + 4 * g + r; const bool lt = s < t, le = s <= t;
            ab[r] = lt ? ab[r] : 0.f; ak[r] = lt ? ak[r] : 0.f; rb[r] = le ? rb[r] : 0.f; rk[r] = le ? rk[r] : 0.f; t1[r] = ab[r] + (s == t ? 1.0f : 0.f); }
        const int cb = 16 * mt + 4 * g;
        st4(ARR(A_XA), t, cb, ab); st4(ARR(A_TA), t, cb, t1); st4(ARR(A_MAK), t, cb, ak); st4(ARR(A_MRB), t, cb, rb); st4(ARR(A_MRK), t, cb, rk); }
    WG_BAR();
    const int cb0 = 16 * (2 * hf) + 4 * g, cb1 = cb0 + 16;
#define SQ_STAGE(XC, XN) do { f32x4 z[2] = {{0.f, 0.f, 0.f, 0.f}, {0.f, 0.f, 0.f, 0.f}}; pq2(ARR(XC), ARR(XC), tt, hf, lane, z); st4(ARR(XN), t, cb0, z[0]); st4(ARR(XN), t, cb1, z[1]); } while (0)
#define T_STAGE(TC, TN, XC) do { f32x4 z[2]; z[0] = ld4(ARR(TC), t, cb0); z[1] = ld4(ARR(TC), t, cb1); pq2(ARR(TC), ARR(XC), tt, hf, lane, z); st4(ARR(TN), t, cb0, z[0]); st4(ARR(TN), t, cb1, z[1]); } while (0)
    SQ_STAGE(A_XA, A_XB); WG_BAR();
    SQ_STAGE(A_XB, A_XA); T_STAGE(A_TA, A_TB, A_XB); WG_BAR();
    SQ_STAGE(A_XA, A_XB); T_STAGE(A_TB, A_TA, A_XA); WG_BAR();
    SQ_STAGE(A_XB, A_XA); T_STAGE(A_TA, A_TB, A_XB); WG_BAR();
    SQ_STAGE(A_XA, A_XB); T_STAGE(A_TB, A_TA, A_XA); WG_BAR();
    T_STAGE(A_TA, A_TB, A_XB); WG_BAR();
    { f32x4 z[2] = {{0.f, 0.f, 0.f, 0.f}, {0.f, 0.f, 0.f, 0.f}}; pq2(ARR(A_TB), ARR(A_AT), tt, hf, lane, z); st4(ARR(A_XA), t, cb0, z[0]); st4(ARR(A_XA), t, cb1, z[1]); }
    { f32x4 z[2] = {{0.f, 0.f, 0.f, 0.f}, {0.f, 0.f, 0.f, 0.f}}; pq2(ARR(A_MAK), ARR(A_VQ), tt, hf, lane, z); st4(ARR(A_TA), t, cb0, z[0]); st4(ARR(A_TA), t, cb1, z[1]); }
    WG_BAR();
    { f32x4 z[2] = {{0.f, 0.f, 0.f, 0.f}, {0.f, 0.f, 0.f, 0.f}}; pq2(ARR(A_TB), ARR(A_TA), tt, hf, lane, z); st4(ARR(A_XB), t, cb0, z[0]); st4(ARR(A_XB), t, cb1, z[1]); }
    WG_BAR();
    { f32x4 z[2]; z[0] = ld4(ARR(A_RT), t, cb0); z[1] = ld4(ARR(A_RT), t, cb1); pq2(ARR(A_MRB), ARR(A_XA), tt, hf, lane, z);
      bf16* qe = WSB_(A, WS_QE) + ((size_t)unit * 64 + t) * 64; *(GAS u32x2*)(qe + cb0) = pk4(z[0]); *(GAS u32x2*)(qe + cb1) = pk4(z[1]); }
    { f32x4 z[2] = {{0.f, 0.f, 0.f, 0.f}, {0.f, 0.f, 0.f, 0.f}}; pq2(ARR(A_MRB), ARR(A_XB), tt, hf, lane, z); pq2(ARR(A_MRK), ARR(A_VQ), tt, hf, lane, z);
      float* ol = WSF_(A, WS_OL) + ((size_t)unit * 64 + t) * 64; *(GAS f32x4*)(ol + cb0) = z[0]; *(GAS f32x4*)(ol + cb1) = z[1]; }
    {
      f32x4 p[2] = {{0.f, 0.f, 0.f, 0.f}, {0.f, 0.f, 0.f, 0.f}}, s[2] = {{0.f, 0.f, 0.f, 0.f}, {0.f, 0.f, 0.f, 0.f}};
#pragma unroll
      for (int ks = 0; ks < 2; ++ks) { const bf16x8 bbh = frag_tr(ARR(A_BH), 32 * ks, 16 * tt, lane), bul = frag_tr(ARR(A_XB), 32 * ks, 16 * tt, lane), bvq = frag_tr(ARR(A_VQ), 32 * ks, 16 * tt, lane);
#pragma unroll
          for (int j = 0; j < 2; ++j) { const int mt = 2 * hf + j;
              p[j] = mfma16(frag_tr(ARR(A_XA), 32 * ks, 16 * mt, lane), bbh, p[j]);
              s[j] = mfma16(frag_tr(ARR(A_BH), 32 * ks, 16 * mt, lane), bul, s[j]);
              s[j] = mfma16(frag_tr(ARR(A_KH), 32 * ks, 16 * mt, lane), bvq, s[j]); } }
      const float gkp = gcl[16 * tt + i];
      bf16* pt = WSB_(A, WS_PT) + ((size_t)unit * 64 + 16 * tt + i) * 64; float* sl = WSF_(A, WS_SL) + ((size_t)unit * 64 + 16 * tt + i) * 64;
#pragma unroll
      for (int j = 0; j < 2; ++j) { const int cb = 16 * (2 * hf + j) + 4 * g; const f32x4 gq = *(const LAS f32x4*)(gcl + cb);
#pragma unroll
          for (int r = 0; r < 4; ++r) { p[j][r] = gkp * (p[j][r] + ((cb + r) == (16 * tt + i) ? 1.0f : 0.f)); s[j][r] *= gq[r]; }
          *(GAS u32x2*)(pt + cb) = pk4(p[j]); *(GAS f32x4*)(sl + cb) = s[j]; } }
    WG_BAR();
#undef SQ_STAGE
#undef T_STAGE
#undef ARR
}

__device__ __forceinline__ void rwkv_carry(Frame& F, const Args& A, int bh) {
    const int lane = F.lane, w = F.wave, i = lane & 15, g = lane >> 4;
    if (w >= 4) return;
    const int v = 16 * w + i;
    f32x4 acc[4];
#pragma unroll
    for (int mt = 0; mt < 4; ++mt) acc[mt] = (f32x4){0.f, 0.f, 0.f, 0.f};
    u32x2 pa[4][2][2]; f32x4 sl[4];
    const bf16* PT = WSB_(A, WS_PT) + (size_t)bh * 128 * 4096; const float* SL = WSF_(A, WS_SL) + (size_t)bh * 128 * 4096; bf16* S0B = WSB_(A, WS_S0B) + (size_t)bh * 128 * 4096;
#define CARRY_LOAD(cc) do { const bf16* pp = PT + (size_t)(cc) * 4096; const float* ss = SL + (size_t)(cc) * 4096 + v * 64 + 4 * g; \
        _Pragma("unroll") for (int mt = 0; mt < 4; ++mt) { sl[mt] = *(const GAS f32x4*)(ss + 16 * mt); \
            _Pragma("unroll") for (int ks = 0; ks < 2; ++ks) { pa[mt][ks][0] = *(const GAS u32x2*)(pp + (16 * mt + i) * 64 + 32 * ks + 4 * g); pa[mt][ks][1] = *(const GAS u32x2*)(pp + (16 * mt + i) * 64 + 32 * ks + 16 + 4 * g); } } } while (0)
    CARRY_LOAD(0);
    for (int c = 0; c < 128; ++c) {
        u32x2 pc[4][2][2]; f32x4 sc[4];
#pragma unroll
        for (int mt = 0; mt < 4; ++mt) { sc[mt] = sl[mt];
#pragma unroll
            for (int ks = 0; ks < 2; ++ks) { pc[mt][ks][0] = pa[mt][ks][0]; pc[mt][ks][1] = pa[mt][ks][1]; } }
        if (c + 1 < 128) CARRY_LOAD(c + 1);
        bf16* s0 = S0B + (size_t)c * 4096 + v * 64 + 4 * g;
        u32x2 pk[4];
#pragma unroll
        for (int mt = 0; mt < 4; ++mt) { pk[mt] = pk4(acc[mt]); *(GAS u32x2*)(s0 + 16 * mt) = pk[mt]; }
#pragma unroll
        for (int ks = 0; ks < 2; ++ks) { const v4u bw = {pk[2 * ks].x, pk[2 * ks].y, pk[2 * ks + 1].x, pk[2 * ks + 1].y}; const bf16x8 bf = __builtin_bit_cast(bf16x8, bw);
#pragma unroll
            for (int mt = 0; mt < 4; ++mt) { const v4u aw4 = {pc[mt][ks][0].x, pc[mt][ks][0].y, pc[mt][ks][1].x, pc[mt][ks][1].y}; sc[mt] = mfma16(__builtin_bit_cast(bf16x8, aw4), bf, sc[mt]); } }
#pragma unroll
        for (int mt = 0; mt < 4; ++mt) acc[mt] = sc[mt];
    }
#undef CARRY_LOAD
    float* so = A.out + O_WKVP + ((size_t)bh * 64 + v) * 64 + 4 * g;
#pragma unroll
    for (int mt = 0; mt < 4; ++mt) *(GAS f32x4*)(so + 16 * mt) = acc[mt];
}

__device__ __forceinline__ void rwkvC_unit(Frame& F, const Args& A, int unit) {
    const int lane = F.lane, tt = F.wave & 3, i = lane & 15, g = lane >> 4;
    const int bh = unit >> 7, c = unit & 127, b = bh >> 3, h = bh & 7;
    const int t = 16 * tt + i, m = b * SEQ + c * 64 + t;
    const bf16* QE = WSB_(A, WS_QE) + (size_t)unit * 4096; const bf16* S0 = WSB_(A, WS_S0B) + (size_t)unit * 4096; const float* OL = WSF_(A, WS_OL) + (size_t)unit * 4096;
    f32x4 acc[4];
#pragma unroll
    for (int mt = 0; mt < 4; ++mt) acc[mt] = *(const GAS f32x4*)(OL + t * 64 + 16 * mt + 4 * g);
#pragma unroll
    for (int ks = 0; ks < 2; ++ks) { const bf16x8 bq = *(const GAS bf16x8*)(QE + t * 64 + 32 * ks + 8 * g);
#pragma unroll
        for (int mt = 0; mt < 4; ++mt) acc[mt] = mfma16(*(const GAS bf16x8*)(S0 + (16 * mt + i) * 64 + 32 * ks + 8 * g), bq, acc[mt]); }
    float s = 0.f;
#pragma unroll
    for (int mt = 0; mt < 4; ++mt) s += (acc[mt][0] + acc[mt][1]) + (acc[mt][2] + acc[mt][3]);
    s += __shfl_xor(s, 16); s += __shfl_xor(s, 32);
    const float mean = s * (1.0f / 64.0f); float q = 0.f;
#pragma unroll
    for (int mt = 0; mt < 4; ++mt)
#pragma unroll
        for (int r = 0; r < 4; ++r) { const float d = acc[mt][r] - mean; q += d * d; }
    q += __shfl_xor(q, 16); q += __shfl_xor(q, 32);
    const float rstd = 1.0f / sqrtf(q * (1.0f / 64.0f) + GN_EPS);
    const float bon = WSF_(A, WS_BON)[(size_t)m * 8 + h];
#pragma unroll
    for (int mt = 0; mt < 4; ++mt) { const int hc = h * 64 + 16 * mt + 4 * g;
        const f32x4 gg = *(const GAS f32x4*)(LNX_G_(A) + hc), bb = *(const GAS f32x4*)(LNX_B_(A) + hc);
        const f32x4 vm = up4(*(const GAS u32x2*)(WSB_(A, WS_VMX) + (size_t)m * RW + hc)), zr = up4(*(const GAS u32x2*)(WSB_(A, WS_H) + (size_t)m * NH + C_ZR + hc));
        f32x4 y;
#pragma unroll
        for (int r = 0; r < 4; ++r) y[r] = ((acc[mt][r] - mean) * rstd * gg[r] + bb[r] + bon * vm[r]) * zr[r];
        *(GAS u32x2*)(WSB_(A, WS_YR) + (size_t)m * RW + hc) = pk4(y); }
}

constexpr int AT_K = 0, AT_V = 65536, AT_VROWS = 272;
constexpr int NATT_UNITS = 3 * 512;
__device__ __forceinline__ int at_off(int row, int e) { return row * 256 + ((((e) >> 3) ^ (row & 15)) << 4) + ((e) & 7) * 2; }
__device__ __forceinline__ void attnP_unit(Frame& F, const Args& A, int unit) {
    const int lane = F.lane, qt = F.wave, i = lane & 15, gq = lane >> 4, tid = F.tid;
    const int g = unit >> 9, r0 = unit & 511, sh = 2 * g, d = 1 << sh, nblk = 64 >> sh;
    const int n = r0 % nblk, x = r0 / nblk, rho = x & (d - 1), y = x >> sh, h = y & 3, b = y >> 2;
    LAS unsigned char* L = F.lds + RING_OFF;
    const bf16* H = WSB_(A, WS_H);
    const int hoff = g * 512 + h * 128;
    for (int idx = tid; idx < 256 * 16; idx += 512) {
        const int kl = idx >> 4, ch = idx & 15, pos = 128 * (n - 1) + kl;
        v4u kq = {0u, 0u, 0u, 0u}, vq = {0u, 0u, 0u, 0u};
        if (pos >= 0) { const bf16* rp = H + (size_t)(b * SEQ + rho + d * pos) * NH + hoff + ch * 8; kq = *(const GAS v4u*)(rp + C_AK); vq = *(const GAS v4u*)(rp + C_AV); }
        const int o = kl * 256 + ((ch ^ (kl & 15)) << 4);
        *(LAS v4u*)(L + AT_K + o) = kq; *(LAS v4u*)(L + AT_V + o) = vq;
    }
    if (tid < 256) { const int kl = 256 + (tid >> 4), ch = tid & 15; *(LAS v4u*)(L + AT_V + kl * 256 + ((ch ^ (kl & 15)) << 4)) = (v4u){0u, 0u, 0u, 0u}; }
    const int ql = 16 * qt + i;
    const size_t qrow = (size_t)(b * SEQ + rho + d * (128 * n + ql));
    bf16x8 qf[4];
#pragma unroll
    for (int ks = 0; ks < 4; ++ks) qf[ks] = *(const GAS bf16x8*)(H + qrow * NH + C_AQ + hoff + 32 * ks + 8 * gq);
    WG_BAR();
    f32x4 sc[9];
#pragma unroll
    for (int kk = 0; kk < 9; ++kk) { const int krow = 16 * (qt + kk) + i; f32x4 acc = {0.f, 0.f, 0.f, 0.f};
#pragma unroll
        for (int ks = 0; ks < 4; ++ks) acc = mfma16(*(const LAS bf16x8*)(L + AT_K + krow * 256 + (((4 * ks + gq) ^ (krow & 15)) << 4)), qf[ks], acc);
        sc[kk] = acc; }
    const float NEG = -__builtin_inff();
    const bool nofirst = n > 0;
#pragma unroll
    for (int r = 0; r < 4; ++r) { if (4 * gq + r < i) sc[0][r] = NEG; if (4 * gq + r > i) sc[8][r] = NEG; }
    if (!nofirst) {
#pragma unroll
        for (int kk = 0; kk < 9; ++kk) { if (16 * (qt + kk) < 128) sc[kk] = (f32x4){NEG, NEG, NEG, NEG}; }
    }
    float mx = -1e30f;
#pragma unroll
    for (int kk = 0; kk < 9; ++kk) mx = fmaxf(mx, fmaxf(fmaxf(sc[kk][0], sc[kk][1]), fmaxf(sc[kk][2], sc[kk][3])));
    mx = fmaxf(mx, __shfl_xor(mx, 16)); mx = fmaxf(mx, __shfl_xor(mx, 32));
    constexpr float C2 = ATT_SCALE * 1.4426950408889634f;
    float l = 0.f;
#pragma unroll
    for (int kk = 0; kk < 9; ++kk)
#pragma unroll
        for (int r = 0; r < 4; ++r) { const float p = __builtin_amdgcn_exp2f((sc[kk][r] - mx) * C2); sc[kk][r] = p; l += p; }
    l += __shfl_xor(l, 16); l += __shfl_xor(l, 32);
    f32x4 oa[8];
#pragma unroll
    for (int et = 0; et < 8; ++et) oa[et] = (f32x4){0.f, 0.f, 0.f, 0.f};
#pragma unroll
    for (int s = 0; s < 5; ++s) {
        const u32x2 plo = pk4(sc[2 * s]); const u32x2 phi = (2 * s + 1 < 9) ? pk4(sc[(2 * s + 1 < 9) ? 2 * s + 1 : 8]) : (u32x2){0u, 0u};
        const v4u pw = {plo.x, plo.y, phi.x, phi.y}; const bf16x8 pf = __builtin_bit_cast(bf16x8, pw);
        const int rlo = 16 * (qt + 2 * s) + 4 * gq + (i >> 2), rhi = rlo + 16;
#pragma unroll
        for (int et = 0; et < 8; ++et) { const int e = 16 * et + 4 * (i & 3);
            const s16x4 lo = __builtin_bit_cast(s16x4, __builtin_amdgcn_ds_read_tr16_b64_v4i16((LAS v4i16_t*)(L + AT_V + at_off(rlo, e))));
            const s16x4 hi = __builtin_bit_cast(s16x4, __builtin_amdgcn_ds_read_tr16_b64_v4i16((LAS v4i16_t*)(L + AT_V + at_off(rhi, e))));
            oa[et] = mfma16(__builtin_shufflevector(lo, hi, 0, 1, 2, 3, 4, 5, 6, 7), pf, oa[et]); }
    }
    const float il = 1.0f / l;
    bf16* ao = WSB_(A, WS_AO) + ((size_t)g * M + qrow) * RW + h * 128 + 4 * gq;
#pragma unroll
    for (int et = 0; et < 8; ++et) *(GAS u32x2*)(ao + 16 * et) = pk4(oa[et] * il);
    if (gq == 0) WSF_(A, WS_LSE)[((size_t)g * M + qrow) * 4 + h] = mx * ATT_SCALE + __logf(l);
    WG_BAR();
}
__device__ __forceinline__ float row_sum16(float x) { return row_scan(x); }
__device__ __forceinline__ void attnS_item(Frame& F, const Args& A, int b, int g, int t, int h) {
    const int lane = F.lane, i = lane & 15, gq = lane >> 4;
    const int sh = 2 * g, d = 1 << sh, Wb = 128 << sh;
    const float* cache = (g == 0 ? C1_(A) : (g == 1 ? C2_(A) : C3_(A))) + (size_t)b * Wb * 1024 + h * 128 + 8 * gq;
    const bf16* H = WSB_(A, WS_H);
    const int ms = MP + b * DSEQ;
    const int hoff = g * 512 + h * 128 + 8 * gq;
    float q[4][8];
#pragma unroll
    for (int ks = 0; ks < 4; ++ks) ld8bf(H + (size_t)(ms + t) * NH + C_AQ + hoff + 32 * ks, q[ks]);
    float sc[9];
#pragma unroll
    for (int x = 0; x < 9; ++x) sc[x] = -__builtin_inff();
#pragma unroll 1
    for (int tile = 0; tile < 8; tile += 2) {
        float pr[2];
#pragma unroll
        for (int u = 0; u < 2; ++u) {
            const int kk = 16 * (tile + u) + i, idx = (g == 0) ? kk : t + d * kk;
            const float* kr = cache + (size_t)idx * 1024;
            float part = 0.f;
#pragma unroll
            for (int ks = 0; ks < 4; ++ks) { const f32x4 k0 = *(const GAS f32x4*)(kr + 32 * ks), k1 = *(const GAS f32x4*)(kr + 32 * ks + 4);
                part += q[ks][0] * k0.x + q[ks][1] * k0.y + q[ks][2] * k0.z + q[ks][3] * k0.w + q[ks][4] * k1.x + q[ks][5] * k1.y + q[ks][6] * k1.z + q[ks][7] * k1.w; }
            part += __shfl_xor(part, 16); part += __shfl_xor(part, 32);
            const bool valid = (g == 0) ? (kk >= t) : true;
            pr[u] = valid ? part * ATT_SCALE : -__builtin_inff();
        }
#pragma unroll
        for (int x = 0; x < 8; x += 2) { if (tile == x) { sc[x] = pr[0]; sc[x + 1] = pr[1]; } }
    }
    {
        const int tn = (g == 0) ? (i & 3) : t; const bool valid = (g == 0) ? (i <= t && i < 4) : (i == 0);
        float part = 0.f;
#pragma unroll
        for (int ks = 0; ks < 4; ++ks) { float kv[8]; ld8bf(H + (size_t)(ms + tn) * NH + C_AK + hoff + 32 * ks, kv);
#pragma unroll
            for (int j = 0; j < 8; ++j) part += q[ks][j] * kv[j]; }
        part += __shfl_xor(part, 16); part += __shfl_xor(part, 32);
        sc[8] = valid ? part * ATT_SCALE : -__builtin_inff();
    }
    float mx = sc[0];
#pragma unroll
    for (int x = 1; x < 9; ++x) mx = fmaxf(mx, sc[x]);
    mx = fmaxf(mx, __shfl_xor(mx, 1)); mx = fmaxf(mx, __shfl_xor(mx, 2)); mx = fmaxf(mx, __shfl_xor(mx, 4)); mx = fmaxf(mx, __shfl_xor(mx, 8));
    float l = 0.f;
#pragma unroll
    for (int x = 0; x < 9; ++x) { sc[x] = __expf(sc[x] - mx); l += sc[x]; }
    float acc[4][8];
#pragma unroll
    for (int ks = 0; ks < 4; ++ks)
#pragma unroll
        for (int j = 0; j < 8; ++j) acc[ks][j] = 0.f;
#pragma unroll 1
    for (int tile = 0; tile < 8; tile += 2) {
        float pp[2] = {0.f, 0.f};
#pragma unroll
        for (int x = 0; x < 8; x += 2) { if (tile == x) { pp[0] = sc[x]; pp[1] = sc[x + 1]; } }
#pragma unroll
        for (int u = 0; u < 2; ++u) {
            const int kk = 16 * (tile + u) + i, idx = (g == 0) ? kk : t + d * kk;
            const float* vr = cache + (size_t)idx * 1024 + 512;
            const float p = pp[u];
#pragma unroll
            for (int ks = 0; ks < 4; ++ks) { const f32x4 v0 = *(const GAS f32x4*)(vr + 32 * ks), v1 = *(const GAS f32x4*)(vr + 32 * ks + 4);
                acc[ks][0] += p * v0.x; acc[ks][1] += p * v0.y; acc[ks][2] += p * v0.z; acc[ks][3] += p * v0.w; acc[ks][4] += p * v1.x; acc[ks][5] += p * v1.y; acc[ks][6] += p * v1.z; acc[ks][7] += p * v1.w; }
        }
    }
    {
        const int tn = (g == 0) ? (i & 3) : t; const float p = sc[8];
#pragma unroll
        for (int ks = 0; ks < 4; ++ks) { float vv[8]; ld8bf(H + (size_t)(ms + tn) * NH + C_AV + hoff + 32 * ks, vv);
#pragma unroll
            for (int j = 0; j < 8; ++j) acc[ks][j] += p * vv[j]; }
    }
    l = row_sum16(l);
#pragma unroll
    for (int ks = 0; ks < 4; ++ks)
#pragma unroll
        for (int j = 0; j < 8; ++j) acc[ks][j] = row_sum16(acc[ks][j]);
    if (i == 15) {
        const float il = 1.0f / l;
        bf16* ao = WSB_(A, WS_AO) + ((size_t)g * M + ms + t) * RW + h * 128 + 8 * gq;
#pragma unroll
        for (int ks = 0; ks < 4; ++ks) { v4u w; w.x = pk2(acc[ks][0] * il, acc[ks][1] * il); w.y = pk2(acc[ks][2] * il, acc[ks][3] * il); w.z = pk2(acc[ks][4] * il, acc[ks][5] * il); w.w = pk2(acc[ks][6] * il, acc[ks][7] * il);
            *(GAS v4u*)(ao + 32 * ks) = w; }
        if (gq == 0) WSF_(A, WS_LSE)[((size_t)g * M + ms + t) * 4 + h] = mx + __logf(l);
    }
}

__device__ __forceinline__ void attn_combine_row(Frame& F, const Args& A, int m) {
    const int lane = F.lane, c0 = lane * 8, h = lane >> 4;
    float o[3][8], ls[3];
#pragma unroll
    for (int g = 0; g < 3; ++g) { ld8bf(WSB_(A, WS_AO) + ((size_t)g * M + m) * RW + c0, o[g]); ls[g] = WSF_(A, WS_LSE)[((size_t)g * M + m) * 4 + h]; }
    const float ml = fmaxf(fmaxf(ls[0], ls[1]), ls[2]);
    const float w0 = __expf(ls[0] - ml), w1 = __expf(ls[1] - ml), w2 = __expf(ls[2] - ml), iw = 1.0f / (w0 + w1 + w2);
    float z[8]; ld8bf(WSB_(A, WS_H) + (size_t)m * NH + C_ZA + c0, z);
    float yv[8];
#pragma unroll
    for (int j = 0; j < 8; ++j) yv[j] = (w0 * o[0][j] + w1 * o[1][j] + w2 * o[2][j]) * iw * z[j];
    v4u w; w.x = pk2(yv[0], yv[1]); w.y = pk2(yv[2], yv[3]); w.z = pk2(yv[4], yv[5]); w.w = pk2(yv[6], yv[7]);
    *(GAS v4u*)(WSB_(A, WS_YA) + (size_t)m * RW + c0) = w;
}

__device__ __forceinline__ void ln_row(Frame& F, const Args& A, int m) {
    const GAS f32x4* xr = (const GAS f32x4*)(WSF_(A, WS_PRE) + (size_t)m * DM) + F.lane;
    f32x4 v[4]; float s = 0.f;
#pragma unroll
    for (int j = 0; j < 4; ++j) { v[j] = xr[64 * j]; s += (v[j].x + v[j].y) + (v[j].z + v[j].w); }
    const float mean = wave_sum(s) * (1.f / DM); float s2 = 0.f;
#pragma unroll
    for (int j = 0; j < 4; ++j) { v[j] = v[j] - mean; s2 += (v[j].x * v[j].x + v[j].y * v[j].y) + (v[j].z * v[j].z + v[j].w * v[j].w); }
    const float rstd = 1.f / sqrtf(wave_sum(s2) * (1.f / DM) + LN_EPS);
    GAS f32x4* o = (GAS f32x4*)(A.out + (size_t)m * DM) + F.lane;
#pragma unroll
    for (int j = 0; j < 4; ++j) { const f32x4 g = *((const GAS f32x4*)LN_G_(A) + F.lane + 64 * j), bta = *((const GAS f32x4*)LN_B_(A) + F.lane + 64 * j); o[64 * j] = v[j] * rstd * g + bta; }
}

__global__ void __launch_bounds__(NWAVES * 64, 2) mega_fwd(Args args) {
    extern __shared__ __attribute__((aligned(16))) unsigned char lds[];
    Frame F;
    F.lds = (LAS unsigned char*)lds;
    F.MISC = (volatile LAS unsigned*)(F.lds + MISC_OFF);
    F.tid = threadIdx.x; F.lane = F.tid & 63; F.wave = __builtin_amdgcn_readfirstlane(F.tid >> 6);
    F.G = gridDim.x;
    F.ctl = (gu32*)(args.ws + WS_CTL);
    for (int u = F.tid; u < (LDS_BYTES - LDSCTL_OFF) / 4; u += NWAVES * 64) ((LAS unsigned*)(F.lds + LDSCTL_OFF))[u] = 0u;
    __syncthreads();
    XcdBarrier bar; bar.bar = (unsigned*)(F.ctl + CW_BAR); bar.x = 0; bar.st = nullptr;
    if (N_LAUNCHES == 1) bar = xcd_barrier_post((unsigned*)(F.ctl + CW_BAR), F.MISC + 8);
#define GRID_BAR() do { if (N_LAUNCHES == 1) xcd_barrier(bar); } while (0)
    const int lo = args.ph_lo, hi = args.ph_hi;
#ifndef PH_MASK
#define PH_MASK 0xFFFF
#endif
#define IN(k) ((((PH_MASK) >> (k)) & 1) && lo <= (k) && (k) < hi)
#define BOTH(k) (IN(k) && IN((k) + 1))
    const int gw = blockIdx.x * NWAVES + F.wave, NGW = F.G * NWAVES;

    if (IN(0)) { p0_prologue(F, args); if (BOTH(0)) GRID_BAR(); }
    if (IN(1)) {
        pg8::Gemm g{WSB_(args, WS_XB), WSB_(args, WS_WIN), M, NH, DM}; pg8::StaticOrder S; S.init(M, NH, F.G, (int)blockIdx.x);
        pg8::EpiH E{WSB_(args, WS_H), B_GATE_(args), args.out};
        pg8::gemm_phase<pg8::EpiH, pg8::StaticOrder, PG8_ALIGN, PG8_SP2>(F.lds + RING_OFF, g, S, E);
        if (BOTH(1)) GRID_BAR();
    }
    if (IN(2)) {
        for (int m = MP + gw; m < M; m += NGW) rwkv_prep_row(F, args, m);
        for (int u = blockIdx.x; u < NUNITS; u += F.G) rwkvA_unit(F, args, u);
        if (BOTH(2)) GRID_BAR();
    }
    if (IN(3)) {
        if (blockIdx.x < 16) rwkv_carry(F, args, (int)blockIdx.x);
        for (int it = 16 + gw; it < 16 + DBATCH * 8; it += NGW) scan_item(F, args, it);
        {
            volatile LAS int* qslot = (volatile LAS int*)(F.lds + LDSCTL_OFF);
            for (;;) {
                if (F.tid == 0) qslot[0] = (int)__hip_atomic_fetch_add((unsigned*)(F.ctl + CW_Q), 1u, __ATOMIC_RELAXED, __HIP_MEMORY_SCOPE_AGENT);
                WG_BAR();
                const int u = qslot[0];
                WG_BAR();
                if (u >= NATT_UNITS + 768) break;
                const int u3 = u / 3, um = u - 3 * u3;
                if (um == 0) { const int tp = u3 & 1, bg = u3 >> 1, b = bg / 3, g = bg - 3 * b; attnS_item(F, args, b, g, 2 * tp + (F.wave >> 2), F.wave & 3); }
                else attnP_unit(F, args, 2 * u3 + um - 1);
            }
        }
        if (BOTH(3)) GRID_BAR();
    }
    if (IN(4)) {
        for (int u2 = blockIdx.x; u2 < NUNITS / 2; u2 += F.G) rwkvC_unit(F, args, 2 * u2 + (F.wave >> 2));
        for (int m = MP + gw; m < M; m += NGW) rwkv_post_row(F, args, m);
        for (int m = gw; m < M; m += NGW) attn_combine_row(F, args, m);
        if (BOTH(4)) GRID_BAR();
    }
    if (IN(5)) {
        pg8::Gemm g{WSB_(args, WS_YR), WSB_(args, WS_WOA), M, DM, RW}; pg8::StaticOrder S; S.init(M, DM, F.G, (int)blockIdx.x);
        pg8::EpiMixA E{WSB_(args, WS_H), WSF_(args, WS_MIXF)};
        pg8::gemm_phase<pg8::EpiMixA, pg8::StaticOrder, PG8_ALIGN, PG8_SP2>(F.lds + RING_OFF, g, S, E);
        if (BOTH(5)) GRID_BAR();
    }
    if (IN(6)) {
        pg8::Gemm g{WSB_(args, WS_YA), WSB_(args, WS_WOB), M, DM, RW}; pg8::StaticOrder S; S.init(M, DM, F.G, (int)blockIdx.x);
        pg8::EpiMixB E{WSB_(args, WS_H), WSF_(args, WS_MIXF), WSB_(args, WS_MIX)};
        pg8::gemm_phase<pg8::EpiMixB, pg8::StaticOrder, PG8_ALIGN, PG8_SP2>(F.lds + RING_OFF, g, S, E);
        if (BOTH(6)) GRID_BAR();
    }
    if (IN(7)) {
        pg8::Gemm g{WSB_(args, WS_MIX), WSB_(args, WS_WOUT), M, DM, DM}; pg8::StaticOrder S; S.init(M, DM, F.G, (int)blockIdx.x);
        pg8::EpiPre E{XP_(args), XS_(args), WSF_(args, WS_PRE)};
        pg8::gemm_phase<pg8::EpiPre, pg8::StaticOrder, PG8_ALIGN, PG8_SP2>(F.lds + RING_OFF, g, S, E);
        if (BOTH(7)) GRID_BAR();
    }
    if (IN(8)) {
        for (int m = gw; m < M; m += NGW) ln_row(F, args, m);
    }
#undef IN
#undef BOTH
}

extern "C" void kernel_launch(void* const* d_in, const int* in_sizes, int n_in, void* d_out, int out_size, void* d_ws, size_t ws_size, hipStream_t stream) {
    static int grid = 0;
    if (grid == 0) {
        if (n_in != 24 || in_sizes[0] != MP * DM || (size_t)out_size != O_END || ws_size < WS_END) { fprintf(stderr, "kernel_launch: unexpected shapes (n_in %d, in0 %d, out %d, ws %zu); nothing launched\n", n_in, n_in > 0 ? in_sizes[0] : -1, out_size, ws_size); grid = -1; return; }
        int dev = 0, cus = 0, per_cu = 0;
        if (hipGetDevice(&dev) != hipSuccess || hipDeviceGetAttribute(&cus, hipDeviceAttributeMultiprocessorCount, dev) != hipSuccess) { grid = -1; return; }
        if (hipFuncSetAttribute((const void*)mega_fwd, hipFuncAttributeMaxDynamicSharedMemorySize, LDS_BYTES) != hipSuccess) { fprintf(stderr, "kernel_launch: hipFuncSetAttribute failed\n"); grid = -1; return; }
        if (hipOccupancyMaxActiveBlocksPerMultiprocessor(&per_cu, (const void*)mega_fwd, NWAVES * 64, LDS_BYTES) != hipSuccess || per_cu < 1) fprintf(stderr, "kernel_launch: occupancy query reports %d\n", per_cu);
        (void)hipGetLastError();
        grid = cus;
    }
    if (grid < 0) return;
    if (hipMemsetAsync((char*)d_ws + WS_CTL, 0, CTL_ZERO_BYTES, stream) != hipSuccess) return;
    Args a{};
    for (int i = 0; i < 24; ++i) a.in[i] = (const float*)d_in[i];
    a.out = (float*)d_out; a.ws = (unsigned char*)d_ws;
    if (N_LAUNCHES == 1) { a.ph_lo = 0; a.ph_hi = N_PHASES; hipLaunchKernelGGL(mega_fwd, dim3(grid), dim3(NWAVES * 64), LDS_BYTES, stream, a); }
    else for (int li = 0; li < N_PHASES; ++li) { a.ph_lo = li; a.ph_hi = li + 1; hipLaunchKernelGGL(mega_fwd, dim3(grid), dim3(NWAVES * 64), LDS_BYTES, stream, a); }
}
```

```cpp
#include <hip/hip_runtime.h>
#include <cstdio>
#include <cstdint>
namespace pg8 {
#define PG8_LAS __attribute__((address_space(3)))
typedef unsigned short bf16_t;
typedef short bf16x8 __attribute__((ext_vector_type(8)));
typedef float f32x4 __attribute__((ext_vector_type(4)));
typedef unsigned u32x4 __attribute__((ext_vector_type(4)));
constexpr int BM = 256, BK = 64, HALF = 128, HTB = HALF * BK * 2  , STAGE_BYTES = 8 * HTB, NXCD = 8, WGM = 8;

__host__ __device__ __forceinline__ int lds_byte(int r, int c) { const int st = (r >> 4) * 2 + (c >> 5), rr = r & 15, cc = c & 31, ob = rr * 64 + cc * 2; return st * 1024 + (ob ^ (((ob >> 9) & 1) << 5)); }
__host__ __device__ __forceinline__ void stage_rc(int b, int& R, int& C) { const int st = b / 1024, sb = b % 1024, swz = sb ^ (((sb >> 9) & 1) << 5); R = (st >> 1) * 16 + swz / 64; C = (st & 1) * 32 + (swz % 64) / 2; }
__host__ __device__ __forceinline__ int perm32(int rho) { const int n = rho >> 4, i = rho & 15; return 8 * (i >> 2) + 4 * n + (i & 3); }

struct Unit { int pm, pn; };
struct Gemm { const bf16_t* A; const bf16_t* Bt; int M, N, K; };

struct StaticOrder {
    int nM, nN, nwg, G, c;
    __host__ __device__ void init(int M, int N, int G_, int c_) { nM = M / BM; nN = N / BM; nwg = nM * nN; G = G_; c = c_; }
    __host__ __device__ bool next(int i, Unit& u) const {
        const long L = (long)i * G + c; if (L >= nwg) return false;
        int wgid = (int)L; { const int q = nwg / NXCD, r = nwg % NXCD, xcd = wgid % NXCD, off = wgid / NXCD; wgid = (xcd < r ? xcd * (q + 1) : r * (q + 1) + (xcd - r) * q) + off; }
        const int nig = WGM * nN, gid = wgid / nig, fm = gid * WGM, gsz = (nM - fm) < WGM ? (nM - fm) : WGM;
        u.pm = fm + ((wgid % nig) % gsz); u.pn = (wgid % nig) / gsz; return true;
    }
    __device__ __forceinline__ void a_ready(const Unit&) const {}
    __device__ __forceinline__ void done(const Unit&) const {}
};

__device__ __forceinline__ unsigned cvt_pk_bf16(float lo, float hi) { unsigned r; asm volatile("v_cvt_pk_bf16_f32 %0, %1, %2" : "=v"(r) : "v"(lo), "v"(hi)); return r; }
typedef float f32x2 __attribute__((ext_vector_type(2)));
__device__ __forceinline__ f32x2 gelu_pk(f32x2 v) {
    const f32x2 av = __builtin_elementwise_abs(v), d = av * 0.2316418882f + 1.0f;
    f32x2 t; t.x = __builtin_amdgcn_rcpf(d.x); t.y = __builtin_amdgcn_rcpf(d.y);
    f32x2 q = t * 0.5307027145f + (-0.7265760135f); q = q * t + 0.7107068705f; q = q * t + (-0.142248368f); q = q * t + 0.127414796f; q = q * t;
    const f32x2 s = (v * v) * (-0.72134752044f);
    f32x2 e; e.x = __builtin_amdgcn_exp2f(s.x); e.y = __builtin_amdgcn_exp2f(s.y);
    const f32x2 m = v * (q * e), r = v - m;
    f32x2 o; o.x = v.x < 0.f ? m.x : r.x; o.y = v.y < 0.f ? m.y : r.y; return o;
}

template <int ACT  > struct EpiBf16 {
    static constexpr bool PERM = true, AFTER_DRAIN = false; static_assert(ACT == 0 || ACT == 1, "EpiBf16: ACT is 0 (none) or 1 (gelu_pk)");
    bf16_t* O; int ldc; const float* bias; int split_cols; size_t split_stride; float scale0;
    __device__ __forceinline__ void operator()(const f32x4 (&acc)[2][2][4][2], const Unit& u, int wr, int wc, int fr, int fq) const {
        const int row0 = u.pm * BM + wr * 64 + fr; int colt = u.pn * BM; bf16_t* base = O;
        float sc = 1.f; if (split_cols) { const int t = colt / split_cols; base += (size_t)t * split_stride; colt -= t * split_cols; if (t == 0) sc = scale0; }
        const int col0 = colt + wc * 32 + 8 * fq, bcol0 = u.pn * BM + wc * 32 + 8 * fq;
        f32x4 bv[2][2];
#pragma unroll
        for (int bj = 0; bj < 2; ++bj)
#pragma unroll
            for (int n = 0; n < 2; ++n) bv[bj][n] = bias ? *(const f32x4*)(bias + bcol0 + bj * HALF + 4 * n) : (f32x4){0.f, 0.f, 0.f, 0.f};
#pragma unroll
        for (int ai = 0; ai < 2; ++ai)
#pragma unroll
            for (int m = 0; m < 4; ++m) { bf16_t* rowp = base + (size_t)(row0 + ai * HALF + m * 16) * ldc + col0;
#pragma unroll
                for (int bj = 0; bj < 2; ++bj) { f32x4 v0 = acc[ai][bj][m][0] + bv[bj][0], v1 = acc[ai][bj][m][1] + bv[bj][1];
                    if (ACT == 1) { f32x2 a = gelu_pk((f32x2){v0[0], v0[1]}), b = gelu_pk((f32x2){v0[2], v0[3]}), c = gelu_pk((f32x2){v1[0], v1[1]}), d = gelu_pk((f32x2){v1[2], v1[3]});
                        v0 = (f32x4){a.x, a.y, b.x, b.y}; v1 = (f32x4){c.x, c.y, d.x, d.y}; }
                    v0 = v0 * sc; v1 = v1 * sc; u32x4 w; w.x = cvt_pk_bf16(v0[0], v0[1]); w.y = cvt_pk_bf16(v0[2], v0[3]); w.z = cvt_pk_bf16(v1[0], v1[1]); w.w = cvt_pk_bf16(v1[2], v1[3]);
                    *(u32x4*)(rowp + bj * HALF) = w; } }
    }
};

struct PanelStats {
    unsigned* xbuf;
    unsigned* cnt;
    unsigned* tmo;
    int ntn; float eps;
    unsigned code;
    __device__ __forceinline__ bool run(const f32x4 (&v)[2][2][4][2], const Unit& u, int wr, int wc, int fr, int fq, PG8_LAS unsigned char* lds, int wid, int lane) const {
        typedef float f32x2v __attribute__((ext_vector_type(2)));
        PG8_LAS f32x2v* P = (PG8_LAS f32x2v*)lds;
        PG8_LAS f32x2v* S = (PG8_LAS f32x2v*)(lds + 8192);
        PG8_LAS unsigned* flag = (PG8_LAS unsigned*)(lds + 8192 + 2048);
#pragma unroll
        for (int ai = 0; ai < 2; ++ai)
#pragma unroll
            for (int m = 0; m < 4; ++m) {
                float s = 0.f;
#pragma unroll
                for (int bj = 0; bj < 2; ++bj)
#pragma unroll
                    for (int n = 0; n < 2; ++n) { const f32x4 x = v[ai][bj][m][n]; s += (x[0] + x[1]) + (x[2] + x[3]); }
                s += __shfl_xor(s, 16); s += __shfl_xor(s, 32);
                const float mw = s * (1.0f / 64.0f); float q = 0.f;
#pragma unroll
                for (int bj = 0; bj < 2; ++bj)
#pragma unroll
                    for (int n = 0; n < 2; ++n) { const f32x4 d = v[ai][bj][m][n] - mw; q += (d[0] * d[0] + d[1] * d[1]) + (d[2] * d[2] + d[3] * d[3]); }
                q += __shfl_xor(q, 16); q += __shfl_xor(q, 32);
                if (fq == 0) P[(ai * HALF + wr * 64 + m * 16 + fr) * 4 + wc] = (f32x2v){mw, q};
            }
        asm volatile("s_waitcnt lgkmcnt(0)" ::: "memory"); __builtin_amdgcn_s_barrier(); asm volatile("" ::: "memory");
#if defined(BROKEN_EXCHANGE_NO_WAIT)
#warning BROKEN CONTROL BUILD: the row-statistics exchange does not wait; results are wrong by design
        if (blockIdx.x >= 64) { const long long t0_ = clock64(); while (clock64() - t0_ < 60000) __builtin_amdgcn_s_sleep(8); }
#endif
        const int row = wid * 32 + (lane & 31);
        if (lane < 32) {
            const f32x2v a = P[row * 4 + 0], b = P[row * 4 + 1], c = P[row * 4 + 2], d = P[row * 4 + 3];
            const float mt = (a.x + b.x + c.x + d.x) * 0.25f;
            const float da = a.x - mt, db = b.x - mt, dc = c.x - mt, dd = d.x - mt;
            const float m2 = (a.y + b.y) + (c.y + d.y) + 64.0f * ((da * da + db * db) + (dc * dc + dd * dd));
            unsigned long long* slot = (unsigned long long*)xbuf + ((size_t)(u.pm * BM + row) * 4 + u.pn);
            __hip_atomic_store(slot, ((unsigned long long)__float_as_uint(m2) << 32) | __float_as_uint(mt), __ATOMIC_RELAXED, __HIP_MEMORY_SCOPE_AGENT);
        }
        asm volatile("s_waitcnt vmcnt(0)" ::: "memory");
        if (lane == 0) __hip_atomic_fetch_add(cnt + 64 * u.pm, 1u, __ATOMIC_RELAXED, __HIP_MEMORY_SCOPE_AGENT);
        if (wid == 0) {
            bool dead = false; const unsigned long long t0 = __builtin_amdgcn_s_memrealtime(); const unsigned want = 8u * (unsigned)ntn;
            for (;;) {
#if defined(BROKEN_EXCHANGE_NO_WAIT)
                break;
#endif
                if ((unsigned)__builtin_amdgcn_readfirstlane(__hip_atomic_load(cnt + 64 * u.pm, __ATOMIC_RELAXED, __HIP_MEMORY_SCOPE_AGENT)) >= want) break;
                if (__builtin_amdgcn_s_memrealtime() - t0 > 2000000ull) {
                    if (lane == 0) { unsigned expect = 0u; __hip_atomic_compare_exchange_strong(tmo + 1, &expect, code | (unsigned)(u.pm & 0xff), __ATOMIC_RELAXED, __ATOMIC_RELAXED, __HIP_MEMORY_SCOPE_AGENT);
                                     __hip_atomic_store(tmo, 1u, __ATOMIC_RELAXED, __HIP_MEMORY_SCOPE_AGENT); }
                    dead = true; break; }
                __builtin_amdgcn_s_sleep(2);
            }
            __builtin_amdgcn_fence(__ATOMIC_ACQUIRE, "agent");
            if (lane == 0) flag[0] = dead ? 1u : 0u;
        }
        asm volatile("s_waitcnt vmcnt(0) lgkmcnt(0)" ::: "memory"); __builtin_amdgcn_s_barrier(); asm volatile("" ::: "memory");
        const bool bad = flag[0] != 0u;
        if (lane < 32) {
            const unsigned long long* slot = (const unsigned long long*)xbuf + (size_t)(u.pm * BM + row) * 4; float mt[4], m2[4]; float ms = 0.f;
#pragma unroll
            for (int t = 0; t < 4; ++t) { if (t < ntn) { const unsigned long long w = __hip_atomic_load(slot + t, __ATOMIC_RELAXED, __HIP_MEMORY_SCOPE_AGENT); mt[t] = __uint_as_float((unsigned)w); m2[t] = __uint_as_float((unsigned)(w >> 32)); } else { mt[t] = 0.f; m2[t] = 0.f; } ms += mt[t]; }
            const float mean = ms / (float)ntn; float q = 0.f;
#pragma unroll
            for (int t = 0; t < 4; ++t) if (t < ntn) { const float dm = mt[t] - mean; q += m2[t] + 256.0f * dm * dm; }
            S[row] = (f32x2v){mean, 1.0f / sqrtf(q / (256.0f * (float)ntn) + eps)};
        }
        asm volatile("s_waitcnt lgkmcnt(0)" ::: "memory"); __builtin_amdgcn_s_barrier(); asm volatile("" ::: "memory");
        return bad;
    }
};
struct EpiLnRes {
    static constexpr bool PERM = false, AFTER_DRAIN = true;
    const float* base; float* out; int ldc; const float* bias; PanelStats st; unsigned poison;
    __device__ __forceinline__ void fused(f32x4 (&acc)[2][2][4][2], const Unit& u, int wr, int wc, int fr, int fq, PG8_LAS unsigned char* lds, int wid, int lane) const {
        typedef float f32x2v __attribute__((ext_vector_type(2)));
        const PG8_LAS f32x2v* S = (const PG8_LAS f32x2v*)(lds + 8192);
        const int col0 = u.pn * BM + wc * 32 + 4 * fq;
#pragma unroll
        for (int bj = 0; bj < 2; ++bj)
#pragma unroll
            for (int n = 0; n < 2; ++n) { const f32x4 bv = bias ? *(const f32x4*)(bias + col0 + bj * HALF + n * 16) : (f32x4){0.f, 0.f, 0.f, 0.f};
#pragma unroll
                for (int ai = 0; ai < 2; ++ai)
#pragma unroll
                    for (int m = 0; m < 4; ++m) acc[ai][bj][m][n] += bv; }
        f32x4 pre[4][2][2];
#pragma unroll
        for (int m = 0; m < 4; ++m) { const size_t off = (size_t)(u.pm * BM + wr * 64 + m * 16 + fr) * ldc + col0;
#pragma unroll
            for (int bj = 0; bj < 2; ++bj)
#pragma unroll
                for (int n = 0; n < 2; ++n) pre[m][bj][n] = *(const f32x4*)(base + off + bj * HALF + n * 16); }
        const bool bad = st.run(acc, u, wr, wc, fr, fq, lds, wid, lane) || poison != 0u;
        const float qnan = __builtin_nanf("");
#pragma unroll
        for (int ai = 0; ai < 2; ++ai)
#pragma unroll
            for (int m = 0; m < 4; ++m) { const int r = ai * HALF + wr * 64 + m * 16 + fr; const f32x2v sr = S[r]; const size_t off = (size_t)(u.pm * BM + r) * ldc + col0;
#pragma unroll
                for (int bj = 0; bj < 2; ++bj)
#pragma unroll
                    for (int n = 0; n < 2; ++n) { const f32x4 bs = ai == 0 ? pre[m][bj][n] : *(const f32x4*)(base + off + bj * HALF + n * 16); f32x4 o = bs + (acc[ai][bj][m][n] - sr.x) * sr.y;
                        if (bad) o = (f32x4){qnan, qnan, qnan, qnan}; *(f32x4*)(out + off + bj * HALF + n * 16) = o; }
                if (m & 1) asm volatile("" ::: "memory"); }
    }
};
struct EpiLnResLn {
    static constexpr bool PERM = false, AFTER_DRAIN = true;
    const float* base; float* out; bf16_t* xn; int ldc; const float* bias; PanelStats st1, st2; unsigned poison;
    __device__ __forceinline__ void fused(f32x4 (&acc)[2][2][4][2], const Unit& u, int wr, int wc, int fr, int fq, PG8_LAS unsigned char* lds, int wid, int lane) const {
        typedef float f32x2v __attribute__((ext_vector_type(2))); typedef unsigned u32x2v __attribute__((ext_vector_type(2)));
        const PG8_LAS f32x2v* S = (const PG8_LAS f32x2v*)(lds + 8192);
        const int col0 = u.pn * BM + wc * 32 + 4 * fq;
#pragma unroll
        for (int bj = 0; bj < 2; ++bj)
#pragma unroll
            for (int n = 0; n < 2; ++n) { const f32x4 bv = bias ? *(const f32x4*)(bias + col0 + bj * HALF + n * 16) : (f32x4){0.f, 0.f, 0.f, 0.f};
#pragma unroll
                for (int ai = 0; ai < 2; ++ai)
#pragma unroll
                    for (int m = 0; m < 4; ++m) acc[ai][bj][m][n] += bv; }
        bool bad = st1.run(acc, u, wr, wc, fr, fq, lds, wid, lane) || poison != 0u;
        const float qnan = __builtin_nanf("");
#pragma unroll
        for (int ai = 0; ai < 2; ++ai)
#pragma unroll
            for (int m = 0; m < 4; ++m) { const int r = ai * HALF + wr * 64 + m * 16 + fr; const f32x2v sr = S[r]; const size_t off = (size_t)(u.pm * BM + r) * ldc + col0;
#pragma unroll
                for (int bj = 0; bj < 2; ++bj)
#pragma unroll
                    for (int n = 0; n < 2; ++n) { const f32x4 bs = *(const f32x4*)(base + off + bj * HALF + n * 16); acc[ai][bj][m][n] = bs + (acc[ai][bj][m][n] - sr.x) * sr.y; }
                asm volatile("" : "+v"(acc[ai][0][m][0]), "+v"(acc[ai][0][m][1]), "+v"(acc[ai][1][m][0]), "+v"(acc[ai][1][m][1]));
                if (m & 1) asm volatile("" ::: "memory"); }
        const bool bad1 = bad;
        bad = st2.run(acc, u, wr, wc, fr, fq, lds, wid, lane) || bad;
#pragma unroll
        for (int ai = 0; ai < 2; ++ai)
#pragma unroll
            for (int m = 0; m < 4; ++m) { const int r = ai * HALF + wr * 64 + m * 16 + fr; const f32x2v sr = S[r]; const size_t off = (size_t)(u.pm * BM + r) * ldc + col0;
#pragma unroll
                for (int bj = 0; bj < 2; ++bj)
#pragma unroll
                    for (int n = 0; n < 2; ++n) { const f32x4 x1 = acc[ai][bj][m][n]; *(f32x4*)(out + off + bj * HALF + n * 16) = bad1 ? (f32x4){qnan, qnan, qnan, qnan} : x1;
                        const f32x4 o = (x1 - sr.x) * sr.y; u32x2v w; w.x = cvt_pk_bf16(o[0], o[1]); w.y = cvt_pk_bf16(o[2], o[3]);
                        if (bad) { w.x = 0x7fc07fc0u; w.y = 0x7fc07fc0u; } *(u32x2v*)(xn + off + bj * HALF + n * 16) = w; }
                asm volatile("" ::: "memory"); }
    }
};

template <class Epi, class Sched, bool ALIGN_EPI = false, bool SP2 = false>
__device__ __forceinline__ void gemm_phase(PG8_LAS unsigned char* lds, const Gemm g, const Sched& S, const Epi& E) {
    const int tid = threadIdx.x, wid = __builtin_amdgcn_readfirstlane(tid >> 6), lane = tid & 63, wr = wid >> 2, wc = wid & 3, fr = lane & 15, fq = lane >> 4;
    const int K = g.K, nt = K / BK;
    unsigned voffA[2], voffB[2];
#pragma unroll
    for (int i = 0; i < 2; ++i) { int R, C; stage_rc(tid * 16 + i * 8192, R, C); const int Rb = Epi::PERM ? ((R & ~31) + perm32(R & 31)) : R;
        voffA[i] = (unsigned)(R * K + C) * 2u; voffB[i] = (unsigned)(Rb * K + C) * 2u; }
    const size_t kstep = (size_t)(BK * 2);
    const size_t hstep = (size_t)HALF * K * 2;
    const size_t tstep = 2 * hstep;
    const unsigned ldsw = (unsigned)wid * 1024u;
    const int aoff = lds_byte(wr * 64 + fr, fq * 8), boff = lds_byte(wc * 32 + fr, fq * 8);
#define PG8_SA(b, h) (((b) * 2 + (h)) * HTB)
#define PG8_SB(b, h) ((4 + (b) * 2 + (h)) * HTB)
#define PG8_STAGE(bufoff, gbase, voff) do { _Pragma("unroll") for (int _i = 0; _i < 2; ++_i) \
        __builtin_amdgcn_global_load_lds((const unsigned*)((const char*)(gbase) + (voff)[_i]), (PG8_LAS unsigned*)(lds + (bufoff) + ldsw + _i * 8192), 16, 0, 0); } while (0)
#define PG8_LDA(dst, b, h) do { _Pragma("unroll") for (int m = 0; m < 4; ++m) _Pragma("unroll") for (int k = 0; k < 2; ++k) dst[m][k] = *(const PG8_LAS bf16x8*)(lds + PG8_SA(b, h) + aoff + m * 2048 + k * 1024); } while (0)
#define PG8_LDB(dst, b, h) do { _Pragma("unroll") for (int n = 0; n < 2; ++n) _Pragma("unroll") for (int k = 0; k < 2; ++k) dst[n][k] = *(const PG8_LAS bf16x8*)(lds + PG8_SB(b, h) + boff + n * 2048 + k * 1024); } while (0)
#define PG8_MMA(ai, bj, At, Bt) do { __builtin_amdgcn_s_setprio(1); _Pragma("unroll") for (int m = 0; m < 4; ++m) _Pragma("unroll") for (int n = 0; n < 2; ++n) _Pragma("unroll") for (int k = 0; k < 2; ++k) \
        acc[ai][bj][m][n] = __builtin_amdgcn_mfma_f32_16x16x32_bf16(Bt[n][k], At[m][k], acc[ai][bj][m][n], 0, 0, 0); __builtin_amdgcn_s_setprio(0); } while (0)
#define PG8_WAIT_V(n) asm volatile("s_waitcnt vmcnt(" #n ")" ::: "memory")
#define PG8_WAIT_L(n) asm volatile("s_waitcnt lgkmcnt(" #n ")" ::: "memory")
#define PG8_BAR __builtin_amdgcn_s_barrier()
#define PG8_SCHED __builtin_amdgcn_sched_barrier(0)
    Unit cur, nxt; int ui = 0;
    if (!S.next(0, cur)) return;
    f32x4 acc[2][2][4][2];
#pragma unroll
    for (int a = 0; a < 2; ++a)
#pragma unroll
        for (int b = 0; b < 2; ++b)
#pragma unroll
            for (int m = 0; m < 4; ++m)
#pragma unroll
                for (int n = 0; n < 2; ++n) acc[a][b][m][n] = (f32x4){0.f, 0.f, 0.f, 0.f};
    bf16x8 At[4][2], B0[2][2], B1[2][2];
    const char* cA = (const char*)g.A + (size_t)cur.pm * tstep; const char* cB = (const char*)g.Bt + (size_t)cur.pn * tstep;
    S.a_ready(cur);
    if constexpr (SP2) {
        PG8_STAGE(PG8_SB(0, 0), cB, voffB); PG8_STAGE(PG8_SB(0, 1), cB + hstep, voffB); PG8_STAGE(PG8_SA(0, 0), cA, voffA); PG8_STAGE(PG8_SA(0, 1), cA + hstep, voffA);
        if (wr == 1) PG8_BAR;
        PG8_WAIT_V(2); PG8_BAR;
        PG8_STAGE(PG8_SB(1, 0), cB + kstep, voffB); PG8_STAGE(PG8_SA(1, 0), cA + kstep, voffA); PG8_STAGE(PG8_SB(1, 1), cB + hstep + kstep, voffB);
        PG8_WAIT_V(6); PG8_BAR;
    } else {
        PG8_STAGE(PG8_SB(0, 0), cB, voffB); PG8_STAGE(PG8_SA(0, 0), cA, voffA); PG8_STAGE(PG8_SB(0, 1), cB + hstep, voffB); PG8_STAGE(PG8_SA(0, 1), cA + hstep, voffA);
        if (wr == 1) PG8_BAR;
        PG8_WAIT_V(4); PG8_BAR;
        PG8_STAGE(PG8_SB(1, 0), cB + kstep, voffB); PG8_STAGE(PG8_SA(1, 0), cA + kstep, voffA); PG8_STAGE(PG8_SB(1, 1), cB + hstep + kstep, voffB);
        PG8_WAIT_V(6); PG8_BAR;
    }
    for (;;) {
        const bool has_next = S.next(ui + 1, nxt);
        const char* nA = has_next ? (const char*)g.A + (size_t)nxt.pm * tstep : cA; const char* nB = has_next ? (const char*)g.Bt + (size_t)nxt.pn * tstep : cB;
        for (int t = 0; t < nt; t += 2) {
            const bool last = (t == nt - 2);
            const char* a1 = cA + (size_t)(t + 1) * kstep;
            const char* a2 = last ? nA : cA + (size_t)(t + 2) * kstep; const char* b2 = last ? nB : cB + (size_t)(t + 2) * kstep;
            const char* a3 = a2 + kstep; const char* b3 = b2 + kstep;
            if (last && has_next) S.a_ready(nxt);
            if constexpr (SP2) {
            PG8_LDB(B0, 0, 0); PG8_LDB(B1, 0, 1); PG8_SCHED; PG8_LDA(At, 0, 0); PG8_STAGE(PG8_SA(1, 1), a1 + hstep, voffA);
            PG8_WAIT_V(8); PG8_WAIT_L(0); PG8_BAR; PG8_MMA(0, 0, At, B0); PG8_MMA(0, 1, At, B1); PG8_BAR; PG8_SCHED;
            PG8_LDA(At, 0, 1); PG8_STAGE(PG8_SB(0, 0), b2, voffB); PG8_STAGE(PG8_SB(0, 1), b2 + hstep, voffB); PG8_STAGE(PG8_SA(0, 0), a2, voffA);
            PG8_WAIT_V(8); PG8_WAIT_L(0); PG8_BAR; PG8_MMA(1, 0, At, B0); PG8_MMA(1, 1, At, B1); PG8_BAR; PG8_SCHED;
            PG8_LDB(B0, 1, 0); PG8_LDB(B1, 1, 1); PG8_SCHED; PG8_LDA(At, 1, 0); PG8_STAGE(PG8_SA(0, 1), a2 + hstep, voffA);
            PG8_WAIT_V(8); PG8_WAIT_L(0); PG8_BAR; PG8_MMA(0, 0, At, B0); PG8_MMA(0, 1, At, B1); PG8_BAR; PG8_SCHED;
            PG8_LDA(At, 1, 1); PG8_STAGE(PG8_SB(1, 0), b3, voffB); PG8_STAGE(PG8_SB(1, 1), b3 + hstep, voffB); PG8_STAGE(PG8_SA(1, 0), a3, voffA);
            PG8_WAIT_V(8); PG8_WAIT_L(0); PG8_BAR; PG8_MMA(1, 0, At, B0); PG8_MMA(1, 1, At, B1); PG8_BAR; PG8_SCHED;
            } else {
            PG8_LDB(B0, 0, 0); PG8_SCHED; PG8_LDA(At, 0, 0); PG8_STAGE(PG8_SA(1, 1), a1 + hstep, voffA);
            PG8_WAIT_L(8); PG8_BAR; PG8_WAIT_L(0); PG8_MMA(0, 0, At, B0); PG8_BAR; PG8_SCHED;
            PG8_LDB(B1, 0, 1); PG8_STAGE(PG8_SB(0, 0), b2, voffB);
            PG8_BAR; PG8_WAIT_L(0); PG8_MMA(0, 1, At, B1); PG8_BAR;
            PG8_LDA(At, 0, 1); PG8_STAGE(PG8_SA(0, 0), a2, voffA);
            PG8_BAR; PG8_WAIT_L(0); PG8_MMA(1, 0, At, B0); PG8_BAR; PG8_SCHED;
            PG8_STAGE(PG8_SB(0, 1), b2 + hstep, voffB);
            PG8_WAIT_V(6); PG8_BAR; PG8_MMA(1, 1, At, B1); PG8_BAR;
            PG8_LDB(B0, 1, 0); PG8_SCHED; PG8_LDA(At, 1, 0); PG8_STAGE(PG8_SA(0, 1), a2 + hstep, voffA);
            PG8_WAIT_L(8); PG8_BAR; PG8_WAIT_L(0); PG8_MMA(0, 0, At, B0); PG8_BAR; PG8_SCHED;
            PG8_LDB(B1, 1, 1); PG8_STAGE(PG8_SB(1, 0), b3, voffB);
            PG8_BAR; PG8_WAIT_L(0); PG8_MMA(0, 1, At, B1); PG8_BAR;
            PG8_LDA(At, 1, 1); PG8_STAGE(PG8_SA(1, 0), a3, voffA);
            PG8_BAR; PG8_WAIT_L(0); PG8_MMA(1, 0, At, B0); PG8_BAR; PG8_SCHED;
            PG8_STAGE(PG8_SB(1, 1), b3 + hstep, voffB);
            PG8_WAIT_V(6); PG8_BAR; PG8_MMA(1, 1, At, B1); PG8_BAR;
            }
        }
        if constexpr (ALIGN_EPI) { if (wr == 0) PG8_BAR; }
        if constexpr (!Epi::AFTER_DRAIN) { E(acc, cur, wr, wc, fr, fq); S.done(cur); }
        if (!has_next) break;
#pragma unroll
        for (int a = 0; a < 2; ++a)
#pragma unroll
            for (int b = 0; b < 2; ++b)
#pragma unroll
                for (int m = 0; m < 4; ++m)
#pragma unroll
                    for (int n = 0; n < 2; ++n) acc[a][b][m][n] = (f32x4){0.f, 0.f, 0.f, 0.f};
        cur = nxt; cA = nA; cB = nB; ++ui;
        if constexpr (ALIGN_EPI) { if (wr == 1) PG8_BAR; }
    }
    PG8_WAIT_V(0);
    if constexpr (!ALIGN_EPI) { if (wr == 0) PG8_BAR; }
    PG8_BAR;
    if constexpr (Epi::AFTER_DRAIN) { E.fused(acc, cur, wr, wc, fr, fq, lds, wid, lane); S.done(cur); }
#undef PG8_SA
#undef PG8_SB
#undef PG8_STAGE
#undef PG8_LDA
#undef PG8_LDB
#undef PG8_MMA
#undef PG8_WAIT_V
#undef PG8_WAIT_L
#undef PG8_BAR
#undef PG8_SCHED
}
}
#ifndef PG8_SP2
#define PG8_SP2 true
#endif
#ifndef PG8_ALIGN
#define PG8_ALIGN true
#endif
constexpr int NWAVES = 8;
#ifndef MK_N_LAUNCHES
#define MK_N_LAUNCHES 1
#endif
constexpr int N_PHASES = 9;
constexpr int N_LAUNCHES = MK_N_LAUNCHES;

constexpr int DM = 1024, SEQ = 8192, NBATCH = 2, MP = NBATCH * SEQ, DBATCH = 128, DSEQ = 4, MS = DBATCH * DSEQ, M = MP + MS;
constexpr int NIN = 9344, NH = 9472;
constexpr int RW = 512, SHIFTC = 1664;
constexpr int C_R = 0, C_K = 512, C_V = 1024, C_WD = 1536, C_AD = 1600, C_ZR = 1792, C_AQ = 2304, C_AK = 3840, C_AV = 5376, C_ZA = 6912, C_GR = 7424, C_GA = 8448;
constexpr float LN_EPS = 1e-5f, GN_EPS = 64e-5f;
constexpr float ALPHA = 1.189207115002721f;
constexpr float ATT_SCALE = 0.08838834764831845f;
constexpr size_t O_YP = 0, O_YS = O_YP + (size_t)MP * DM, O_KV1P = O_YS + (size_t)MS * DM, O_KV1S = O_KV1P + (size_t)2 * 128 * 1024, O_KV2P = O_KV1S + (size_t)MS * 1024,
                 O_KV2S = O_KV2P + (size_t)2 * 512 * 1024, O_KV3P = O_KV2S + (size_t)MS * 1024, O_KV3S = O_KV3P + (size_t)2 * 2048 * 1024, O_WKVP = O_KV3S + (size_t)MS * 1024,
                 O_WKVS = O_WKVP + (size_t)2 * 8 * 64 * 64, O_SHP = O_WKVS + (size_t)128 * 8 * 64 * 64, O_SHS = O_SHP + (size_t)2 * SHIFTC, O_END = O_SHS + (size_t)128 * SHIFTC;
static_assert(O_END == 28855552, "d_out size");

constexpr size_t MiB = 1u << 20;
constexpr size_t WS_CTL = 0, CTL_ZERO_BYTES = 1 * MiB;
constexpr size_t WS_WIN = 2 * MiB, WS_WOA = 22 * MiB, WS_WOB = 23 * MiB, WS_WOUT = 24 * MiB;
constexpr size_t WS_XB = 32 * MiB, WS_H = 96 * MiB, WS_YR = 416 * MiB, WS_YA = 448 * MiB, WS_MIX = 480 * MiB, WS_MIXF = 528 * MiB, WS_PRE = 608 * MiB;
constexpr size_t WS_RR = 704 * MiB, WS_DEC = 744 * MiB, WS_K2 = 784 * MiB, WS_VV = 824 * MiB, WS_KK = 864 * MiB, WS_KA = 904 * MiB, WS_OO = 944 * MiB;
constexpr size_t WS_W2T = 26 * MiB, WS_A2T = 27 * MiB;
constexpr size_t WS_QE = 984 * MiB, WS_PT = 1000 * MiB, WS_S0B = 1016 * MiB, WS_OL = 1032 * MiB, WS_SL = 1064 * MiB, WS_VMX = 1096 * MiB, WS_BON = 1112 * MiB, WS_AO = 1120 * MiB  , WS_LSE = 1172 * MiB  , WS_REC = 1176 * MiB  , WS_END = 1224 * MiB;
static_assert(WS_WIN + (size_t)NH * DM * 2 <= WS_WOA && WS_XB + (size_t)M * DM * 2 <= WS_H && WS_H + (size_t)M * NH * 2 <= WS_YR, "ws map");
constexpr int CW_TMO = 0, CW_CODE = 1, CW_Q = 2048, CW_BAR = 4096;

constexpr int RING_OFF = 0, RING_BYTES = 131072;
constexpr int LDSCTL_OFF = 146432, MISC_OFF = LDSCTL_OFF + 320;
constexpr int LDS_BYTES = 147456;
#define GAS __attribute__((address_space(1)))
#define LAS __attribute__((address_space(3)))
typedef unsigned short bf16;
typedef unsigned v4u __attribute__((ext_vector_type(4)));
typedef float f32x4 __attribute__((ext_vector_type(4)));
typedef short bf16x8 __attribute__((ext_vector_type(8)));
typedef GAS unsigned gu32;
typedef GAS unsigned long long gu64;
#define RLX_AGENT __ATOMIC_RELAXED, __HIP_MEMORY_SCOPE_AGENT
#define LDS_WAIT() asm volatile("s_waitcnt lgkmcnt(0)" ::: "memory")
#define VM_WAIT() asm volatile("s_waitcnt vmcnt(0)" ::: "memory")
__device__ __forceinline__ unsigned long long rt() { return __builtin_amdgcn_s_memrealtime(); }
__device__ __forceinline__ unsigned f2bf(float f) { unsigned u = __builtin_bit_cast(unsigned, f); return (u + 0x7fffu + ((u >> 16) & 1u)) >> 16; }
__device__ __forceinline__ unsigned pk2(float lo, float hi) { return f2bf(lo) | (f2bf(hi) << 16); }

#define XB_TMO      128
#define XB_XCNT(j)  (256  + 64 * (j))
#define XB_XSUB(j)  (1280 + 64 * (j))
#define XB_XGEN(j)  (2304 + 64 * (j))
#define XB_TOP      3328
#define XB_TOPGEN   3392
#define XCD_BAR_WORDS 3456
#define XB_SPIN_CAP (1u << 18)

__device__ __forceinline__ unsigned xb_ld(unsigned* p)              { return __hip_atomic_load(p, __ATOMIC_RELAXED, __HIP_MEMORY_SCOPE_AGENT); }
__device__ __forceinline__ unsigned xb_add(unsigned* p, unsigned v) { return __hip_atomic_fetch_add(p, v, __ATOMIC_RELAXED, __HIP_MEMORY_SCOPE_AGENT); }
__device__ __forceinline__ unsigned xb_xcc_id() { return (unsigned)__builtin_amdgcn_s_getreg((3 << 11) | 20) & 0xFu; }
#define XB_SPIN(cond, bar) do { unsigned _sp = 0; while (cond) { __builtin_amdgcn_s_sleep(1); \
    if ((++_sp & 255u) == 0u) { if (xb_ld(&(bar)[XB_TMO])) break; if (_sp > XB_SPIN_CAP) { atomicAdd(&(bar)[XB_TMO], 1u); break; } } } } while (0)

struct XcdBarrier {
    unsigned* bar; unsigned x;
    volatile LAS unsigned* st;
};

__device__ __forceinline__ XcdBarrier xcd_barrier_post(unsigned* bar, volatile LAS unsigned* st) {
    XcdBarrier b; b.bar = bar; b.x = xb_xcc_id(); b.st = st;
    if (threadIdx.x == 0) (void)xb_add(&bar[XB_XCNT(b.x)], 1u);
    return b;
}
__device__ __forceinline__ void xcd_barrier_complete(unsigned* bar, unsigned x, unsigned& nloc, unsigned& nx) {
    const unsigned G = gridDim.x * gridDim.y * gridDim.z;
    unsigned sum, cnt, mine, sp = 0u;
    for (;;) {
        sum = 0u; cnt = 0u; mine = 0u;
#pragma unroll
        for (unsigned j = 0; j < 16; ++j) { const unsigned c = xb_ld(&bar[XB_XCNT(j)]); sum += c; cnt += (c > 0u) ? 1u : 0u; mine = (j == x) ? c : mine; }
        if (sum == G) break;
        __builtin_amdgcn_s_sleep(1);
        if ((++sp & 255u) == 0u) { if (xb_ld(&bar[XB_TMO])) break; if (sp > XB_SPIN_CAP) { atomicAdd(&bar[XB_TMO], 1u); break; } }
    }
    nloc = mine > 0u ? mine : 1u; nx = cnt > 0u ? cnt : 1u;
}

__device__ __forceinline__ void xcd_barrier(const XcdBarrier& b) {
    asm volatile("s_waitcnt vmcnt(0)" ::: "memory");
    __syncthreads();
    if (threadIdx.x == 0) {
        unsigned* bar = b.bar;
        __builtin_amdgcn_s_waitcnt(0);
        unsigned nloc = b.st[0], nx = b.st[1];
        if (nloc == 0u) { xcd_barrier_complete(bar, b.x, nloc, nx); b.st[0] = nloc; b.st[1] = nx; }
        const unsigned old = xb_add(&bar[XB_XSUB(b.x)], 1u);
        const unsigned gen = old / nloc;
        if (old + 1u == (gen + 1u) * nloc) {
            __builtin_amdgcn_fence(__ATOMIC_RELEASE, "agent");
            asm volatile("s_waitcnt vmcnt(0)" ::: "memory");
            const unsigned og = xb_add(&bar[XB_TOP], 1u);
            const unsigned tg = og / nx;
            if (og + 1u == (tg + 1u) * nx) xb_add(&bar[XB_TOPGEN], 1u);
            else XB_SPIN(xb_ld(&bar[XB_TOPGEN]) == tg, bar);
            __builtin_amdgcn_fence(__ATOMIC_ACQUIRE, "agent");
            xb_add(&bar[XB_XGEN(b.x)], 1u);
            asm volatile("s_waitcnt vmcnt(0)" ::: "memory");
        } else {
            XB_SPIN(xb_ld(&bar[XB_XGEN(b.x)]) == gen, bar);
            __builtin_amdgcn_fence(__ATOMIC_ACQUIRE, "agent");
            asm volatile("s_waitcnt vmcnt(0)" ::: "memory");
        }
    }
    __syncthreads();
}

typedef unsigned u32x2 __attribute__((ext_vector_type(2)));
__device__ __forceinline__ float bf2f(unsigned b) { return __builtin_bit_cast(float, b << 16); }
__device__ __forceinline__ float wave_sum(float v) {
#pragma unroll
    for (int o = 1; o < 64; o <<= 1) v += __shfl_xor(v, o);
    return v;
}
__device__ __forceinline__ float wave_max(float v) {
#pragma unroll
    for (int o = 1; o < 64; o <<= 1) v = fmaxf(v, __shfl_xor(v, o));
    return v;
}
__device__ __forceinline__ float sigmoidf_(float x) { return 1.0f / (1.0f + __expf(-x)); }
__device__ __forceinline__ float siluf_(float x) { return x / (1.0f + __expf(-x)); }

namespace pg8 {
struct EpiH {
    static constexpr bool PERM = true, AFTER_DRAIN = false;
    bf16_t* H; const float* bgate; float* out;
    __device__ __forceinline__ void operator()(const f32x4 (&acc)[2][2][4][2], const Unit& u, int wr, int wc, int fr, int fq) const {
        const int pn = u.pn;
        const int row0 = u.pm * BM + wr * 64 + fr, cw = wc * 32 + 8 * fq;
        const int mode = (pn >= 29) ? 2 : ((pn == 7 || pn == 8 || pn == 27 || pn == 28) ? 1 : 0);
        const bool is_zs = pn <= 6, is_kv = (pn >= 15 && pn <= 26);
        int kvsel = 0, g = 0, hcb = 0;
        if (is_kv) { int q = pn - 15; kvsel = q >= 6 ? 1 : 0; q = q >= 6 ? q - 6 : q; g = q >> 1; hcb = (q & 1) * 256; }
        const int keep = 128 << (2 * g);
        float* kvp = out + (g == 0 ? O_KV1P : (g == 1 ? O_KV2P : O_KV3P));
        float* kvs = out + (g == 0 ? O_KV1S : (g == 1 ? O_KV2S : O_KV3S));
        f32x4 bv[2][2];
#pragma unroll
        for (int bj = 0; bj < 2; ++bj)
#pragma unroll
            for (int n = 0; n < 2; ++n) bv[bj][n] = (mode == 2) ? *(const f32x4*)(bgate + (pn * BM + bj * HALF + cw - C_GR) + 4 * n) : (f32x4){0.f, 0.f, 0.f, 0.f};
#pragma unroll
        for (int ai = 0; ai < 2; ++ai)
#pragma unroll
            for (int m = 0; m < 4; ++m) {
                const int row = row0 + ai * HALF + m * 16;
                bf16_t* rowp = H + (size_t)row * NH + pn * BM + cw;
#pragma unroll
                for (int bj = 0; bj < 2; ++bj) {
                    f32x4 v0 = acc[ai][bj][m][0], v1 = acc[ai][bj][m][1];
                    const int col = pn * BM + bj * HALF + cw;
                    if (is_zs && col < SHIFTC) {
                        float* dst = nullptr;
                        if (row < MP) { if ((row & (SEQ - 1)) == SEQ - 1) dst = out + O_SHP + (size_t)(row >> 13) * SHIFTC + col; }
                        else if (((row - MP) & 3) == 3) dst = out + O_SHS + (size_t)((row - MP) >> 2) * SHIFTC + col;
                        if (dst) { *(f32x4*)dst = v0; *(f32x4*)(dst + 4) = v1; }
                    }
                    if (is_kv) {
                        const int hc = hcb + bj * HALF + cw;
                        float* dst = nullptr;
                        if (row < MP) { const int t = row & (SEQ - 1), b = row >> 13; if (t >= SEQ - keep) dst = kvp + ((size_t)(b * keep + t - (SEQ - keep)) * 2 + kvsel) * 512 + hc; }
                        else dst = kvs + ((size_t)(row - MP) * 2 + kvsel) * 512 + hc;
                        if (dst) { *(f32x4*)dst = v0; *(f32x4*)(dst + 4) = v1; }
                    }
                    if (mode == 1) {
#pragma unroll
                        for (int j = 0; j < 4; ++j) { v0[j] = siluf_(v0[j]); v1[j] = siluf_(v1[j]); }
                    } else if (mode == 2) {
                        v0 = v0 + bv[bj][0]; v1 = v1 + bv[bj][1];
#pragma unroll
                        for (int j = 0; j < 4; ++j) { v0[j] = sigmoidf_(v0[j]); v1[j] = sigmoidf_(v1[j]); }
                    }
                    u32x4 w; w.x = cvt_pk_bf16(v0[0], v0[1]); w.y = cvt_pk_bf16(v0[2], v0[3]); w.z = cvt_pk_bf16(v1[0], v1[1]); w.w = cvt_pk_bf16(v1[2], v1[3]);
                    *(u32x4*)(rowp + bj * HALF) = w;
                }
            }
    }
};
struct EpiMixA {
    static constexpr bool PERM = false, AFTER_DRAIN = false;
    const bf16_t* H; float* MIXF;
    __device__ __forceinline__ void operator()(const f32x4 (&acc)[2][2][4][2], const Unit& u, int wr, int wc, int fr, int fq) const {
        const int row0 = u.pm * BM + wr * 64 + fr, col0 = u.pn * BM + wc * 32 + 4 * fq;
#pragma unroll
        for (int ai = 0; ai < 2; ++ai)
#pragma unroll
            for (int m = 0; m < 4; ++m) { const int row = row0 + ai * HALF + m * 16;
#pragma unroll
                for (int bj = 0; bj < 2; ++bj)
#pragma unroll
                    for (int n = 0; n < 2; ++n) { const int c = col0 + bj * HALF + n * 16;
                        const u32x2 gb = *(const u32x2*)(H + (size_t)row * NH + C_GR + c);
                        f32x4 gt = {bf2f(gb.x & 0xffffu), bf2f(gb.x >> 16), bf2f(gb.y & 0xffffu), bf2f(gb.y >> 16)};
                        *(f32x4*)(MIXF + (size_t)row * DM + c) = gt * acc[ai][bj][m][n]; } }
    }
};
struct EpiMixB {
    static constexpr bool PERM = false, AFTER_DRAIN = false;
    const bf16_t* H; const float* MIXF; bf16_t* MIX;
    __device__ __forceinline__ void operator()(const f32x4 (&acc)[2][2][4][2], const Unit& u, int wr, int wc, int fr, int fq) const {
        const int row0 = u.pm * BM + wr * 64 + fr, col0 = u.pn * BM + wc * 32 + 4 * fq;
#pragma unroll
        for (int ai = 0; ai < 2; ++ai)
#pragma unroll
            for (int m = 0; m < 4; ++m) { const int row = row0 + ai * HALF + m * 16;
#pragma unroll
                for (int bj = 0; bj < 2; ++bj)
#pragma unroll
                    for (int n = 0; n < 2; ++n) { const int c = col0 + bj * HALF + n * 16;
                        const u32x2 gb = *(const u32x2*)(H + (size_t)row * NH + C_GA + c);
                        f32x4 gt = {bf2f(gb.x & 0xffffu), bf2f(gb.x >> 16), bf2f(gb.y & 0xffffu), bf2f(gb.y >> 16)};
                        const f32x4 v = *(const f32x4*)(MIXF + (size_t)row * DM + c) + gt * acc[ai][bj][m][n];
                        u32x2 w; w.x = cvt_pk_bf16(v[0], v[1]); w.y = cvt_pk_bf16(v[2], v[3]);
                        *(u32x2*)(MIX + (size_t)row * DM + c) = w; } }
    }
};
struct EpiPre {
    static constexpr bool PERM = false, AFTER_DRAIN = false;
    const float* xp; const float* xs; float* PRE;
    __device__ __forceinline__ void operator()(const f32x4 (&acc)[2][2][4][2], const Unit& u, int wr, int wc, int fr, int fq) const {
        const int row0 = u.pm * BM + wr * 64 + fr, col0 = u.pn * BM + wc * 32 + 4 * fq;
#pragma unroll
        for (int ai = 0; ai < 2; ++ai)
#pragma unroll
            for (int m = 0; m < 4; ++m) { const int row = row0 + ai * HALF + m * 16;
                const float* xr = row < MP ? xp + (size_t)row * DM : xs + (size_t)(row - MP) * DM;
#pragma unroll
                for (int bj = 0; bj < 2; ++bj)
#pragma unroll
                    for (int n = 0; n < 2; ++n) { const int c = col0 + bj * HALF + n * 16;
                        *(f32x4*)(PRE + (size_t)row * DM + c) = *(const f32x4*)(xr + c) * ALPHA + acc[ai][bj][m][n]; } }
    }
};
}

struct Args { const float* in[24]; float* out; unsigned char* ws; int ph_lo, ph_hi; };
struct Frame {
    LAS unsigned char* lds;
    volatile LAS unsigned* MISC;
    gu32* ctl;
    int tid, lane, wave, G;
};
#define XP_(A) ((A).in[0])
#define XS_(A) ((A).in[1])
#define C1_(A) ((A).in[2])
#define C2_(A) ((A).in[3])
#define C3_(A) ((A).in[4])
#define WKV0_(A) ((A).in[5])
#define SHIFT0_(A) ((A).in[6])
#define W_IN_(A) ((A).in[7])
#define B_GATE_(A) ((A).in[8])
#define MU_(A) ((A).in[9])
#define W0_(A) ((A).in[10])
#define W_W2_(A) ((A).in[11])
#define A0_(A) ((A).in[12])
#define W_A2_(A) ((A).in[13])
#define K_K_(A) ((A).in[14])
#define K_A_(A) ((A).in[15])
#define R_K_(A) ((A).in[16])
#define LNX_G_(A) ((A).in[17])
#define LNX_B_(A) ((A).in[18])
#define W_OA_(A) ((A).in[19])
#define W_OB_(A) ((A).in[20])
#define W_OUT_(A) ((A).in[21])
#define LN_G_(A) ((A).in[22])
#define LN_B_(A) ((A).in[23])
#define WSB_(A, off) ((bf16*)((A).ws + (off)))
#define WSF_(A, off) ((float*)((A).ws + (off)))

__device__ __forceinline__ void p0_transpose_item(const float* W, int K, int N, bf16* WT, int split_at, int split_add, LAS float* scr, int item, int lane) {
    const int nblk = N / 32, kb = item / nblk, nb = item % nblk, k0 = 64 * kb, n0 = 32 * nb;
    const int radd = n0 >= split_at ? split_add : 0;
#pragma unroll 8
    for (int i = 0; i < 32; ++i) { const int kk = 2 * i + (lane >> 5); scr[kk * 33 + (lane & 31)] = W[(size_t)(k0 + kk) * N + n0 + (lane & 31)]; }
    LDS_WAIT(); asm volatile("" ::: "memory");
    const int c = lane & 7;
#pragma unroll
    for (int j = 0; j < 4; ++j) { const int n = (lane >> 3) + 8 * j; const LAS float* s = scr + (8 * c) * 33 + n;
        v4u o; o.x = pk2(s[0 * 33], s[1 * 33]); o.y = pk2(s[2 * 33], s[3 * 33]); o.z = pk2(s[4 * 33], s[5 * 33]); o.w = pk2(s[6 * 33], s[7 * 33]);
        *(GAS v4u*)(WT + (size_t)(radd + n0 + n) * K + k0 + 8 * c) = o; }
    LDS_WAIT(); asm volatile("" ::: "memory");
}
__device__ __forceinline__ void p0_prologue(Frame& F, const Args& A) {
    LAS float* scr = (LAS float*)(F.lds + RING_OFF + F.wave * 16384);
    const int gw = blockIdx.x * NWAVES + F.wave, NGW = F.G * NWAVES;
    constexpr int I_IN = (DM / 64) * (NIN / 32), I_OA = (RW / 64) * (DM / 32), I_OUT = (DM / 64) * (DM / 32);
    constexpr int I_LR = (RW / 32);
    constexpr int NITEMS = I_IN + 2 * I_OA + I_OUT + 2 * I_LR;
    for (int it = gw; it < NITEMS; it += NGW) {
        int r = it;
        if (r < I_IN) { p0_transpose_item(W_IN_(A), DM, NIN, WSB_(A, WS_WIN), SHIFTC, 128, scr, r, F.lane); continue; } r -= I_IN;
        if (r < I_OA) { p0_transpose_item(W_OA_(A), RW, DM, WSB_(A, WS_WOA), 1 << 30, 0, scr, r, F.lane); continue; } r -= I_OA;
        if (r < I_OA) { p0_transpose_item(W_OB_(A), RW, DM, WSB_(A, WS_WOB), 1 << 30, 0, scr, r, F.lane); continue; } r -= I_OA;
        if (r < I_OUT) { p0_transpose_item(W_OUT_(A), DM, DM, WSB_(A, WS_WOUT), 1 << 30, 0, scr, r, F.lane); continue; } r -= I_OUT;
        if (r < I_LR) { p0_transpose_item(W_W2_(A), 64, RW, WSB_(A, WS_W2T), 1 << 30, 0, scr, r, F.lane); continue; } r -= I_LR;
        p0_transpose_item(W_A2_(A), 64, RW, WSB_(A, WS_A2T), 1 << 30, 0, scr, r, F.lane);
    }
    const size_t gt = (size_t)blockIdx.x * 512 + F.tid, GT = (size_t)F.G * 512;
    for (size_t i = gt; i < (size_t)128 * DM / 8; i += GT) *(GAS v4u*)(WSB_(A, WS_WIN) + (size_t)SHIFTC * DM + i * 8) = (v4u){0u, 0u, 0u, 0u};
    for (size_t i = gt; i < (size_t)M * DM / 8; i += GT) {
        const size_t e = i * 8; const float* src = e < (size_t)MP * DM ? XP_(A) + e : XS_(A) + (e - (size_t)MP * DM);
        const f32x4 a = *(const GAS f32x4*)src, b = *(const GAS f32x4*)(src + 4);
        v4u o; o.x = pk2(a.x, a.y); o.y = pk2(a.z, a.w); o.z = pk2(b.x, b.y); o.w = pk2(b.z, b.w);
        *(GAS v4u*)(WSB_(A, WS_XB) + e) = o;
    }
}

__device__ __forceinline__ void ld8bf(const bf16* p, float (&v)[8]) {
    const v4u w = *(const GAS v4u*)p;
    v[0] = bf2f(w.x & 0xffffu); v[1] = bf2f(w.x >> 16); v[2] = bf2f(w.y & 0xffffu); v[3] = bf2f(w.y >> 16);
    v[4] = bf2f(w.z & 0xffffu); v[5] = bf2f(w.z >> 16); v[6] = bf2f(w.w & 0xffffu); v[7] = bf2f(w.w >> 16);
}
__device__ __forceinline__ void ld8f(const float* p, float (&v)[8]) {
    const f32x4 a = *(const GAS f32x4*)p, b = *(const GAS f32x4*)(p + 4);
    v[0] = a.x; v[1] = a.y; v[2] = a.z; v[3] = a.w; v[4] = b.x; v[5] = b.y; v[6] = b.z; v[7] = b.w;
}
__device__ __forceinline__ void st8f(float* p, const float (&v)[8]) {
    *(GAS f32x4*)p = (f32x4){v[0], v[1], v[2], v[3]}; *(GAS f32x4*)(p + 4) = (f32x4){v[4], v[5], v[6], v[7]};
}
__device__ __forceinline__ void mixed8(Frame& F, const Args& A, int m, int c0, float (&z)[8]) {
    ld8bf(WSB_(A, WS_H) + (size_t)m * NH + c0, z);
    float p[8], mu[8];
    bool first; int sb = 0;
    if (m < MP) first = (m & (SEQ - 1)) == 0; else { first = ((m - MP) & 3) == 0; sb = (m - MP) >> 2; }
    if (!first) ld8bf(WSB_(A, WS_H) + (size_t)(m - 1) * NH + c0, p);
    else if (m < MP) {
#pragma unroll
        for (int j = 0; j < 8; ++j) p[j] = 0.f;
    } else ld8f(SHIFT0_(A) + (size_t)sb * SHIFTC + c0, p);
    ld8f(MU_(A) + c0, mu);
#pragma unroll
    for (int j = 0; j < 8; ++j) z[j] = z[j] + mu[j] * (p[j] - z[j]);
}
__device__ __forceinline__ void rwkv_prep_row(Frame& F, const Args& A, int m) {
    const int lane = F.lane, c0 = lane * 8;
    float r[8], k[8], v[8];
    mixed8(F, A, m, C_R + c0, r); mixed8(F, A, m, C_K + c0, k); mixed8(F, A, m, C_V + c0, v);
    float wa8[8];
#pragma unroll
    for (int j = 0; j < 8; ++j) wa8[j] = 0.f;
    if (lane < 16) mixed8(F, A, m, C_WD + c0, wa8);
    float wdl = 0.f, adl = 0.f;
#pragma unroll
    for (int j = 0; j < 8; ++j) { const float a = __shfl(wa8[j], lane >> 3), b = __shfl(wa8[j], 8 + (lane >> 3)); if ((lane & 7) == j) { wdl = a; adl = b; } }
    wdl = tanhf(wdl);
    float wp[8], ap[8];
#pragma unroll
    for (int j = 0; j < 8; ++j) { wp[j] = 0.f; ap[j] = 0.f; }
    for (int j = 0; j < 64; ++j) {
        const float tw = __shfl(wdl, j), ta = __shfl(adl, j);
        float w2[8], a2[8]; ld8f(W_W2_(A) + (size_t)j * RW + c0, w2); ld8f(W_A2_(A) + (size_t)j * RW + c0, a2);
#pragma unroll
        for (int q = 0; q < 8; ++q) { wp[q] += tw * w2[q]; ap[q] += ta * a2[q]; }
    }
    float w0[8], a0[8], kkc[8], kac[8];
    ld8f(W0_(A) + c0, w0); ld8f(A0_(A) + c0, a0); ld8f(K_K_(A) + c0, kkc); ld8f(K_A_(A) + c0, kac);
    float dec[8], kk[8], ka[8], k2[8]; float ss = 0.f;
#pragma unroll
    for (int j = 0; j < 8; ++j) {
        const float x = -(w0[j] + wp[j]);
        const float sp = fmaxf(x, 0.f) + log1pf(__expf(-fabsf(x)));
        const float w = -sp - 0.5f;
        dec[j] = __expf(-__expf(w));
        const float a = sigmoidf_(a0[j] + ap[j]);
        kk[j] = k[j] * kkc[j]; ss += kk[j] * kk[j];
        k2[j] = k[j] * (1.0f + (a - 1.0f) * kac[j]);
        ka[j] = a;
    }
    ss += __shfl_xor(ss, 1); ss += __shfl_xor(ss, 2); ss += __shfl_xor(ss, 4);
    const float inv = 1.0f / fmaxf(sqrtf(ss), 1e-12f);
#pragma unroll
    for (int j = 0; j < 8; ++j) { kk[j] *= inv; ka[j] *= kk[j]; }
    const size_t o = (size_t)m * RW + c0;
    st8f(WSF_(A, WS_RR) + o, r); st8f(WSF_(A, WS_DEC) + o, dec); st8f(WSF_(A, WS_K2) + o, k2); st8f(WSF_(A, WS_VV) + o, v); st8f(WSF_(A, WS_KK) + o, kk); st8f(WSF_(A, WS_KA) + o, ka);
}

template <bool PROMPT>
__device__ __forceinline__ void attn_item(Frame& F, const Args& A, int m, int h, LAS float* sq, LAS float* sp) {
    const int lane = F.lane;
    int b, t; if (PROMPT) { b = m >> 13; t = m & (SEQ - 1); } else { b = (m - MP) >> 2; t = (m - MP) & 3; }
    float og[3][2], lse[3];
#pragma unroll
    for (int g = 0; g < 3; ++g) {
        const int d = 1 << (2 * g), Wb = 128 << (2 * g);
        const float* cache = g == 0 ? C1_(A) : (g == 1 ? C2_(A) : C3_(A));
        const int hoff = g * 512 + h * 128;
        { const unsigned qq = *(const GAS unsigned*)(WSB_(A, WS_H) + (size_t)m * NH + C_AQ + hoff + 2 * lane); sq[2 * lane] = bf2f(qq & 0xffffu); sq[2 * lane + 1] = bf2f(qq >> 16); }
        LDS_WAIT(); asm volatile("" ::: "memory");
        float s[3];
#pragma unroll
        for (int kx = 0; kx < 3; ++kx) {
            const int j = lane + 64 * kx; float sc = -1e30f;
            if (kx < 2 || lane == 0) {
                const bf16* kr = nullptr; const float* kf = nullptr;
                if (PROMPT) { const int tk = t - j * d; if (tk >= 0) kr = WSB_(A, WS_H) + (size_t)(b * SEQ + tk) * NH + C_AK + hoff; }
                else { const int idx = Wb + t - j * d; if (idx >= Wb) kr = WSB_(A, WS_H) + (size_t)(MP + b * DSEQ + idx - Wb) * NH + C_AK + hoff; else kf = cache + ((size_t)(b * Wb + idx) * 2 + 0) * 512 + h * 128; }
                if (kr) { float a = 0.f;
                    for (int e = 0; e < 128; e += 8) { float kv[8]; ld8bf(kr + e, kv);
#pragma unroll
                        for (int q = 0; q < 8; ++q) a += sq[e + q] * kv[q]; }
                    sc = a * ATT_SCALE; }
                else if (kf) { float a = 0.f;
                    for (int e = 0; e < 128; e += 8) { float kv[8]; ld8f(kf + e, kv);
#pragma unroll
                        for (int q = 0; q < 8; ++q) a += sq[e + q] * kv[q]; }
                    sc = a * ATT_SCALE; }
            }
            s[kx] = sc;
        }
        const float mx = wave_max(fmaxf(fmaxf(s[0], s[1]), s[2]));
        float p[3]; float ls = 0.f;
#pragma unroll
        for (int kx = 0; kx < 3; ++kx) { p[kx] = s[kx] > -1e29f ? __expf(s[kx] - mx) : 0.f; ls += p[kx]; }
        const float l = wave_sum(ls);
        sp[lane] = p[0]; sp[lane + 64] = p[1]; if (lane == 0) sp[128] = p[2];
        LDS_WAIT(); asm volatile("" ::: "memory");
        float a0 = 0.f, a1 = 0.f;
        for (int j = 0; j < 129; ++j) {
            const float pj = sp[j];
            if (PROMPT) { const int tk = t - j * d; if (tk >= 0) { const unsigned vv = *(const GAS unsigned*)(WSB_(A, WS_H) + (size_t)(b * SEQ + tk) * NH + C_AV + hoff + 2 * lane); a0 += pj * bf2f(vv & 0xffffu); a1 += pj * bf2f(vv >> 16); } }
            else { const int idx = Wb + t - j * d;
                if (idx >= Wb) { const unsigned vv = *(const GAS unsigned*)(WSB_(A, WS_H) + (size_t)(MP + b * DSEQ + idx - Wb) * NH + C_AV + hoff + 2 * lane); a0 += pj * bf2f(vv & 0xffffu); a1 += pj * bf2f(vv >> 16); }
                else { const float* vf = cache + ((size_t)(b * Wb + idx) * 2 + 1) * 512 + h * 128 + 2 * lane; a0 += pj * vf[0]; a1 += pj * vf[1]; } }
        }
        const float il = 1.0f / l;
        og[g][0] = a0 * il; og[g][1] = a1 * il; lse[g] = mx + __logf(l);
        LDS_WAIT(); asm volatile("" ::: "memory");
    }
    const float ml = fmaxf(fmaxf(lse[0], lse[1]), lse[2]);
    const float w0 = __expf(lse[0] - ml), w1 = __expf(lse[1] - ml), w2 = __expf(lse[2] - ml), iw = 1.0f / (w0 + w1 + w2);
    const unsigned zz = *(const GAS unsigned*)(WSB_(A, WS_H) + (size_t)m * NH + C_ZA + h * 128 + 2 * lane);
    const float y0 = (w0 * og[0][0] + w1 * og[1][0] + w2 * og[2][0]) * iw * bf2f(zz & 0xffffu);
    const float y1 = (w0 * og[0][1] + w1 * og[1][1] + w2 * og[2][1]) * iw * bf2f(zz >> 16);
    *(GAS unsigned*)(WSB_(A, WS_YA) + (size_t)m * RW + h * 128 + 2 * lane) = pk2(y0, y1);
}

__device__ __forceinline__ void scan_item(Frame& F, const Args& A, int item) {
    const int lane = F.lane;
    int T, row0, h; float* sout; const float* s0 = nullptr;
    if (item < 16) { const int b = item >> 3; h = item & 7; T = SEQ; row0 = b * SEQ; sout = A.out + O_WKVP + ((size_t)(b * 8 + h) * 64 + lane) * 64; }
    else { const int s = item - 16, b = s >> 3; h = s & 7; T = DSEQ; row0 = MP + b * DSEQ; sout = A.out + O_WKVS + ((size_t)(b * 8 + h) * 64 + lane) * 64; s0 = WKV0_(A) + ((size_t)(b * 8 + h) * 64 + lane) * 64; }
    float S[64];
#pragma unroll
    for (int k = 0; k < 64; k += 4) { f32x4 v = s0 ? *(const GAS f32x4*)(s0 + k) : (f32x4){0.f, 0.f, 0.f, 0.f}; S[k] = v.x; S[k + 1] = v.y; S[k + 2] = v.z; S[k + 3] = v.w; }
    for (int t = 0; t < T; ++t) {
        const size_t base = (size_t)(row0 + t) * RW + h * 64;
        const float vi = WSF_(A, WS_VV)[base + lane];
        float sa = 0.f;
#pragma unroll
        for (int k = 0; k < 64; k += 4) { const f32x4 q = *(const GAS f32x4*)(WSF_(A, WS_KK) + base + k); sa -= S[k] * q.x; sa -= S[k + 1] * q.y; sa -= S[k + 2] * q.z; sa -= S[k + 3] * q.w; if ((k & 15) == 12) asm volatile("" ::: "memory"); }
        float o = 0.f;
#pragma unroll
        for (int k = 0; k < 64; k += 4) {
            const f32x4 dc = *(const GAS f32x4*)(WSF_(A, WS_DEC) + base + k), ka = *(const GAS f32x4*)(WSF_(A, WS_KA) + base + k), k2 = *(const GAS f32x4*)(WSF_(A, WS_K2) + base + k), rr = *(const GAS f32x4*)(WSF_(A, WS_RR) + base + k);
            S[k] = S[k] * dc.x + sa * ka.x + vi * k2.x; S[k + 1] = S[k + 1] * dc.y + sa * ka.y + vi * k2.y; S[k + 2] = S[k + 2] * dc.z + sa * ka.z + vi * k2.z; S[k + 3] = S[k + 3] * dc.w + sa * ka.w + vi * k2.w;
            o += S[k] * rr.x; o += S[k + 1] * rr.y; o += S[k + 2] * rr.z; o += S[k + 3] * rr.w;
            if ((k & 7) == 4) asm volatile("" ::: "memory");
        }
        WSF_(A, WS_OO)[base + lane] = o;
    }
#pragma unroll
    for (int k = 0; k < 64; k += 4) *(GAS f32x4*)(sout + k) = (f32x4){S[k], S[k + 1], S[k + 2], S[k + 3]};
}

__device__ __forceinline__ void rwkv_post_row(Frame& F, const Args& A, int m) {
    const int lane = F.lane, c0 = lane * 8; const size_t o = (size_t)m * RW + c0;
    float ov[8], r[8], k2[8], v[8], rk[8], g[8], bb[8], z[8];
    ld8f(WSF_(A, WS_OO) + o, ov); ld8f(WSF_(A, WS_RR) + o, r); ld8f(WSF_(A, WS_K2) + o, k2); ld8f(WSF_(A, WS_VV) + o, v); ld8f(R_K_(A) + c0, rk); ld8f(LNX_G_(A) + c0, g); ld8f(LNX_B_(A) + c0, bb);
    ld8bf(WSB_(A, WS_H) + (size_t)m * NH + C_ZR + c0, z);
    float s = 0.f, bs = 0.f;
#pragma unroll
    for (int j = 0; j < 8; ++j) { s += ov[j]; bs += r[j] * k2[j] * rk[j]; }
    s += __shfl_xor(s, 1); s += __shfl_xor(s, 2); s += __shfl_xor(s, 4);
    bs += __shfl_xor(bs, 1); bs += __shfl_xor(bs, 2); bs += __shfl_xor(bs, 4);
    const float mean = s * (1.0f / 64.0f); float q = 0.f;
#pragma unroll
    for (int j = 0; j < 8; ++j) { const float dlt = ov[j] - mean; q += dlt * dlt; }
    q += __shfl_xor(q, 1); q += __shfl_xor(q, 2); q += __shfl_xor(q, 4);
    const float rstd = 1.0f / sqrtf(q * (1.0f / 64.0f) + GN_EPS);
    float y[8];
#pragma unroll
    for (int j = 0; j < 8; ++j) y[j] = ((ov[j] - mean) * rstd * g[j] + bb[j] + bs * v[j]) * z[j];
    v4u w; w.x = pk2(y[0], y[1]); w.y = pk2(y[2], y[3]); w.z = pk2(y[4], y[5]); w.w = pk2(y[6], y[7]);
    *(GAS v4u*)(WSB_(A, WS_YR) + o) = w;
}

typedef short s16x4 __attribute__((ext_vector_type(4)));
typedef short v4i16_t __attribute__((ext_vector_type(4)));
constexpr int LDP = 72;
constexpr int ARRB = 64 * LDP * 2;
enum { A_AT = 0, A_BH, A_KH, A_RT, A_VQ, A_XA, A_XB, A_TA, A_TB, A_MAK, A_MRB, A_MRK, A_NARR };
constexpr int A_SMALL = A_NARR * ARRB;
static_assert(A_SMALL + 4096 <= RING_BYTES, "phase A LDS");
constexpr int NUNITS = 16 * 128;

__device__ __forceinline__ f32x4 mfma16(bf16x8 a, bf16x8 b, f32x4 c) { return __builtin_amdgcn_mfma_f32_16x16x32_bf16(a, b, c, 0, 0, 0); }
__device__ __forceinline__ bf16x8 frag_rows(const LAS bf16* X, int row0, int k0, int lane) { return *(const LAS bf16x8*)(X + (row0 + (lane & 15)) * LDP + k0 + 8 * (lane >> 4)); }
__device__ __forceinline__ bf16x8 frag_tr(const LAS bf16* X, int k0, int col0, int lane) {
    const int g = lane >> 4, i = lane & 15;
    const LAS bf16* a0 = X + (k0 + 8 * g + (i >> 2)) * LDP + col0 + 4 * (i & 3);
    const s16x4 lo = __builtin_bit_cast(s16x4, __builtin_amdgcn_ds_read_tr16_b64_v4i16((LAS v4i16_t*)a0));
    const s16x4 hi = __builtin_bit_cast(s16x4, __builtin_amdgcn_ds_read_tr16_b64_v4i16((LAS v4i16_t*)(a0 + 4 * LDP)));
    return __builtin_shufflevector(lo, hi, 0, 1, 2, 3, 4, 5, 6, 7);
}
__device__ __forceinline__ u32x2 pk4(f32x4 v) { u32x2 w; w.x = pk2(v[0], v[1]); w.y = pk2(v[2], v[3]); return w; }
__device__ __forceinline__ f32x4 up4(u32x2 w) { return (f32x4){bf2f(w.x & 0xffffu), bf2f(w.x >> 16), bf2f(w.y & 0xffffu), bf2f(w.y >> 16)}; }
__device__ __forceinline__ void st4(LAS bf16* X, int row, int col, f32x4 v) { *(LAS u32x2*)(X + row * LDP + col) = pk4(v); }
__device__ __forceinline__ f32x4 ld4(const LAS bf16* X, int row, int col) { return up4(*(const LAS u32x2*)(X + row * LDP + col)); }
__device__ __forceinline__ float dpp_shr(float x, int n) {
    const int iv = __builtin_bit_cast(int, x); int r;
    switch (n) { case 1: r = __builtin_amdgcn_update_dpp(0, iv, 0x111, 0xf, 0xf, true); break; case 2: r = __builtin_amdgcn_update_dpp(0, iv, 0x112, 0xf, 0xf, true); break;
                 case 4: r = __builtin_amdgcn_update_dpp(0, iv, 0x114, 0xf, 0xf, true); break; default: r = __builtin_amdgcn_update_dpp(0, iv, 0x118, 0xf, 0xf, true); break; }
    return __builtin_bit_cast(float, r);
}
__device__ __forceinline__ float row_scan(float x) { x += dpp_shr(x, 1); x += dpp_shr(x, 2); x += dpp_shr(x, 4); x += dpp_shr(x, 8); return x; }
__device__ __forceinline__ f32x4 mixed4(const bf16* H, const float* mu, int m, int col, bool first) {
    const f32x4 z = up4(*(const GAS u32x2*)(H + (size_t)m * NH + col));
    f32x4 p = {0.f, 0.f, 0.f, 0.f};
    if (!first) p = up4(*(const GAS u32x2*)(H + (size_t)(m - 1) * NH + col));
    const f32x4 mv = *(const GAS f32x4*)(mu + col);
    return z + mv * (p - z);
}
__device__ __forceinline__ void pq2(const LAS bf16* P, const LAS bf16* Q, int tt, int hf, int lane, f32x4 (&acc)[2]) {
#pragma unroll
    for (int ks = 0; ks < 2; ++ks) { const bf16x8 bp = frag_rows(P, 16 * tt, 32 * ks, lane);
#pragma unroll
        for (int j = 0; j < 2; ++j) acc[j] = mfma16(frag_tr(Q, 32 * ks, 16 * (2 * hf + j), lane), bp, acc[j]); }
}
#define WG_BAR() do { asm volatile("s_waitcnt vmcnt(0) lgkmcnt(0)" ::: "memory"); __builtin_amdgcn_s_barrier(); asm volatile("" ::: "memory"); } while (0)

__device__ __forceinline__ void rwkvA_unit(Frame& F, const Args& A, int unit) {
    const int lane = F.lane, w = F.wave, tt = w & 3, hf = w >> 2, i = lane & 15, g = lane >> 4;
    const int bh = unit >> 7, c = unit & 127, b = bh >> 3, h = bh & 7;
    const int t = 16 * tt + i, m = b * SEQ + c * 64 + t;
    const bool first = (c == 0) && (t == 0);
    LAS unsigned char* L = F.lds + RING_OFF;
#define ARR(k) ((LAS bf16*)(L + (k) * ARRB))
    LAS float* tot = (LAS float*)(L + A_SMALL); LAS float* gcl = tot + 256; LAS float* pss = gcl + 64; LAS float* pbn = pss + 128;
    const bf16* H = WSB_(A, WS_H);
    const float z4[4] = {0.f, 0.f, 0.f, 0.f}; (void)z4;
    f32x4 rv[2], kv[2], vv[2];
#pragma unroll
    for (int j = 0; j < 2; ++j) { const int cb = 16 * (2 * hf + j) + 4 * g;
        rv[j] = mixed4(H, MU_(A), m, C_R + h * 64 + cb, first); kv[j] = mixed4(H, MU_(A), m, C_K + h * 64 + cb, first); vv[j] = mixed4(H, MU_(A), m, C_V + h * 64 + cb, first);
        f32x4 wd = mixed4(H, MU_(A), m, C_WD + cb, first); const f32x4 ad = mixed4(H, MU_(A), m, C_AD + cb, first);
#pragma unroll
        for (int r = 0; r < 4; ++r) wd[r] = tanhf(wd[r]);
        st4(ARR(A_XA), t, cb, wd); st4(ARR(A_XB), t, cb, ad); }
    WG_BAR();
    f32x4 aw[2] = {{0.f, 0.f, 0.f, 0.f}, {0.f, 0.f, 0.f, 0.f}}, aa[2] = {{0.f, 0.f, 0.f, 0.f}, {0.f, 0.f, 0.f, 0.f}};
#pragma unroll
    for (int ks = 0; ks < 2; ++ks) { const bf16x8 btw = frag_rows(ARR(A_XA), 16 * tt, 32 * ks, lane), bad = frag_rows(ARR(A_XB), 16 * tt, 32 * ks, lane);
#pragma unroll
        for (int j = 0; j < 2; ++j) { const size_t wo = (size_t)(h * 64 + 16 * (2 * hf + j) + i) * 64 + 32 * ks + 8 * g;
            const bf16x8 a_w = *(const GAS bf16x8*)(WSB_(A, WS_W2T) + wo), a_a = *(const GAS bf16x8*)(WSB_(A, WS_A2T) + wo);
            aw[j] = mfma16(a_w, btw, aw[j]); aa[j] = mfma16(a_a, bad, aa[j]); } }
    f32x4 ld[2], av[2], kkr[2], k2[2], cum[2]; float ssq = 0.f, bon = 0.f;
#pragma unroll
    for (int j = 0; j < 2; ++j) { const int hc = h * 64 + 16 * (2 * hf + j) + 4 * g;
        const f32x4 w0 = *(const GAS f32x4*)(W0_(A) + hc), a0 = *(const GAS f32x4*)(A0_(A) + hc), kkc = *(const GAS f32x4*)(K_K_(A) + hc), kac = *(const GAS f32x4*)(K_A_(A) + hc), rkc = *(const GAS f32x4*)(R_K_(A) + hc);
#pragma unroll
        for (int r = 0; r < 4; ++r) {
            const float x = -(w0[r] + aw[j][r]); const float sp = fmaxf(x, 0.f) + log1pf(__expf(-fabsf(x)));
            ld[j][r] = -__expf(-sp - 0.5f);
            const float a = sigmoidf_(a0[r] + aa[j][r]); av[j][r] = a;
            kkr[j][r] = kv[j][r] * kkc[r]; ssq += kkr[j][r] * kkr[j][r];
            k2[j][r] = kv[j][r] * (1.0f + (a - 1.0f) * kac[r]);
            bon += rv[j][r] * k2[j][r] * rkc[r];
            cum[j][r] = row_scan(ld[j][r]);
        }
        if (i == 15) *(LAS f32x4*)(tot + tt * 64 + 16 * (2 * hf + j) + 4 * g) = cum[j]; }
    ssq += __shfl_xor(ssq, 16); ssq += __shfl_xor(ssq, 32); bon += __shfl_xor(bon, 16); bon += __shfl_xor(bon, 32);
    if (g == 0) { pss[w * 16 + i] = ssq; pbn[w * 16 + i] = bon; }
    WG_BAR();
    ssq = pss[w * 16 + i] + pss[(w ^ 4) * 16 + i]; bon = pbn[w * 16 + i] + pbn[(w ^ 4) * 16 + i];
    const float inv = 1.0f / fmaxf(sqrtf(ssq), 1e-12f);
#pragma unroll
    for (int j = 0; j < 2; ++j) { const int cb = 16 * (2 * hf + j) + 4 * g;
        f32x4 off = {0.f, 0.f, 0.f, 0.f}, all = {0.f, 0.f, 0.f, 0.f};
#pragma unroll
        for (int q = 0; q < 4; ++q) { const f32x4 tq = *(const LAS f32x4*)(tot + q * 64 + cb); all = all + tq; if (q < tt) off = off + tq; }
        f32x4 at, bhv, khv, rt;
#pragma unroll
        for (int r = 0; r < 4; ++r) { const float cm = cum[j][r] + off[r]; const float ep = __expf(cm), em = __expf(-cm), epv = __expf(cm - ld[j][r]); const float kk = kkr[j][r] * inv;
            at[r] = -kk * epv; bhv[r] = kk * av[j][r] * em; khv[r] = k2[j][r] * em; rt[r] = rv[j][r] * ep; }
        st4(ARR(A_AT), t, cb, at); st4(ARR(A_BH), t, cb, bhv); st4(ARR(A_KH), t, cb, khv); st4(ARR(A_RT), t, cb, rt); st4(ARR(A_VQ), t, cb, vv[j]);
        *(GAS u32x2*)(WSB_(A, WS_VMX) + (size_t)m * RW + h * 64 + cb) = pk4(vv[j]);
        if (tt == 0 && i == 0) { f32x4 gc; for (int r = 0; r < 4; ++r) gc[r] = __expf(all[r]); *(LAS f32x4*)(gcl + cb) = gc; } }
    if (hf == 0 && g == 0) WSF_(A, WS_BON)[(size_t)m * 8 + h] = bon;
    WG_BAR();
#pragma unroll
    for (int j = 0; j < 2; ++j) { const int mt = 2 * hf + j;
        f32x4 ab = {0.f, 0.f, 0.f, 0.f}, ak = ab, rb = ab, rk = ab;
        if (mt <= tt) {
#pragma unroll
            for (int ks = 0; ks < 2; ++ks) { const bf16x8 abh = frag_rows(ARR(A_BH), 16 * mt, 32 * ks, lane), akh = frag_rows(ARR(A_KH), 16 * mt, 32 * ks, lane), bat = frag_rows(ARR(A_AT), 16 * tt, 32 * ks, lane), brt = frag_rows(ARR(A_RT), 16 * tt, 32 * ks, lane);
                ab = mfma16(abh, bat, ab); ak = mfma16(akh, bat, ak); rb = mfma16(abh, brt, rb); rk = mfma16(akh, brt, rk); } }
        f32x4 t1;
#pragma unroll
        for (int r = 0; r < 4; ++r) { const int s = 16 * mt + 4 * g + r; const bool lt = s < t, le = s <= t;
            ab[r] = lt ? ab[r] : 0.f; ak[r] = lt ? ak[r] : 0.f; rb[r] = le ? rb[r] : 0.f; rk[r] = le ? rk[r] : 0.f; t1[r] = ab[r] + (s == t ? 1.0f : 0.f); }
        const int cb = 16 * mt + 4 * g;
        st4(ARR(A_XA), t, cb, ab); st4(ARR(A_TA), t, cb, t1); st4(ARR(A_MAK), t, cb, ak); st4(ARR(A_MRB), t, cb, rb); st4(ARR(A_MRK), t, cb, rk); }
    WG_BAR();
    const int cb0 = 16 * (2 * hf) + 4 * g, cb1 = cb0 + 16;
#define SQ_STAGE(XC, XN) do { f32x4 z[2] = {{0.f, 0.f, 0.f, 0.f}, {0.f, 0.f, 0.f, 0.f}}; pq2(ARR(XC), ARR(XC), tt, hf, lane, z); st4(ARR(XN), t, cb0, z[0]); st4(ARR(XN), t, cb1, z[1]); } while (0)
#define T_STAGE(TC, TN, XC) do { f32x4 z[2]; z[0] = ld4(ARR(TC), t, cb0); z[1] = ld4(ARR(TC), t, cb1); pq2(ARR(TC), ARR(XC), tt, hf, lane, z); st4(ARR(TN), t, cb0, z[0]); st4(ARR(TN), t, cb1, z[1]); } while (0)
    SQ_STAGE(A_XA, A_XB); WG_BAR();
    SQ_STAGE(A_XB, A_XA); T_STAGE(A_TA, A_TB, A_XB); WG_BAR();
    SQ_STAGE(A_XA, A_XB); T_STAGE(A_TB, A_TA, A_XA); WG_BAR();
    SQ_STAGE(A_XB, A_XA); T_STAGE(A_TA, A_TB, A_XB); WG_BAR();
    SQ_STAGE(A_XA, A_XB); T_STAGE(A_TB, A_TA, A_XA); WG_BAR();
    T_STAGE(A_TA, A_TB, A_XB); WG_BAR();
    { f32x4 z[2] = {{0.f, 0.f, 0.f, 0.f}, {0.f, 0.f, 0.f, 0.f}}; pq2(ARR(A_TB), ARR(A_AT), tt, hf, lane, z); st4(ARR(A_XA), t, cb0, z[0]); st4(ARR(A_XA), t, cb1, z[1]); }
    { f32x4 z[2] = {{0.f, 0.f, 0.f, 0.f}, {0.f, 0.f, 0.f, 0.f}}; pq2(ARR(A_MAK), ARR(A_VQ), tt, hf, lane, z); st4(ARR(A_TA), t, cb0, z[0]); st4(ARR(A_TA), t, cb1, z[1]); }
    WG_BAR();
    { f32x4 z[2] = {{0.f, 0.f, 0.f, 0.f}, {0.f, 0.f, 0.f, 0.f}}; pq2(ARR(A_TB), ARR(A_TA), tt, hf, lane, z); st4(ARR(A_XB), t, cb0, z[0]); st4(ARR(A_XB), t, cb1, z[1]); }
    WG_BAR();
    { f32x4 z[2]; z[0] = ld4(ARR(A_RT), t, cb0); z[1] = ld4(ARR(A_RT), t, cb1); pq2(ARR(A_MRB), ARR(A_XA), tt, hf, lane, z);
      bf16* qe = WSB_(A, WS_QE) + ((size_t)unit * 64 + t) * 64; *(GAS u32x2*)(qe + cb0) = pk4(z[0]); *(GAS u32x2*)(qe + cb1) = pk4(z[1]); }
    { f32x4 z[2] = {{0.f, 0.f, 0.f, 0.f}, {0.f, 0.f, 0.f, 0.f}}; pq2(ARR(A_MRB), ARR(A_XB), tt, hf, lane, z); pq2(ARR(A_MRK), ARR(A_VQ), tt, hf, lane, z);
      float* ol = WSF_(A, WS_OL) + ((size_t)unit * 64 + t) * 64; *(GAS f32x4*)(ol + cb0) = z[0]; *(GAS f32x4*)(ol + cb1) = z[1]; }
    {
      f32x4 p[2] = {{0.f, 0.f, 0.f, 0.f}, {0.f, 0.f, 0.f, 0.f}}, s[2] = {{0.f, 0.f, 0.f, 0.f}, {0.f, 0.f, 0.f, 0.f}};
#pragma unroll
      for (int ks = 0; ks < 2; ++ks) { const bf16x8 bbh = frag_tr(ARR(A_BH), 32 * ks, 16 * tt, lane), bul = frag_tr(ARR(A_XB), 32 * ks, 16 * tt, lane), bvq = frag_tr(ARR(A_VQ), 32 * ks, 16 * tt, lane);
#pragma unroll
          for (int j = 0; j < 2; ++j) { const int mt = 2 * hf + j;
              p[j] = mfma16(frag_tr(ARR(A_XA), 32 * ks, 16 * mt, lane), bbh, p[j]);
              s[j] = mfma16(frag_tr(ARR(A_BH), 32 * ks, 16 * mt, lane), bul, s[j]);
              s[j] = mfma16(frag_tr(ARR(A_KH), 32 * ks, 16 * mt, lane), bvq, s[j]); } }
      const float gkp = gcl[16 * tt + i];
      unsigned char* rec = A.ws + WS_REC + (size_t)unit * 24576;
#pragma unroll
      for (int j = 0; j < 2; ++j) { const int mt = 2 * hf + j, cb = 16 * mt + 4 * g; const f32x4 gq = *(const LAS f32x4*)(gcl + cb);
#pragma unroll
          for (int r = 0; r < 4; ++r) { p[j][r] = gkp * (p[j][r] + ((cb + r) == (16 * tt + i) ? 1.0f : 0.f)); s[j][r] *= gq[r]; }
          *(GAS u32x2*)(rec + (((tt * 2 + (mt >> 1)) * 64 + g * 16 + i) * 16 + (mt & 1) * 8)) = pk4(p[j]);
          *(GAS f32x4*)(rec + 8192 + ((tt * 4 + mt) * 64 + g * 16 + i) * 16) = s[j]; } }
    WG_BAR();
#undef SQ_STAGE
#undef T_STAGE
#undef ARR
}

__device__ __forceinline__ void rwkv_carry(Frame& F, const Args& A, int bh) {
    const int lane = F.lane, w = F.wave, i = lane & 15, g = lane >> 4;
    LAS unsigned char* L = F.lds + RING_OFF;
    const unsigned char* REC = A.ws + WS_REC + (size_t)bh * 128 * 24576;
    bf16* S0B = WSB_(A, WS_S0B) + (size_t)bh * 128 * 4096;
    const int v = 16 * (w & 3) + i;
    f32x4 acc[4];
#pragma unroll
    for (int mt = 0; mt < 4; ++mt) acc[mt] = (f32x4){0.f, 0.f, 0.f, 0.f};
#define CARRY_ISSUE(cc) do { const unsigned char* src = REC + (size_t)(cc) * 24576 + (w - 4) * 6144 + lane * 16; LAS unsigned char* dst = L + ((cc) % 5) * 24576 + (w - 4) * 6144; \
        _Pragma("unroll") for (int k = 0; k < 6; ++k) __builtin_amdgcn_global_load_lds((const unsigned*)(src + k * 1024), (LAS unsigned*)(dst + k * 1024), 16, 0, 0); } while (0)
    if (w >= 4) { CARRY_ISSUE(0); CARRY_ISSUE(1); CARRY_ISSUE(2); CARRY_ISSUE(3); asm volatile("s_waitcnt vmcnt(18)" ::: "memory"); }
    __builtin_amdgcn_s_barrier(); asm volatile("" ::: "memory");
#pragma unroll 1
    for (int c = 0; c < 128; ++c) {
        if (w >= 4) {
            if (c + 4 < 128) { CARRY_ISSUE(c + 4); asm volatile("s_waitcnt vmcnt(18)" ::: "memory"); }
            else asm volatile("s_waitcnt vmcnt(0)" ::: "memory");
        } else {
            const LAS unsigned char* sb = L + (c % 5) * 24576;
            f32x4 sc[4]; bf16x8 pa[4][2];
#pragma unroll
            for (int mt = 0; mt < 4; ++mt) { sc[mt] = *(const LAS f32x4*)(sb + 8192 + ((w * 4 + mt) * 64 + lane) * 16);
#pragma unroll
                for (int ks = 0; ks < 2; ++ks) pa[mt][ks] = *(const LAS bf16x8*)(sb + ((mt * 2 + ks) * 64 + lane) * 16); }
            bf16* s0 = S0B + (size_t)c * 4096 + v * 64 + 4 * g;
            u32x2 pk[4];
#pragma unroll
            for (int mt = 0; mt < 4; ++mt) { pk[mt] = pk4(acc[mt]); *(GAS u32x2*)(s0 + 16 * mt) = pk[mt]; }
#pragma unroll
            for (int ks = 0; ks < 2; ++ks) { const v4u bw = {pk[2 * ks].x, pk[2 * ks].y, pk[2 * ks + 1].x, pk[2 * ks + 1].y}; const bf16x8 bf = __builtin_bit_cast(bf16x8, bw);
#pragma unroll
                for (int mt = 0; mt < 4; ++mt) sc[mt] = mfma16(pa[mt][ks], bf, sc[mt]); }
#pragma unroll
            for (int mt = 0; mt < 4; ++mt) acc[mt] = sc[mt];
            asm volatile("s_waitcnt lgkmcnt(0)" ::: "memory");
        }
        __builtin_amdgcn_s_barrier(); asm volatile("" ::: "memory");
    }
#undef CARRY_ISSUE
    if (w < 4) { float* so = A.out + O_WKVP + ((size_t)bh * 64 + v) * 64 + 4 * g;
#pragma unroll
        for (int mt = 0; mt < 4; ++mt) *(GAS f32x4*)(so + 16 * mt) = acc[mt]; }
}

__device__ __forceinline__ void rwkvC_unit(Frame& F, const Args& A, int unit) {
    const int lane = F.lane, tt = F.wave & 3, i = lane & 15, g = lane >> 4;
    const int bh = unit >> 7, c = unit & 127, b = bh >> 3, h = bh & 7;
    const int t = 16 * tt + i, m = b * SEQ + c * 64 + t;
    const bf16* QE = WSB_(A, WS_QE) + (size_t)unit * 4096; const bf16* S0 = WSB_(A, WS_S0B) + (size_t)unit * 4096; const float* OL = WSF_(A, WS_OL) + (size_t)unit * 4096;
    f32x4 acc[4];
#pragma unroll
    for (int mt = 0; mt < 4; ++mt) acc[mt] = *(const GAS f32x4*)(OL + t * 64 + 16 * mt + 4 * g);
#pragma unroll
    for (int ks = 0; ks < 2; ++ks) { const bf16x8 bq = *(const GAS bf16x8*)(QE + t * 64 + 32 * ks + 8 * g);
#pragma unroll
        for (int mt = 0; mt < 4; ++mt) acc[mt] = mfma16(*(const GAS bf16x8*)(S0 + (16 * mt + i) * 64 + 32 * ks + 8 * g), bq, acc[mt]); }
    float s = 0.f;
#pragma unroll
    for (int mt = 0; mt < 4; ++mt) s += (acc[mt][0] + acc[mt][1]) + (acc[mt][2] + acc[mt][3]);
    s += __shfl_xor(s, 16); s += __shfl_xor(s, 32);
    const float mean = s * (1.0f / 64.0f); float q = 0.f;
#pragma unroll
    for (int mt = 0; mt < 4; ++mt)
#pragma unroll
        for (int r = 0; r < 4; ++r) { const float d = acc[mt][r] - mean; q += d * d; }
    q += __shfl_xor(q, 16); q += __shfl_xor(q, 32);
    const float rstd = 1.0f / sqrtf(q * (1.0f / 64.0f) + GN_EPS);
    const float bon = WSF_(A, WS_BON)[(size_t)m * 8 + h];
#pragma unroll
    for (int mt = 0; mt < 4; ++mt) { const int hc = h * 64 + 16 * mt + 4 * g;
        const f32x4 gg = *(const GAS f32x4*)(LNX_G_(A) + hc), bb = *(const GAS f32x4*)(LNX_B_(A) + hc);
        const f32x4 vm = up4(*(const GAS u32x2*)(WSB_(A, WS_VMX) + (size_t)m * RW + hc)), zr = up4(*(const GAS u32x2*)(WSB_(A, WS_H) + (size_t)m * NH + C_ZR + hc));
        f32x4 y;
#pragma unroll
        for (int r = 0; r < 4; ++r) y[r] = ((acc[mt][r] - mean) * rstd * gg[r] + bb[r] + bon * vm[r]) * zr[r];
        *(GAS u32x2*)(WSB_(A, WS_YR) + (size_t)m * RW + hc) = pk4(y); }
}

constexpr int AT_K = 0, AT_V = 65536, AT_VROWS = 272;
constexpr int NATT_UNITS = 3 * 512;
__device__ __forceinline__ int at_off(int row, int e) { return row * 256 + ((((e) >> 3) ^ (row & 15)) << 4) + ((e) & 7) * 2; }
__device__ __forceinline__ void attnP_unit(Frame& F, const Args& A, int unit) {
    const int lane = F.lane, qt = F.wave, i = lane & 15, gq = lane >> 4, tid = F.tid;
    const int g = unit >> 9, r0 = unit & 511, sh = 2 * g, d = 1 << sh, nblk = 64 >> sh;
    const int n = r0 % nblk, x = r0 / nblk, rho = x & (d - 1), y = x >> sh, h = y & 3, b = y >> 2;
    LAS unsigned char* L = F.lds + RING_OFF;
    const bf16* H = WSB_(A, WS_H);
    const int hoff = g * 512 + h * 128;
    for (int idx = tid; idx < 256 * 16; idx += 512) {
        const int kl = idx >> 4, ch = idx & 15, pos = 128 * (n - 1) + kl;
        v4u kq = {0u, 0u, 0u, 0u}, vq = {0u, 0u, 0u, 0u};
        if (pos >= 0) { const bf16* rp = H + (size_t)(b * SEQ + rho + d * pos) * NH + hoff + ch * 8; kq = *(const GAS v4u*)(rp + C_AK); vq = *(const GAS v4u*)(rp + C_AV); }
        const int o = kl * 256 + ((ch ^ (kl & 15)) << 4);
        *(LAS v4u*)(L + AT_K + o) = kq; *(LAS v4u*)(L + AT_V + o) = vq;
    }
    if (tid < 256) { const int kl = 256 + (tid >> 4), ch = tid & 15; *(LAS v4u*)(L + AT_V + kl * 256 + ((ch ^ (kl & 15)) << 4)) = (v4u){0u, 0u, 0u, 0u}; }
    const int ql = 16 * qt + i;
    const size_t qrow = (size_t)(b * SEQ + rho + d * (128 * n + ql));
    bf16x8 qf[4];
#pragma unroll
    for (int ks = 0; ks < 4; ++ks) qf[ks] = *(const GAS bf16x8*)(H + qrow * NH + C_AQ + hoff + 32 * ks + 8 * gq);
    WG_BAR();
    f32x4 sc[9];
#pragma unroll
    for (int kk = 0; kk < 9; ++kk) { const int krow = 16 * (qt + kk) + i; f32x4 acc = {0.f, 0.f, 0.f, 0.f};
#pragma unroll
        for (int ks = 0; ks < 4; ++ks) acc = mfma16(*(const LAS bf16x8*)(L + AT_K + krow * 256 + (((4 * ks + gq) ^ (krow & 15)) << 4)), qf[ks], acc);
        sc[kk] = acc; }
    const float NEG = -__builtin_inff();
    const bool nofirst = n > 0;
#pragma unroll
    for (int r = 0; r < 4; ++r) { if (4 * gq + r < i) sc[0][r] = NEG; if (4 * gq + r > i) sc[8][r] = NEG; }
    if (!nofirst) {
#pragma unroll
        for (int kk = 0; kk < 9; ++kk) { if (16 * (qt + kk) < 128) sc[kk] = (f32x4){NEG, NEG, NEG, NEG}; }
    }
    float mx = -1e30f;
#pragma unroll
    for (int kk = 0; kk < 9; ++kk) mx = fmaxf(mx, fmaxf(fmaxf(sc[kk][0], sc[kk][1]), fmaxf(sc[kk][2], sc[kk][3])));
    mx = fmaxf(mx, __shfl_xor(mx, 16)); mx = fmaxf(mx, __shfl_xor(mx, 32));
    constexpr float C2 = ATT_SCALE * 1.4426950408889634f;
    float l = 0.f;
#pragma unroll
    for (int kk = 0; kk < 9; ++kk)
#pragma unroll
        for (int r = 0; r < 4; ++r) { const float p = __builtin_amdgcn_exp2f((sc[kk][r] - mx) * C2); sc[kk][r] = p; l += p; }
    l += __shfl_xor(l, 16); l += __shfl_xor(l, 32);
    f32x4 oa[8];
#pragma unroll
    for (int et = 0; et < 8; ++et) oa[et] = (f32x4){0.f, 0.f, 0.f, 0.f};
#pragma unroll
    for (int s = 0; s < 5; ++s) {
        const u32x2 plo = pk4(sc[2 * s]); const u32x2 phi = (2 * s + 1 < 9) ? pk4(sc[(2 * s + 1 < 9) ? 2 * s + 1 : 8]) : (u32x2){0u, 0u};
        const v4u pw = {plo.x, plo.y, phi.x, phi.y}; const bf16x8 pf = __builtin_bit_cast(bf16x8, pw);
        const int rlo = 16 * (qt + 2 * s) + 4 * gq + (i >> 2), rhi = rlo + 16;
#pragma unroll
        for (int et = 0; et < 8; ++et) { const int e = 16 * et + 4 * (i & 3);
            const s16x4 lo = __builtin_bit_cast(s16x4, __builtin_amdgcn_ds_read_tr16_b64_v4i16((LAS v4i16_t*)(L + AT_V + at_off(rlo, e))));
            const s16x4 hi = __builtin_bit_cast(s16x4, __builtin_amdgcn_ds_read_tr16_b64_v4i16((LAS v4i16_t*)(L + AT_V + at_off(rhi, e))));
            oa[et] = mfma16(__builtin_shufflevector(lo, hi, 0, 1, 2, 3, 4, 5, 6, 7), pf, oa[et]); }
    }
    const float il = 1.0f / l;
    bf16* ao = WSB_(A, WS_AO) + ((size_t)g * M + qrow) * RW + h * 128 + 4 * gq;
#pragma unroll
    for (int et = 0; et < 8; ++et) *(GAS u32x2*)(ao + 16 * et) = pk4(oa[et] * il);
    if (gq == 0) WSF_(A, WS_LSE)[((size_t)g * M + qrow) * 4 + h] = mx * ATT_SCALE + __logf(l);
    WG_BAR();
}
__device__ __forceinline__ float row_sum16(float x) { return row_scan(x); }
__device__ __forceinline__ void attnS_item(Frame& F, const Args& A, int b, int g, int t, int h) {
    const int lane = F.lane, i = lane & 15, gq = lane >> 4;
    const int sh = 2 * g, d = 1 << sh, Wb = 128 << sh;
    const float* cache = (g == 0 ? C1_(A) : (g == 1 ? C2_(A) : C3_(A))) + (size_t)b * Wb * 1024 + h * 128 + 8 * gq;
    const bf16* H = WSB_(A, WS_H);
    const int ms = MP + b * DSEQ;
    const int hoff = g * 512 + h * 128 + 8 * gq;
    float q[4][8];
#pragma unroll
    for (int ks = 0; ks < 4; ++ks) ld8bf(H + (size_t)(ms + t) * NH + C_AQ + hoff + 32 * ks, q[ks]);
    float sc[9];
#pragma unroll
    for (int x = 0; x < 9; ++x) sc[x] = -__builtin_inff();
#pragma unroll 1
    for (int tile = 0; tile < 8; tile += 2) {
        float pr[2];
#pragma unroll
        for (int u = 0; u < 2; ++u) {
            const int kk = 16 * (tile + u) + i, idx = (g == 0) ? kk : t + d * kk;
            const float* kr = cache + (size_t)idx * 1024;
            float part = 0.f;
#pragma unroll
            for (int ks = 0; ks < 4; ++ks) { const f32x4 k0 = *(const GAS f32x4*)(kr + 32 * ks), k1 = *(const GAS f32x4*)(kr + 32 * ks + 4);
                part += q[ks][0] * k0.x + q[ks][1] * k0.y + q[ks][2] * k0.z + q[ks][3] * k0.w + q[ks][4] * k1.x + q[ks][5] * k1.y + q[ks][6] * k1.z + q[ks][7] * k1.w; }
            part += __shfl_xor(part, 16); part += __shfl_xor(part, 32);
            const bool valid = (g == 0) ? (kk >= t) : true;
            pr[u] = valid ? part * ATT_SCALE : -__builtin_inff();
        }
#pragma unroll
        for (int x = 0; x < 8; x += 2) { if (tile == x) { sc[x] = pr[0]; sc[x + 1] = pr[1]; } }
    }
    {
        const int tn = (g == 0) ? (i & 3) : t; const bool valid = (g == 0) ? (i <= t && i < 4) : (i == 0);
        float part = 0.f;
#pragma unroll
        for (int ks = 0; ks < 4; ++ks) { float kv[8]; ld8bf(H + (size_t)(ms + tn) * NH + C_AK + hoff + 32 * ks, kv);
#pragma unroll
            for (int j = 0; j < 8; ++j) part += q[ks][j] * kv[j]; }
        part += __shfl_xor(part, 16); part += __shfl_xor(part, 32);
        sc[8] = valid ? part * ATT_SCALE : -__builtin_inff();
    }
    float mx = sc[0];
#pragma unroll
    for (int x = 1; x < 9; ++x) mx = fmaxf(mx, sc[x]);
    mx = fmaxf(mx, __shfl_xor(mx, 1)); mx = fmaxf(mx, __shfl_xor(mx, 2)); mx = fmaxf(mx, __shfl_xor(mx, 4)); mx = fmaxf(mx, __shfl_xor(mx, 8));
    float l = 0.f;
#pragma unroll
    for (int x = 0; x < 9; ++x) { sc[x] = __expf(sc[x] - mx); l += sc[x]; }
    float acc[4][8];
#pragma unroll
    for (int ks = 0; ks < 4; ++ks)
#pragma unroll
        for (int j = 0; j < 8; ++j) acc[ks][j] = 0.f;
#pragma unroll 1
    for (int tile = 0; tile < 8; tile += 2) {
        float pp[2] = {0.f, 0.f};
#pragma unroll
        for (int x = 0; x < 8; x += 2) { if (tile == x) { pp[0] = sc[x]; pp[1] = sc[x + 1]; } }
#pragma unroll
        for (int u = 0; u < 2; ++u) {
            const int kk = 16 * (tile + u) + i, idx = (g == 0) ? kk : t + d * kk;
            const float* vr = cache + (size_t)idx * 1024 + 512;
            const float p = pp[u];
#pragma unroll
            for (int ks = 0; ks < 4; ++ks) { const f32x4 v0 = *(const GAS f32x4*)(vr + 32 * ks), v1 = *(const GAS f32x4*)(vr + 32 * ks + 4);
                acc[ks][0] += p * v0.x; acc[ks][1] += p * v0.y; acc[ks][2] += p * v0.z; acc[ks][3] += p * v0.w; acc[ks][4] += p * v1.x; acc[ks][5] += p * v1.y; acc[ks][6] += p * v1.z; acc[ks][7] += p * v1.w; }
        }
    }
    {
        const int tn = (g == 0) ? (i & 3) : t; const float p = sc[8];
#pragma unroll
        for (int ks = 0; ks < 4; ++ks) { float vv[8]; ld8bf(H + (size_t)(ms + tn) * NH + C_AV + hoff + 32 * ks, vv);
#pragma unroll
            for (int j = 0; j < 8; ++j) acc[ks][j] += p * vv[j]; }
    }
    l = row_sum16(l);
#pragma unroll
    for (int ks = 0; ks < 4; ++ks)
#pragma unroll
        for (int j = 0; j < 8; ++j) acc[ks][j] = row_sum16(acc[ks][j]);
    if (i == 15) {
        const float il = 1.0f / l;
        bf16* ao = WSB_(A, WS_AO) + ((size_t)g * M + ms + t) * RW + h * 128 + 8 * gq;
#pragma unroll
        for (int ks = 0; ks < 4; ++ks) { v4u w; w.x = pk2(acc[ks][0] * il, acc[ks][1] * il); w.y = pk2(acc[ks][2] * il, acc[ks][3] * il); w.z = pk2(acc[ks][4] * il, acc[ks][5] * il); w.w = pk2(acc[ks][6] * il, acc[ks][7] * il);
            *(GAS v4u*)(ao + 32 * ks) = w; }
        if (gq == 0) WSF_(A, WS_LSE)[((size_t)g * M + ms + t) * 4 + h] = mx + __logf(l);
    }
}

__device__ __forceinline__ void attn_combine_row(Frame& F, const Args& A, int m) {
    const int lane = F.lane, c0 = lane * 8, h = lane >> 4;
    float o[3][8], ls[3];
#pragma unroll
    for (int g = 0; g < 3; ++g) { ld8bf(WSB_(A, WS_AO) + ((size_t)g * M + m) * RW + c0, o[g]); ls[g] = WSF_(A, WS_LSE)[((size_t)g * M + m) * 4 + h]; }
    const float ml = fmaxf(fmaxf(ls[0], ls[1]), ls[2]);
    const float w0 = __expf(ls[0] - ml), w1 = __expf(ls[1] - ml), w2 = __expf(ls[2] - ml), iw = 1.0f / (w0 + w1 + w2);
    float z[8]; ld8bf(WSB_(A, WS_H) + (size_t)m * NH + C_ZA + c0, z);
    float yv[8];
#pragma unroll
    for (int j = 0; j < 8; ++j) yv[j] = (w0 * o[0][j] + w1 * o[1][j] + w2 * o[2][j]) * iw * z[j];
    v4u w; w.x = pk2(yv[0], yv[1]); w.y = pk2(yv[2], yv[3]); w.z = pk2(yv[4], yv[5]); w.w = pk2(yv[6], yv[7]);
    *(GAS v4u*)(WSB_(A, WS_YA) + (size_t)m * RW + c0) = w;
}

__device__ __forceinline__ void ln_row(Frame& F, const Args& A, int m) {
    const GAS f32x4* xr = (const GAS f32x4*)(WSF_(A, WS_PRE) + (size_t)m * DM) + F.lane;
    f32x4 v[4]; float s = 0.f;
#pragma unroll
    for (int j = 0; j < 4; ++j) { v[j] = xr[64 * j]; s += (v[j].x + v[j].y) + (v[j].z + v[j].w); }
    const float mean = wave_sum(s) * (1.f / DM); float s2 = 0.f;
#pragma unroll
    for (int j = 0; j < 4; ++j) { v[j] = v[j] - mean; s2 += (v[j].x * v[j].x + v[j].y * v[j].y) + (v[j].z * v[j].z + v[j].w * v[j].w); }
    const float rstd = 1.f / sqrtf(wave_sum(s2) * (1.f / DM) + LN_EPS);
    GAS f32x4* o = (GAS f32x4*)(A.out + (size_t)m * DM) + F.lane;
#pragma unroll
    for (int j = 0; j < 4; ++j) { const f32x4 g = *((const GAS f32x4*)LN_G_(A) + F.lane + 64 * j), bta = *((const GAS f32x4*)LN_B_(A) + F.lane + 64 * j); o[64 * j] = v[j] * rstd * g + bta; }
}

__global__ void __launch_bounds__(NWAVES * 64, 2) mega_fwd(Args args) {
    extern __shared__ __attribute__((aligned(16))) unsigned char lds[];
    Frame F;
    F.lds = (LAS unsigned char*)lds;
    F.MISC = (volatile LAS unsigned*)(F.lds + MISC_OFF);
    F.tid = threadIdx.x; F.lane = F.tid & 63; F.wave = __builtin_amdgcn_readfirstlane(F.tid >> 6);
    F.G = gridDim.x;
    F.ctl = (gu32*)(args.ws + WS_CTL);
    for (int u = F.tid; u < (LDS_BYTES - LDSCTL_OFF) / 4; u += NWAVES * 64) ((LAS unsigned*)(F.lds + LDSCTL_OFF))[u] = 0u;
    __syncthreads();
    XcdBarrier bar; bar.bar = (unsigned*)(F.ctl + CW_BAR); bar.x = 0; bar.st = nullptr;
    if (N_LAUNCHES == 1) bar = xcd_barrier_post((unsigned*)(F.ctl + CW_BAR), F.MISC + 8);
#define GRID_BAR() do { if (N_LAUNCHES == 1) xcd_barrier(bar); } while (0)
    const int lo = args.ph_lo, hi = args.ph_hi;
#ifndef PH_MASK
#define PH_MASK 0xFFFF
#endif
#define IN(k) ((((PH_MASK) >> (k)) & 1) && lo <= (k) && (k) < hi)
#define BOTH(k) (IN(k) && IN((k) + 1))
    const int gw = blockIdx.x * NWAVES + F.wave, NGW = F.G * NWAVES;

    if (IN(0)) { p0_prologue(F, args); if (BOTH(0)) GRID_BAR(); }
    if (IN(1)) {
        pg8::Gemm g{WSB_(args, WS_XB), WSB_(args, WS_WIN), M, NH, DM}; pg8::StaticOrder S; S.init(M, NH, F.G, (int)blockIdx.x);
        pg8::EpiH E{WSB_(args, WS_H), B_GATE_(args), args.out};
        pg8::gemm_phase<pg8::EpiH, pg8::StaticOrder, PG8_ALIGN, PG8_SP2>(F.lds + RING_OFF, g, S, E);
        if (BOTH(1)) GRID_BAR();
    }
    if (IN(2)) {
        for (int m = MP + gw; m < M; m += NGW) rwkv_prep_row(F, args, m);
        for (int u = blockIdx.x; u < NUNITS; u += F.G) rwkvA_unit(F, args, u);
        if (BOTH(2)) GRID_BAR();
    }
    if (IN(3)) {
        if (blockIdx.x < 16) rwkv_carry(F, args, (int)blockIdx.x);
        for (int it = 16 + gw; it < 16 + DBATCH * 8; it += NGW) scan_item(F, args, it);
        {
            volatile LAS int* qslot = (volatile LAS int*)(F.lds + LDSCTL_OFF);
            for (;;) {
                if (F.tid == 0) qslot[0] = (int)__hip_atomic_fetch_add((unsigned*)(F.ctl + CW_Q), 1u, __ATOMIC_RELAXED, __HIP_MEMORY_SCOPE_AGENT);
                WG_BAR();
                const int u = qslot[0];
                WG_BAR();
                if (u >= NATT_UNITS + 768) break;
                const int u3 = u / 3, um = u - 3 * u3;
                if (um == 0) { const int tp = u3 & 1, bg = u3 >> 1, b = bg / 3, g = bg - 3 * b; attnS_item(F, args, b, g, 2 * tp + (F.wave >> 2), F.wave & 3); }
                else attnP_unit(F, args, 2 * u3 + um - 1);
            }
        }
        if (BOTH(3)) GRID_BAR();
    }
    if (IN(4)) {
        for (int u2 = blockIdx.x; u2 < NUNITS / 2; u2 += F.G) rwkvC_unit(F, args, 2 * u2 + (F.wave >> 2));
        for (int m = MP + gw; m < M; m += NGW) rwkv_post_row(F, args, m);
        for (int m = gw; m < M; m += NGW) attn_combine_row(F, args, m);
        if (BOTH(4)) GRID_BAR();
    }
    if (IN(5)) {
        pg8::Gemm g{WSB_(args, WS_YR), WSB_(args, WS_WOA), M, DM, RW}; pg8::StaticOrder S; S.init(M, DM, F.G, (int)blockIdx.x);
        pg8::EpiMixA E{WSB_(args, WS_H), WSF_(args, WS_MIXF)};
        pg8::gemm_phase<pg8::EpiMixA, pg8::StaticOrder, PG8_ALIGN, PG8_SP2>(F.lds + RING_OFF, g, S, E);
        if (BOTH(5)) GRID_BAR();
    }
    if (IN(6)) {
        pg8::Gemm g{WSB_(args, WS_YA), WSB_(args, WS_WOB), M, DM, RW}; pg8::StaticOrder S; S.init(M, DM, F.G, (int)blockIdx.x);
        pg8::EpiMixB E{WSB_(args, WS_H), WSF_(args, WS_MIXF), WSB_(args, WS_MIX)};
        pg8::gemm_phase<pg8::EpiMixB, pg8::StaticOrder, PG8_ALIGN, PG8_SP2>(F.lds + RING_OFF, g, S, E);
        if (BOTH(6)) GRID_BAR();
    }
    if (IN(7)) {
        pg8::Gemm g{WSB_(args, WS_MIX), WSB_(args, WS_WOUT), M, DM, DM}; pg8::StaticOrder S; S.init(M, DM, F.G, (int)blockIdx.x);
        pg8::EpiPre E{XP_(args), XS_(args), WSF_(args, WS_PRE)};
        pg8::gemm_phase<pg8::EpiPre, pg8::StaticOrder, PG8_ALIGN, PG8_SP2>(F.lds + RING_OFF, g, S, E);
        if (BOTH(7)) GRID_BAR();
    }
    if (IN(8)) {
        for (int m = gw; m < M; m += NGW) ln_row(F, args, m);
    }
#undef IN
#undef BOTH
}

extern "C" void kernel_launch(void* const* d_in, const int* in_sizes, int n_in, void* d_out, int out_size, void* d_ws, size_t ws_size, hipStream_t stream) {
    static int grid = 0;
    if (grid == 0) {
        if (n_in != 24 || in_sizes[0] != MP * DM || (size_t)out_size != O_END || ws_size < WS_END) { fprintf(stderr, "kernel_launch: unexpected shapes (n_in %d, in0 %d, out %d, ws %zu); nothing launched\n", n_in, n_in > 0 ? in_sizes[0] : -1, out_size, ws_size); grid = -1; return; }
        int dev = 0, cus = 0, per_cu = 0;
        if (hipGetDevice(&dev) != hipSuccess || hipDeviceGetAttribute(&cus, hipDeviceAttributeMultiprocessorCount, dev) != hipSuccess) { grid = -1; return; }
        if (hipFuncSetAttribute((const void*)mega_fwd, hipFuncAttributeMaxDynamicSharedMemorySize, LDS_BYTES) != hipSuccess) { fprintf(stderr, "kernel_launch: hipFuncSetAttribute failed\n"); grid = -1; return; }
        if (hipOccupancyMaxActiveBlocksPerMultiprocessor(&per_cu, (const void*)mega_fwd, NWAVES * 64, LDS_BYTES) != hipSuccess || per_cu < 1) fprintf(stderr, "kernel_launch: occupancy query reports %d\n", per_cu);
        (void)hipGetLastError();
        grid = cus;
    }
    if (grid < 0) return;
    if (hipMemsetAsync((char*)d_ws + WS_CTL, 0, CTL_ZERO_BYTES, stream) != hipSuccess) return;
    Args a{};
    for (int i = 0; i < 24; ++i) a.in[i] = (const float*)d_in[i];
    a.out = (float*)d_out; a.ws = (unsigned char*)d_ws;
    if (N_LAUNCHES == 1) { a.ph_lo = 0; a.ph_hi = N_PHASES; hipLaunchKernelGGL(mega_fwd, dim3(grid), dim3(NWAVES * 64), LDS_BYTES, stream, a); }
    else for (int li = 0; li < N_PHASES; ++li) { a.ph_lo = li; a.ph_hi = li + 1; hipLaunchKernelGGL(mega_fwd, dim3(grid), dim3(NWAVES * 64), LDS_BYTES, stream, a); }
}
```

```cpp
#include <hip/hip_runtime.h>
#include <cstdio>
#include <cstdint>
namespace pg8 {
#define PG8_LAS __attribute__((address_space(3)))
typedef unsigned short bf16_t;
typedef short bf16x8 __attribute__((ext_vector_type(8)));
typedef float f32x4 __attribute__((ext_vector_type(4)));
typedef unsigned u32x4 __attribute__((ext_vector_type(4)));
constexpr int BM = 256, BK = 64, HALF = 128, HTB = HALF * BK * 2  , STAGE_BYTES = 8 * HTB, NXCD = 8, WGM = 8;

__host__ __device__ __forceinline__ int lds_byte(int r, int c) { const int st = (r >> 4) * 2 + (c >> 5), rr = r & 15, cc = c & 31, ob = rr * 64 + cc * 2; return st * 1024 + (ob ^ (((ob >> 9) & 1) << 5)); }
__host__ __device__ __forceinline__ void stage_rc(int b, int& R, int& C) { const int st = b / 1024, sb = b % 1024, swz = sb ^ (((sb >> 9) & 1) << 5); R = (st >> 1) * 16 + swz / 64; C = (st & 1) * 32 + (swz % 64) / 2; }
__host__ __device__ __forceinline__ int perm32(int rho) { const int n = rho >> 4, i = rho & 15; return 8 * (i >> 2) + 4 * n + (i & 3); }

struct Unit { int pm, pn; };
struct Gemm { const bf16_t* A; const bf16_t* Bt; int M, N, K; };

struct StaticOrder {
    int nM, nN, nwg, G, c;
    __host__ __device__ void init(int M, int N, int G_, int c_) { nM = M / BM; nN = N / BM; nwg = nM * nN; G = G_; c = c_; }
    __host__ __device__ bool next(int i, Unit& u) const {
        const long L = (long)i * G + c; if (L >= nwg) return false;
        int wgid = (int)L; { const int q = nwg / NXCD, r = nwg % NXCD, xcd = wgid % NXCD, off = wgid / NXCD; wgid = (xcd < r ? xcd * (q + 1) : r * (q + 1) + (xcd - r) * q) + off; }
        const int nig = WGM * nN, gid = wgid / nig, fm = gid * WGM, gsz = (nM - fm) < WGM ? (nM - fm) : WGM;
        u.pm = fm + ((wgid % nig) % gsz); u.pn = (wgid % nig) / gsz; return true;
    }
    __device__ __forceinline__ void a_ready(const Unit&) const {}
    __device__ __forceinline__ void done(const Unit&) const {}
};

__device__ __forceinline__ unsigned cvt_pk_bf16(float lo, float hi) { unsigned r; asm volatile("v_cvt_pk_bf16_f32 %0, %1, %2" : "=v"(r) : "v"(lo), "v"(hi)); return r; }
typedef float f32x2 __attribute__((ext_vector_type(2)));
__device__ __forceinline__ f32x2 gelu_pk(f32x2 v) {
    const f32x2 av = __builtin_elementwise_abs(v), d = av * 0.2316418882f + 1.0f;
    f32x2 t; t.x = __builtin_amdgcn_rcpf(d.x); t.y = __builtin_amdgcn_rcpf(d.y);
    f32x2 q = t * 0.5307027145f + (-0.7265760135f); q = q * t + 0.7107068705f; q = q * t + (-0.142248368f); q = q * t + 0.127414796f; q = q * t;
    const f32x2 s = (v * v) * (-0.72134752044f);
    f32x2 e; e.x = __builtin_amdgcn_exp2f(s.x); e.y = __builtin_amdgcn_exp2f(s.y);
    const f32x2 m = v * (q * e), r = v - m;
    f32x2 o; o.x = v.x < 0.f ? m.x : r.x; o.y = v.y < 0.f ? m.y : r.y; return o;
}

template <int ACT  > struct EpiBf16 {
    static constexpr bool PERM = true, AFTER_DRAIN = false; static_assert(ACT == 0 || ACT == 1, "EpiBf16: ACT is 0 (none) or 1 (gelu_pk)");
    bf16_t* O; int ldc; const float* bias; int split_cols; size_t split_stride; float scale0;
    __device__ __forceinline__ void operator()(const f32x4 (&acc)[2][2][4][2], const Unit& u, int wr, int wc, int fr, int fq) const {
        const int row0 = u.pm * BM + wr * 64 + fr; int colt = u.pn * BM; bf16_t* base = O;
        float sc = 1.f; if (split_cols) { const int t = colt / split_cols; base += (size_t)t * split_stride; colt -= t * split_cols; if (t == 0) sc = scale0; }
        const int col0 = colt + wc * 32 + 8 * fq, bcol0 = u.pn * BM + wc * 32 + 8 * fq;
        f32x4 bv[2][2];
#pragma unroll
        for (int bj = 0; bj < 2; ++bj)
#pragma unroll
            for (int n = 0; n < 2; ++n) bv[bj][n] = bias ? *(const f32x4*)(bias + bcol0 + bj * HALF + 4 * n) : (f32x4){0.f, 0.f, 0.f, 0.f};
#pragma unroll
        for (int ai = 0; ai < 2; ++ai)
#pragma unroll
            for (int m = 0; m < 4; ++m) { bf16_t* rowp = base + (size_t)(row0 + ai * HALF + m * 16) * ldc + col0;
#pragma unroll
                for (int bj = 0; bj < 2; ++bj) { f32x4 v0 = acc[ai][bj][m][0] + bv[bj][0], v1 = acc[ai][bj][m][1] + bv[bj][1];
                    if (ACT == 1) { f32x2 a = gelu_pk((f32x2){v0[0], v0[1]}), b = gelu_pk((f32x2){v0[2], v0[3]}), c = gelu_pk((f32x2){v1[0], v1[1]}), d = gelu_pk((f32x2){v1[2], v1[3]});
                        v0 = (f32x4){a.x, a.y, b.x, b.y}; v1 = (f32x4){c.x, c.y, d.x, d.y}; }
                    v0 = v0 * sc; v1 = v1 * sc; u32x4 w; w.x = cvt_pk_bf16(v0[0], v0[1]); w.y = cvt_pk_bf16(v0[2], v0[3]); w.z = cvt_pk_bf16(v1[0], v1[1]); w.w = cvt_pk_bf16(v1[2], v1[3]);
                    *(u32x4*)(rowp + bj * HALF) = w; } }
    }
};

struct PanelStats {
    unsigned* xbuf;
    unsigned* cnt;
    unsigned* tmo;
    int ntn; float eps;
    unsigned code;
    __device__ __forceinline__ bool run(const f32x4 (&v)[2][2][4][2], const Unit& u, int wr, int wc, int fr, int fq, PG8_LAS unsigned char* lds, int wid, int lane) const {
        typedef float f32x2v __attribute__((ext_vector_type(2)));
        PG8_LAS f32x2v* P = (PG8_LAS f32x2v*)lds;
        PG8_LAS f32x2v* S = (PG8_LAS f32x2v*)(lds + 8192);
        PG8_LAS unsigned* flag = (PG8_LAS unsigned*)(lds + 8192 + 2048);
#pragma unroll
        for (int ai = 0; ai < 2; ++ai)
#pragma unroll
            for (int m = 0; m < 4; ++m) {
                float s = 0.f;
#pragma unroll
                for (int bj = 0; bj < 2; ++bj)
#pragma unroll
                    for (int n = 0; n < 2; ++n) { const f32x4 x = v[ai][bj][m][n]; s += (x[0] + x[1]) + (x[2] + x[3]); }
                s += __shfl_xor(s, 16); s += __shfl_xor(s, 32);
                const float mw = s * (1.0f / 64.0f); float q = 0.f;
#pragma unroll
                for (int bj = 0; bj < 2; ++bj)
#pragma unroll
                    for (int n = 0; n < 2; ++n) { const f32x4 d = v[ai][bj][m][n] - mw; q += (d[0] * d[0] + d[1] * d[1]) + (d[2] * d[2] + d[3] * d[3]); }
                q += __shfl_xor(q, 16); q += __shfl_xor(q, 32);
                if (fq == 0) P[(ai * HALF + wr * 64 + m * 16 + fr) * 4 + wc] = (f32x2v){mw, q};
            }
        asm volatile("s_waitcnt lgkmcnt(0)" ::: "memory"); __builtin_amdgcn_s_barrier(); asm volatile("" ::: "memory");
#if defined(BROKEN_EXCHANGE_NO_WAIT)
#warning BROKEN CONTROL BUILD: the row-statistics exchange does not wait; results are wrong by design
        if (blockIdx.x >= 64) { const long long t0_ = clock64(); while (clock64() - t0_ < 60000) __builtin_amdgcn_s_sleep(8); }
#endif
        const int row = wid * 32 + (lane & 31);
        if (lane < 32) {
            const f32x2v a = P[row * 4 + 0], b = P[row * 4 + 1], c = P[row * 4 + 2], d = P[row * 4 + 3];
            const float mt = (a.x + b.x + c.x + d.x) * 0.25f;
            const float da = a.x - mt, db = b.x - mt, dc = c.x - mt, dd = d.x - mt;
            const float m2 = (a.y + b.y) + (c.y + d.y) + 64.0f * ((da * da + db * db) + (dc * dc + dd * dd));
            unsigned long long* slot = (unsigned long long*)xbuf + ((size_t)(u.pm * BM + row) * 4 + u.pn);
            __hip_atomic_store(slot, ((unsigned long long)__float_as_uint(m2) << 32) | __float_as_uint(mt), __ATOMIC_RELAXED, __HIP_MEMORY_SCOPE_AGENT);
        }
        asm volatile("s_waitcnt vmcnt(0)" ::: "memory");
        if (lane == 0) __hip_atomic_fetch_add(cnt + 64 * u.pm, 1u, __ATOMIC_RELAXED, __HIP_MEMORY_SCOPE_AGENT);
        if (wid == 0) {
            bool dead = false; const unsigned long long t0 = __builtin_amdgcn_s_memrealtime(); const unsigned want = 8u * (unsigned)ntn;
            for (;;) {
#if defined(BROKEN_EXCHANGE_NO_WAIT)
                break;
#endif
                if ((unsigned)__builtin_amdgcn_readfirstlane(__hip_atomic_load(cnt + 64 * u.pm, __ATOMIC_RELAXED, __HIP_MEMORY_SCOPE_AGENT)) >= want) break;
                if (__builtin_amdgcn_s_memrealtime() - t0 > 2000000ull) {
                    if (lane == 0) { unsigned expect = 0u; __hip_atomic_compare_exchange_strong(tmo + 1, &expect, code | (unsigned)(u.pm & 0xff), __ATOMIC_RELAXED, __ATOMIC_RELAXED, __HIP_MEMORY_SCOPE_AGENT);
                                     __hip_atomic_store(tmo, 1u, __ATOMIC_RELAXED, __HIP_MEMORY_SCOPE_AGENT); }
                    dead = true; break; }
                __builtin_amdgcn_s_sleep(2);
            }
            __builtin_amdgcn_fence(__ATOMIC_ACQUIRE, "agent");
            if (lane == 0) flag[0] = dead ? 1u : 0u;
        }
        asm volatile("s_waitcnt vmcnt(0) lgkmcnt(0)" ::: "memory"); __builtin_amdgcn_s_barrier(); asm volatile("" ::: "memory");
        const bool bad = flag[0] != 0u;
        if (lane < 32) {
            const unsigned long long* slot = (const unsigned long long*)xbuf + (size_t)(u.pm * BM + row) * 4; float mt[4], m2[4]; float ms = 0.f;
#pragma unroll
            for (int t = 0; t < 4; ++t) { if (t < ntn) { const unsigned long long w = __hip_atomic_load(slot + t, __ATOMIC_RELAXED, __HIP_MEMORY_SCOPE_AGENT); mt[t] = __uint_as_float((unsigned)w); m2[t] = __uint_as_float((unsigned)(w >> 32)); } else { mt[t] = 0.f; m2[t] = 0.f; } ms += mt[t]; }
            const float mean = ms / (float)ntn; float q = 0.f;
#pragma unroll
            for (int t = 0; t < 4; ++t) if (t < ntn) { const float dm = mt[t] - mean; q += m2[t] + 256.0f * dm * dm; }
            S[row] = (f32x2v){mean, 1.0f / sqrtf(q / (256.0f * (float)ntn) + eps)};
        }
        asm volatile("s_waitcnt lgkmcnt(0)" ::: "memory"); __builtin_amdgcn_s_barrier(); asm volatile("" ::: "memory");
        return bad;
    }
};
struct EpiLnRes {
    static constexpr bool PERM = false, AFTER_DRAIN = true;
    const float* base; float* out; int ldc; const float* bias; PanelStats st; unsigned poison;
    __device__ __forceinline__ void fused(f32x4 (&acc)[2][2][4][2], const Unit& u, int wr, int wc, int fr, int fq, PG8_LAS unsigned char* lds, int wid, int lane) const {
        typedef float f32x2v __attribute__((ext_vector_type(2)));
        const PG8_LAS f32x2v* S = (const PG8_LAS f32x2v*)(lds + 8192);
        const int col0 = u.pn * BM + wc * 32 + 4 * fq;
#pragma unroll
        for (int bj = 0; bj < 2; ++bj)
#pragma unroll
            for (int n = 0; n < 2; ++n) { const f32x4 bv = bias ? *(const f32x4*)(bias + col0 + bj * HALF + n * 16) : (f32x4){0.f, 0.f, 0.f, 0.f};
#pragma unroll
                for (int ai = 0; ai < 2; ++ai)
#pragma unroll
                    for (int m = 0; m < 4; ++m) acc[ai][bj][m][n] += bv; }
        f32x4 pre[4][2][2];
#pragma unroll
        for (int m = 0; m < 4; ++m) { const size_t off = (size_t)(u.pm * BM + wr * 64 + m * 16 + fr) * ldc + col0;
#pragma unroll
            for (int bj = 0; bj < 2; ++bj)
#pragma unroll
                for (int n = 0; n < 2; ++n) pre[m][bj][n] = *(const f32x4*)(base + off + bj * HALF + n * 16); }
        const bool bad = st.run(acc, u, wr, wc, fr, fq, lds, wid, lane) || poison != 0u;
        const float qnan = __builtin_nanf("");
#pragma unroll
        for (int ai = 0; ai < 2; ++ai)
#pragma unroll
            for (int m = 0; m < 4; ++m) { const int r = ai * HALF + wr * 64 + m * 16 + fr; const f32x2v sr = S[r]; const size_t off = (size_t)(u.pm * BM + r) * ldc + col0;
#pragma unroll
                for (int bj = 0; bj < 2; ++bj)
#pragma unroll
                    for (int n = 0; n < 2; ++n) { const f32x4 bs = ai == 0 ? pre[m][bj][n] : *(const f32x4*)(base + off + bj * HALF + n * 16); f32x4 o = bs + (acc[ai][bj][m][n] - sr.x) * sr.y;
                        if (bad) o = (f32x4){qnan, qnan, qnan, qnan}; *(f32x4*)(out + off + bj * HALF + n * 16) = o; }
                if (m & 1) asm volatile("" ::: "memory"); }
    }
};
struct EpiLnResLn {
    static constexpr bool PERM = false, AFTER_DRAIN = true;
    const float* base; float* out; bf16_t* xn; int ldc; const float* bias; PanelStats st1, st2; unsigned poison;
    __device__ __forceinline__ void fused(f32x4 (&acc)[2][2][4][2], const Unit& u, int wr, int wc, int fr, int fq, PG8_LAS unsigned char* lds, int wid, int lane) const {
        typedef float f32x2v __attribute__((ext_vector_type(2))); typedef unsigned u32x2v __attribute__((ext_vector_type(2)));
        const PG8_LAS f32x2v* S = (const PG8_LAS f32x2v*)(lds + 8192);
        const int col0 = u.pn * BM + wc * 32 + 4 * fq;
#pragma unroll
        for (int bj = 0; bj < 2; ++bj)
#pragma unroll
            for (int n = 0; n < 2; ++n) { const f32x4 bv = bias ? *(const f32x4*)(bias + col0 + bj * HALF + n * 16) : (f32x4){0.f, 0.f, 0.f, 0.f};
#pragma unroll
                for (int ai = 0; ai < 2; ++ai)
#pragma unroll
                    for (int m = 0; m < 4; ++m) acc[ai][bj][m][n] += bv; }
        bool bad = st1.run(acc, u, wr, wc, fr, fq, lds, wid, lane) || poison != 0u;
        const float qnan = __builtin_nanf("");
#pragma unroll
        for (int ai = 0; ai < 2; ++ai)
#pragma unroll
            for (int m = 0; m < 4; ++m) { const int r = ai * HALF + wr * 64 + m * 16 + fr; const f32x2v sr = S[r]; const size_t off = (size_t)(u.pm * BM + r) * ldc + col0;
#pragma unroll
                for (int bj = 0; bj < 2; ++bj)
#pragma unroll
                    for (int n = 0; n < 2; ++n) { const f32x4 bs = *(const f32x4*)(base + off + bj * HALF + n * 16); acc[ai][bj][m][n] = bs + (acc[ai][bj][m][n] - sr.x) * sr.y; }
                asm volatile("" : "+v"(acc[ai][0][m][0]), "+v"(acc[ai][0][m][1]), "+v"(acc[ai][1][m][0]), "+v"(acc[ai][1][m][1]));
                if (m & 1) asm volatile("" ::: "memory"); }
        const bool bad1 = bad;
        bad = st2.run(acc, u, wr, wc, fr, fq, lds, wid, lane) || bad;
#pragma unroll
        for (int ai = 0; ai < 2; ++ai)
#pragma unroll
            for (int m = 0; m < 4; ++m) { const int r = ai * HALF + wr * 64 + m * 16 + fr; const f32x2v sr = S[r]; const size_t off = (size_t)(u.pm * BM + r) * ldc + col0;
#pragma unroll
                for (int bj = 0; bj < 2; ++bj)
#pragma unroll
                    for (int n = 0; n < 2; ++n) { const f32x4 x1 = acc[ai][bj][m][n]; *(f32x4*)(out + off + bj * HALF + n * 16) = bad1 ? (f32x4){qnan, qnan, qnan, qnan} : x1;
                        const f32x4 o = (x1 - sr.x) * sr.y; u32x2v w; w.x = cvt_pk_bf16(o[0], o[1]); w.y = cvt_pk_bf16(o[2], o[3]);
                        if (bad) { w.x = 0x7fc07fc0u; w.y = 0x7fc07fc0u; } *(u32x2v*)(xn + off + bj * HALF + n * 16) = w; }
                asm volatile("" ::: "memory"); }
    }
};

template <class Epi, class Sched, bool ALIGN_EPI = false, bool SP2 = false>
__device__ __forceinline__ void gemm_phase(PG8_LAS unsigned char* lds, const Gemm g, const Sched& S, const Epi& E) {
    const int tid = threadIdx.x, wid = __builtin_amdgcn_readfirstlane(tid >> 6), lane = tid & 63, wr = wid >> 2, wc = wid & 3, fr = lane & 15, fq = lane >> 4;
    const int K = g.K, nt = K / BK;
    unsigned voffA[2], voffB[2];
#pragma unroll
    for (int i = 0; i < 2; ++i) { int R, C; stage_rc(tid * 16 + i * 8192, R, C); const int Rb = Epi::PERM ? ((R & ~31) + perm32(R & 31)) : R;
        voffA[i] = (unsigned)(R * K + C) * 2u; voffB[i] = (unsigned)(Rb * K + C) * 2u; }
    const size_t kstep = (size_t)(BK * 2);
    const size_t hstep = (size_t)HALF * K * 2;
    const size_t tstep = 2 * hstep;
    const unsigned ldsw = (unsigned)wid * 1024u;
    const int aoff = lds_byte(wr * 64 + fr, fq * 8), boff = lds_byte(wc * 32 + fr, fq * 8);
#define PG8_SA(b, h) (((b) * 2 + (h)) * HTB)
#define PG8_SB(b, h) ((4 + (b) * 2 + (h)) * HTB)
#define PG8_STAGE(bufoff, gbase, voff) do { _Pragma("unroll") for (int _i = 0; _i < 2; ++_i) \
        __builtin_amdgcn_global_load_lds((const unsigned*)((const char*)(gbase) + (voff)[_i]), (PG8_LAS unsigned*)(lds + (bufoff) + ldsw + _i * 8192), 16, 0, 0); } while (0)
#define PG8_LDA(dst, b, h) do { _Pragma("unroll") for (int m = 0; m < 4; ++m) _Pragma("unroll") for (int k = 0; k < 2; ++k) dst[m][k] = *(const PG8_LAS bf16x8*)(lds + PG8_SA(b, h) + aoff + m * 2048 + k * 1024); } while (0)
#define PG8_LDB(dst, b, h) do { _Pragma("unroll") for (int n = 0; n < 2; ++n) _Pragma("unroll") for (int k = 0; k < 2; ++k) dst[n][k] = *(const PG8_LAS bf16x8*)(lds + PG8_SB(b, h) + boff + n * 2048 + k * 1024); } while (0)
#define PG8_MMA(ai, bj, At, Bt) do { __builtin_amdgcn_s_setprio(1); _Pragma("unroll") for (int m = 0; m < 4; ++m) _Pragma("unroll") for (int n = 0; n < 2; ++n) _Pragma("unroll") for (int k = 0; k < 2; ++k) \
        acc[ai][bj][m][n] = __builtin_amdgcn_mfma_f32_16x16x32_bf16(Bt[n][k], At[m][k], acc[ai][bj][m][n], 0, 0, 0); __builtin_amdgcn_s_setprio(0); } while (0)
#define PG8_WAIT_V(n) asm volatile("s_waitcnt vmcnt(" #n ")" ::: "memory")
#define PG8_WAIT_L(n) asm volatile("s_waitcnt lgkmcnt(" #n ")" ::: "memory")
#define PG8_BAR __builtin_amdgcn_s_barrier()
#define PG8_SCHED __builtin_amdgcn_sched_barrier(0)
    Unit cur, nxt; int ui = 0;
    if (!S.next(0, cur)) return;
    f32x4 acc[2][2][4][2];
#pragma unroll
    for (int a = 0; a < 2; ++a)
#pragma unroll
        for (int b = 0; b < 2; ++b)
#pragma unroll
            for (int m = 0; m < 4; ++m)
#pragma unroll
                for (int n = 0; n < 2; ++n) acc[a][b][m][n] = (f32x4){0.f, 0.f, 0.f, 0.f};
    bf16x8 At[4][2], B0[2][2], B1[2][2];
    const char* cA = (const char*)g.A + (size_t)cur.pm * tstep; const char* cB = (const char*)g.Bt + (size_t)cur.pn * tstep;
    S.a_ready(cur);
    if constexpr (SP2) {
        PG8_STAGE(PG8_SB(0, 0), cB, voffB); PG8_STAGE(PG8_SB(0, 1), cB + hstep, voffB); PG8_STAGE(PG8_SA(0, 0), cA, voffA); PG8_STAGE(PG8_SA(0, 1), cA + hstep, voffA);
        if (wr == 1) PG8_BAR;
        PG8_WAIT_V(2); PG8_BAR;
        PG8_STAGE(PG8_SB(1, 0), cB + kstep, voffB); PG8_STAGE(PG8_SA(1, 0), cA + kstep, voffA); PG8_STAGE(PG8_SB(1, 1), cB + hstep + kstep, voffB);
        PG8_WAIT_V(6); PG8_BAR;
    } else {
        PG8_STAGE(PG8_SB(0, 0), cB, voffB); PG8_STAGE(PG8_SA(0, 0), cA, voffA); PG8_STAGE(PG8_SB(0, 1), cB + hstep, voffB); PG8_STAGE(PG8_SA(0, 1), cA + hstep, voffA);
        if (wr == 1) PG8_BAR;
        PG8_WAIT_V(4); PG8_BAR;
        PG8_STAGE(PG8_SB(1, 0), cB + kstep, voffB); PG8_STAGE(PG8_SA(1, 0), cA + kstep, voffA); PG8_STAGE(PG8_SB(1, 1), cB + hstep + kstep, voffB);
        PG8_WAIT_V(6); PG8_BAR;
    }
    for (;;) {
        const bool has_next = S.next(ui + 1, nxt);
        const char* nA = has_next ? (const char*)g.A + (size_t)nxt.pm * tstep : cA; const char* nB = has_next ? (const char*)g.Bt + (size_t)nxt.pn * tstep : cB;
        for (int t = 0; t < nt; t += 2) {
            const bool last = (t == nt - 2);
            const char* a1 = cA + (size_t)(t + 1) * kstep;
            const char* a2 = last ? nA : cA + (size_t)(t + 2) * kstep; const char* b2 = last ? nB : cB + (size_t)(t + 2) * kstep;
            const char* a3 = a2 + kstep; const char* b3 = b2 + kstep;
            if (last && has_next) S.a_ready(nxt);
            if constexpr (SP2) {
            PG8_LDB(B0, 0, 0); PG8_LDB(B1, 0, 1); PG8_SCHED; PG8_LDA(At, 0, 0); PG8_STAGE(PG8_SA(1, 1), a1 + hstep, voffA);
            PG8_WAIT_V(8); PG8_WAIT_L(0); PG8_BAR; PG8_MMA(0, 0, At, B0); PG8_MMA(0, 1, At, B1); PG8_BAR; PG8_SCHED;
            PG8_LDA(At, 0, 1); PG8_STAGE(PG8_SB(0, 0), b2, voffB); PG8_STAGE(PG8_SB(0, 1), b2 + hstep, voffB); PG8_STAGE(PG8_SA(0, 0), a2, voffA);
            PG8_WAIT_V(8); PG8_WAIT_L(0); PG8_BAR; PG8_MMA(1, 0, At, B0); PG8_MMA(1, 1, At, B1); PG8_BAR; PG8_SCHED;
            PG8_LDB(B0, 1, 0); PG8_LDB(B1, 1, 1); PG8_SCHED; PG8_LDA(At, 1, 0); PG8_STAGE(PG8_SA(0, 1), a2 + hstep, voffA);
            PG8_WAIT_V(8); PG8_WAIT_L(0); PG8_BAR; PG8_MMA(0, 0, At, B0); PG8_MMA(0, 1, At, B1); PG8_BAR; PG8_SCHED;
            PG8_LDA(At, 1, 1); PG8_STAGE(PG8_SB(1, 0), b3, voffB); PG8_STAGE(PG8_SB(1, 1), b3 + hstep, voffB); PG8_STAGE(PG8_SA(1, 0), a3, voffA);
            PG8_WAIT_V(8); PG8_WAIT_L(0); PG8_BAR; PG8_MMA(1, 0, At, B0); PG8_MMA(1, 1, At, B1); PG8_BAR; PG8_SCHED;
            } else {
            PG8_LDB(B0, 0, 0); PG8_SCHED; PG8_LDA(At, 0, 0); PG8_STAGE(PG8_SA(1, 1), a1 + hstep, voffA);
            PG8_WAIT_L(8); PG8_BAR; PG8_WAIT_L(0); PG8_MMA(0, 0, At, B0); PG8_BAR; PG8_SCHED;
            PG8_LDB(B1, 0, 1); PG8_STAGE(PG8_SB(0, 0), b2, voffB);
            PG8_BAR; PG8_WAIT_L(0); PG8_MMA(0, 1, At, B1); PG8_BAR;
            PG8_LDA(At, 0, 1); PG8_STAGE(PG8_SA(0, 0), a2, voffA);
            PG8_BAR; PG8_WAIT_L(0); PG8_MMA(1, 0, At, B0); PG8_BAR; PG8_SCHED;
            PG8_STAGE(PG8_SB(0, 1), b2 + hstep, voffB);
            PG8_WAIT_V(6); PG8_BAR; PG8_MMA(1, 1, At, B1); PG8_BAR;
            PG8_LDB(B0, 1, 0); PG8_SCHED; PG8_LDA(At, 1, 0); PG8_STAGE(PG8_SA(0, 1), a2 + hstep, voffA);
            PG8_WAIT_L(8); PG8_BAR; PG8_WAIT_L(0); PG8_MMA(0, 0, At, B0); PG8_BAR; PG8_SCHED;
            PG8_LDB(B1, 1, 1); PG8_STAGE(PG8_SB(1, 0), b3, voffB);
            PG8_BAR; PG8_WAIT_L(0); PG8_MMA(0, 1, At, B1); PG8_BAR;
            PG8_LDA(At, 1, 1); PG8_STAGE(PG8_SA(1, 0), a3, voffA);
            PG8_BAR; PG8_WAIT_L(0); PG8_MMA(1, 0, At, B0); PG8_BAR; PG8_SCHED;
            PG8_STAGE(PG8_SB(1, 1), b3 + hstep, voffB);
            PG8_WAIT_V(6); PG8_BAR; PG8_MMA(1, 1, At, B1); PG8_BAR;
            }
        }
        if constexpr (ALIGN_EPI) { if (wr == 0) PG8_BAR; }
        if constexpr (!Epi::AFTER_DRAIN) { E(acc, cur, wr, wc, fr, fq); S.done(cur); }
        if (!has_next) break;
#pragma unroll
        for (int a = 0; a < 2; ++a)
#pragma unroll
            for (int b = 0; b < 2; ++b)
#pragma unroll
                for (int m = 0; m < 4; ++m)
#pragma unroll
                    for (int n = 0; n < 2; ++n) acc[a][b][m][n] = (f32x4){0.f, 0.f, 0.f, 0.f};
        cur = nxt; cA = nA; cB = nB; ++ui;
        if constexpr (ALIGN_EPI) { if (wr == 1) PG8_BAR; }
    }
    PG8_WAIT_V(0);
    if constexpr (!ALIGN_EPI) { if (wr == 0) PG8_BAR; }
    PG8_BAR;
    if constexpr (Epi::AFTER_DRAIN) { E.fused(acc, cur, wr, wc, fr, fq, lds, wid, lane); S.done(cur); }
#undef PG8_SA
#undef PG8_SB
#undef PG8_STAGE
#undef PG8_LDA
#undef PG8_LDB
#undef PG8_MMA
#undef PG8_WAIT_V
#undef PG8_WAIT_L
#undef PG8_BAR
#undef PG8_SCHED
}
}
#ifndef PG8_SP2
#define PG8_SP2 true
#endif
#ifndef PG8_ALIGN
#define PG8_ALIGN true
#endif
constexpr int NWAVES = 8;
#ifndef MK_N_LAUNCHES
#define MK_N_LAUNCHES 1
#endif
constexpr int N_PHASES = 9;
constexpr int N_LAUNCHES = MK_N_LAUNCHES;

constexpr int DM = 1024, SEQ = 8192, NBATCH = 2, MP = NBATCH * SEQ, DBATCH = 128, DSEQ = 4, MS = DBATCH * DSEQ, M = MP + MS;
constexpr int NIN = 9344, NH = 9472;
constexpr int RW = 512, SHIFTC = 1664;
constexpr int C_R = 0, C_K = 512, C_V = 1024, C_WD = 1536, C_AD = 1600, C_ZR = 1792, C_AQ = 2304, C_AK = 3840, C_AV = 5376, C_ZA = 6912, C_GR = 7424, C_GA = 8448;
constexpr float LN_EPS = 1e-5f, GN_EPS = 64e-5f;
constexpr float ALPHA = 1.189207115002721f;
constexpr float ATT_SCALE = 0.08838834764831845f;
constexpr size_t O_YP = 0, O_YS = O_YP + (size_t)MP * DM, O_KV1P = O_YS + (size_t)MS * DM, O_KV1S = O_KV1P + (size_t)2 * 128 * 1024, O_KV2P = O_KV1S + (size_t)MS * 1024,
                 O_KV2S = O_KV2P + (size_t)2 * 512 * 1024, O_KV3P = O_KV2S + (size_t)MS * 1024, O_KV3S = O_KV3P + (size_t)2 * 2048 * 1024, O_WKVP = O_KV3S + (size_t)MS * 1024,
                 O_WKVS = O_WKVP + (size_t)2 * 8 * 64 * 64, O_SHP = O_WKVS + (size_t)128 * 8 * 64 * 64, O_SHS = O_SHP + (size_t)2 * SHIFTC, O_END = O_SHS + (size_t)128 * SHIFTC;
static_assert(O_END == 28855552, "d_out size");

constexpr size_t MiB = 1u << 20;
constexpr size_t WS_CTL = 0, CTL_ZERO_BYTES = 1 * MiB;
constexpr size_t WS_WIN = 2 * MiB, WS_WOA = 22 * MiB, WS_WOB = 23 * MiB, WS_WOUT = 24 * MiB;
constexpr size_t WS_XB = 32 * MiB, WS_H = 96 * MiB, WS_YR = 416 * MiB, WS_YA = 448 * MiB, WS_MIX = 480 * MiB, WS_MIXF = 528 * MiB, WS_PRE = 608 * MiB;
constexpr size_t WS_RR = 704 * MiB, WS_DEC = 744 * MiB, WS_K2 = 784 * MiB, WS_VV = 824 * MiB, WS_KK = 864 * MiB, WS_KA = 904 * MiB, WS_OO = 944 * MiB;
constexpr size_t WS_W2T = 26 * MiB, WS_A2T = 27 * MiB;
constexpr size_t WS_QE = 984 * MiB, WS_PT = 1000 * MiB, WS_S0B = 1016 * MiB, WS_OL = 1032 * MiB, WS_SL = 1064 * MiB, WS_VMX = 1096 * MiB, WS_BON = 1112 * MiB, WS_AO = 1120 * MiB  , WS_LSE = 1172 * MiB  , WS_REC = 1176 * MiB  , WS_END = 1224 * MiB;
static_assert(WS_WIN + (size_t)NH * DM * 2 <= WS_WOA && WS_XB + (size_t)M * DM * 2 <= WS_H && WS_H + (size_t)M * NH * 2 <= WS_YR, "ws map");
constexpr int CW_TMO = 0, CW_CODE = 1, CW_Q = 2048, CW_BAR = 4096;

constexpr int RING_OFF = 0, RING_BYTES = 131072;
constexpr int LDSCTL_OFF = 146432, MISC_OFF = LDSCTL_OFF + 320;
constexpr int LDS_BYTES = 147456;
#define GAS __attribute__((address_space(1)))
#define LAS __attribute__((address_space(3)))
typedef unsigned short bf16;
typedef unsigned v4u __attribute__((ext_vector_type(4)));
typedef float f32x4 __attribute__((ext_vector_type(4)));
typedef short bf16x8 __attribute__((ext_vector_type(8)));
typedef GAS unsigned gu32;
typedef GAS unsigned long long gu64;
#define RLX_AGENT __ATOMIC_RELAXED, __HIP_MEMORY_SCOPE_AGENT
#define LDS_WAIT() asm volatile("s_waitcnt lgkmcnt(0)" ::: "memory")
#define VM_WAIT() asm volatile("s_waitcnt vmcnt(0)" ::: "memory")
__device__ __forceinline__ unsigned long long rt() { return __builtin_amdgcn_s_memrealtime(); }
__device__ __forceinline__ unsigned f2bf(float f) { unsigned u = __builtin_bit_cast(unsigned, f); return (u + 0x7fffu + ((u >> 16) & 1u)) >> 16; }
typedef float f32x2_t __attribute__((ext_vector_type(2)));
typedef __bf16 bf16x2_t __attribute__((ext_vector_type(2)));
__device__ __forceinline__ unsigned pk2(float lo, float hi) { const f32x2_t v = {lo, hi}; const bf16x2_t b = __builtin_convertvector(v, bf16x2_t); return __builtin_bit_cast(unsigned, b); }

#define XB_TMO      128
#define XB_XCNT(j)  (256  + 64 * (j))
#define XB_XSUB(j)  (1280 + 64 * (j))
#define XB_XGEN(j)  (2304 + 64 * (j))
#define XB_TOP      3328
#define XB_TOPGEN   3392
#define XCD_BAR_WORDS 3456
#define XB_SPIN_CAP (1u << 18)

__device__ __forceinline__ unsigned xb_ld(unsigned* p)              { return __hip_atomic_load(p, __ATOMIC_RELAXED, __HIP_MEMORY_SCOPE_AGENT); }
__device__ __forceinline__ unsigned xb_add(unsigned* p, unsigned v) { return __hip_atomic_fetch_add(p, v, __ATOMIC_RELAXED, __HIP_MEMORY_SCOPE_AGENT); }
__device__ __forceinline__ unsigned xb_xcc_id() { return (unsigned)__builtin_amdgcn_s_getreg((3 << 11) | 20) & 0xFu; }
#define XB_SPIN(cond, bar) do { unsigned _sp = 0; while (cond) { __builtin_amdgcn_s_sleep(1); \
    if ((++_sp & 255u) == 0u) { if (xb_ld(&(bar)[XB_TMO])) break; if (_sp > XB_SPIN_CAP) { atomicAdd(&(bar)[XB_TMO], 1u); break; } } } } while (0)

struct XcdBarrier {
    unsigned* bar; unsigned x;
    volatile LAS unsigned* st;
};

__device__ __forceinline__ XcdBarrier xcd_barrier_post(unsigned* bar, volatile LAS unsigned* st) {
    XcdBarrier b; b.bar = bar; b.x = xb_xcc_id(); b.st = st;
    if (threadIdx.x == 0) (void)xb_add(&bar[XB_XCNT(b.x)], 1u);
    return b;
}
__device__ __forceinline__ void xcd_barrier_complete(unsigned* bar, unsigned x, unsigned& nloc, unsigned& nx) {
    const unsigned G = gridDim.x * gridDim.y * gridDim.z;
    unsigned sum, cnt, mine, sp = 0u;
    for (;;) {
        sum = 0u; cnt = 0u; mine = 0u;
#pragma unroll
        for (unsigned j = 0; j < 16; ++j) { const unsigned c = xb_ld(&bar[XB_XCNT(j)]); sum += c; cnt += (c > 0u) ? 1u : 0u; mine = (j == x) ? c : mine; }
        if (sum == G) break;
        __builtin_amdgcn_s_sleep(1);
        if ((++sp & 255u) == 0u) { if (xb_ld(&bar[XB_TMO])) break; if (sp > XB_SPIN_CAP) { atomicAdd(&bar[XB_TMO], 1u); break; } }
    }
    nloc = mine > 0u ? mine : 1u; nx = cnt > 0u ? cnt : 1u;
}

__device__ __forceinline__ void xcd_barrier(const XcdBarrier& b) {
    asm volatile("s_waitcnt vmcnt(0)" ::: "memory");
    __syncthreads();
    if (threadIdx.x == 0) {
        unsigned* bar = b.bar;
        __builtin_amdgcn_s_waitcnt(0);
        unsigned nloc = b.st[0], nx = b.st[1];
        if (nloc == 0u) { xcd_barrier_complete(bar, b.x, nloc, nx); b.st[0] = nloc; b.st[1] = nx; }
        const unsigned old = xb_add(&bar[XB_XSUB(b.x)], 1u);
        const unsigned gen = old / nloc;
        if (old + 1u == (gen + 1u) * nloc) {
            __builtin_amdgcn_fence(__ATOMIC_RELEASE, "agent");
            asm volatile("s_waitcnt vmcnt(0)" ::: "memory");
            const unsigned og = xb_add(&bar[XB_TOP], 1u);
            const unsigned tg = og / nx;
            if (og + 1u == (tg + 1u) * nx) xb_add(&bar[XB_TOPGEN], 1u);
            else XB_SPIN(xb_ld(&bar[XB_TOPGEN]) == tg, bar);
            __builtin_amdgcn_fence(__ATOMIC_ACQUIRE, "agent");
            xb_add(&bar[XB_XGEN(b.x)], 1u);
            asm volatile("s_waitcnt vmcnt(0)" ::: "memory");
        } else {
            XB_SPIN(xb_ld(&bar[XB_XGEN(b.x)]) == gen, bar);
            __builtin_amdgcn_fence(__ATOMIC_ACQUIRE, "agent");
            asm volatile("s_waitcnt vmcnt(0)" ::: "memory");
        }
    }
    __syncthreads();
}

typedef unsigned u32x2 __attribute__((ext_vector_type(2)));
__device__ __forceinline__ float bf2f(unsigned b) { return __builtin_bit_cast(float, b << 16); }
__device__ __forceinline__ float wave_sum(float v) {
#pragma unroll
    for (int o = 1; o < 64; o <<= 1) v += __shfl_xor(v, o);
    return v;
}
__device__ __forceinline__ float wave_max(float v) {
#pragma unroll
    for (int o = 1; o < 64; o <<= 1) v = fmaxf(v, __shfl_xor(v, o));
    return v;
}
__device__ __forceinline__ float sigmoidf_(float x) { return 1.0f / (1.0f + __expf(-x)); }
__device__ __forceinline__ float siluf_(float x) { return x / (1.0f + __expf(-x)); }

namespace pg8 {
struct EpiH {
    static constexpr bool PERM = true, AFTER_DRAIN = false;
    bf16_t* H; const float* bgate; float* out;
    __device__ __forceinline__ void operator()(const f32x4 (&acc)[2][2][4][2], const Unit& u, int wr, int wc, int fr, int fq) const {
        const int pn = u.pn;
        const int row0 = u.pm * BM + wr * 64 + fr, cw = wc * 32 + 8 * fq;
        const int mode = (pn >= 29) ? 2 : ((pn == 7 || pn == 8 || pn == 27 || pn == 28) ? 1 : 0);
        const bool is_zs = pn <= 6, is_kv = (pn >= 15 && pn <= 26);
        int kvsel = 0, g = 0, hcb = 0;
        if (is_kv) { int q = pn - 15; kvsel = q >= 6 ? 1 : 0; q = q >= 6 ? q - 6 : q; g = q >> 1; hcb = (q & 1) * 256; }
        const int keep = 128 << (2 * g);
        float* kvp = out + (g == 0 ? O_KV1P : (g == 1 ? O_KV2P : O_KV3P));
        float* kvs = out + (g == 0 ? O_KV1S : (g == 1 ? O_KV2S : O_KV3S));
        f32x4 bv[2][2];
#pragma unroll
        for (int bj = 0; bj < 2; ++bj)
#pragma unroll
            for (int n = 0; n < 2; ++n) bv[bj][n] = (mode == 2) ? *(const f32x4*)(bgate + (pn * BM + bj * HALF + cw - C_GR) + 4 * n) : (f32x4){0.f, 0.f, 0.f, 0.f};
#pragma unroll
        for (int ai = 0; ai < 2; ++ai)
#pragma unroll
            for (int m = 0; m < 4; ++m) {
                const int row = row0 + ai * HALF + m * 16;
                bf16_t* rowp = H + (size_t)row * NH + pn * BM + cw;
#pragma unroll
                for (int bj = 0; bj < 2; ++bj) {
                    f32x4 v0 = acc[ai][bj][m][0], v1 = acc[ai][bj][m][1];
                    const int col = pn * BM + bj * HALF + cw;
                    if (is_zs && col < SHIFTC) {
                        float* dst = nullptr;
                        if (row < MP) { if ((row & (SEQ - 1)) == SEQ - 1) dst = out + O_SHP + (size_t)(row >> 13) * SHIFTC + col; }
                        else if (((row - MP) & 3) == 3) dst = out + O_SHS + (size_t)((row - MP) >> 2) * SHIFTC + col;
                        if (dst) { *(f32x4*)dst = v0; *(f32x4*)(dst + 4) = v1; }
                    }
                    if (is_kv) {
                        const int hc = hcb + bj * HALF + cw;
                        float* dst = nullptr;
                        if (row < MP) { const int t = row & (SEQ - 1), b = row >> 13; if (t >= SEQ - keep) dst = kvp + ((size_t)(b * keep + t - (SEQ - keep)) * 2 + kvsel) * 512 + hc; }
                        else dst = kvs + ((size_t)(row - MP) * 2 + kvsel) * 512 + hc;
                        if (dst) { *(f32x4*)dst = v0; *(f32x4*)(dst + 4) = v1; }
                    }
                    if (mode == 1) {
#pragma unroll
                        for (int j = 0; j < 4; ++j) { v0[j] = siluf_(v0[j]); v1[j] = siluf_(v1[j]); }
                    } else if (mode == 2) {
                        v0 = v0 + bv[bj][0]; v1 = v1 + bv[bj][1];
#pragma unroll
                        for (int j = 0; j < 4; ++j) { v0[j] = sigmoidf_(v0[j]); v1[j] = sigmoidf_(v1[j]); }
                    }
                    u32x4 w; w.x = cvt_pk_bf16(v0[0], v0[1]); w.y = cvt_pk_bf16(v0[2], v0[3]); w.z = cvt_pk_bf16(v1[0], v1[1]); w.w = cvt_pk_bf16(v1[2], v1[3]);
                    *(u32x4*)(rowp + bj * HALF) = w;
                }
            }
    }
};
struct EpiMixA {
    static constexpr bool PERM = false, AFTER_DRAIN = false;
    const bf16_t* H; float* MIXF;
    __device__ __forceinline__ void operator()(const f32x4 (&acc)[2][2][4][2], const Unit& u, int wr, int wc, int fr, int fq) const {
        const int row0 = u.pm * BM + wr * 64 + fr, col0 = u.pn * BM + wc * 32 + 4 * fq;
#pragma unroll
        for (int ai = 0; ai < 2; ++ai)
#pragma unroll
            for (int m = 0; m < 4; ++m) { const int row = row0 + ai * HALF + m * 16;
#pragma unroll
                for (int bj = 0; bj < 2; ++bj)
#pragma unroll
                    for (int n = 0; n < 2; ++n) { const int c = col0 + bj * HALF + n * 16;
                        const u32x2 gb = *(const u32x2*)(H + (size_t)row * NH + C_GR + c);
                        f32x4 gt = {bf2f(gb.x & 0xffffu), bf2f(gb.x >> 16), bf2f(gb.y & 0xffffu), bf2f(gb.y >> 16)};
                        *(f32x4*)(MIXF + (size_t)row * DM + c) = gt * acc[ai][bj][m][n]; } }
    }
};
struct EpiMixB {
    static constexpr bool PERM = false, AFTER_DRAIN = false;
    const bf16_t* H; const float* MIXF; bf16_t* MIX;
    __device__ __forceinline__ void operator()(const f32x4 (&acc)[2][2][4][2], const Unit& u, int wr, int wc, int fr, int fq) const {
        const int row0 = u.pm * BM + wr * 64 + fr, col0 = u.pn * BM + wc * 32 + 4 * fq;
#pragma unroll
        for (int ai = 0; ai < 2; ++ai)
#pragma unroll
            for (int m = 0; m < 4; ++m) { const int row = row0 + ai * HALF + m * 16;
#pragma unroll
                for (int bj = 0; bj < 2; ++bj)
#pragma unroll
                    for (int n = 0; n < 2; ++n) { const int c = col0 + bj * HALF + n * 16;
                        const u32x2 gb = *(const u32x2*)(H + (size_t)row * NH + C_GA + c);
                        f32x4 gt = {bf2f(gb.x & 0xffffu), bf2f(gb.x >> 16), bf2f(gb.y & 0xffffu), bf2f(gb.y >> 16)};
                        const f32x4 v = *(const f32x4*)(MIXF + (size_t)row * DM + c) + gt * acc[ai][bj][m][n];
                        u32x2 w; w.x = cvt_pk_bf16(v[0], v[1]); w.y = cvt_pk_bf16(v[2], v[3]);
                        *(u32x2*)(MIX + (size_t)row * DM + c) = w; } }
    }
};
struct EpiPre {
    static constexpr bool PERM = false, AFTER_DRAIN = false;
    const float* xp; const float* xs; float* PRE;
    __device__ __forceinline__ void operator()(const f32x4 (&acc)[2][2][4][2], const Unit& u, int wr, int wc, int fr, int fq) const {
        const int row0 = u.pm * BM + wr * 64 + fr, col0 = u.pn * BM + wc * 32 + 4 * fq;
#pragma unroll
        for (int ai = 0; ai < 2; ++ai)
#pragma unroll
            for (int m = 0; m < 4; ++m) { const int row = row0 + ai * HALF + m * 16;
                const float* xr = row < MP ? xp + (size_t)row * DM : xs + (size_t)(row - MP) * DM;
#pragma unroll
                for (int bj = 0; bj < 2; ++bj)
#pragma unroll
                    for (int n = 0; n < 2; ++n) { const int c = col0 + bj * HALF + n * 16;
                        *(f32x4*)(PRE + (size_t)row * DM + c) = *(const f32x4*)(xr + c) * ALPHA + acc[ai][bj][m][n]; } }
    }
};
}

struct Args { const float* in[24]; float* out; unsigned char* ws; int ph_lo, ph_hi; };
struct Frame {
    LAS unsigned char* lds;
    volatile LAS unsigned* MISC;
    gu32* ctl;
    int tid, lane, wave, G;
};
#define XP_(A) ((A).in[0])
#define XS_(A) ((A).in[1])
#define C1_(A) ((A).in[2])
#define C2_(A) ((A).in[3])
#define C3_(A) ((A).in[4])
#define WKV0_(A) ((A).in[5])
#define SHIFT0_(A) ((A).in[6])
#define W_IN_(A) ((A).in[7])
#define B_GATE_(A) ((A).in[8])
#define MU_(A) ((A).in[9])
#define W0_(A) ((A).in[10])
#define W_W2_(A) ((A).in[11])
#define A0_(A) ((A).in[12])
#define W_A2_(A) ((A).in[13])
#define K_K_(A) ((A).in[14])
#define K_A_(A) ((A).in[15])
#define R_K_(A) ((A).in[16])
#define LNX_G_(A) ((A).in[17])
#define LNX_B_(A) ((A).in[18])
#define W_OA_(A) ((A).in[19])
#define W_OB_(A) ((A).in[20])
#define W_OUT_(A) ((A).in[21])
#define LN_G_(A) ((A).in[22])
#define LN_B_(A) ((A).in[23])
#define WSB_(A, off) ((bf16*)((A).ws + (off)))
#define WSF_(A, off) ((float*)((A).ws + (off)))

__device__ __forceinline__ void p0_transpose_item(const float* W, int K, int N, bf16* WT, int split_at, int split_add, LAS float* scr, int item, int lane) {
    const int nblk = N / 32, kb = item / nblk, nb = item % nblk, k0 = 64 * kb, n0 = 32 * nb;
    const int radd = n0 >= split_at ? split_add : 0;
#pragma unroll 8
    for (int i = 0; i < 32; ++i) { const int kk = 2 * i + (lane >> 5); scr[kk * 33 + (lane & 31)] = W[(size_t)(k0 + kk) * N + n0 + (lane & 31)]; }
    LDS_WAIT(); asm volatile("" ::: "memory");
    const int c = lane & 7;
#pragma unroll
    for (int j = 0; j < 4; ++j) { const int n = (lane >> 3) + 8 * j; const LAS float* s = scr + (8 * c) * 33 + n;
        v4u o; o.x = pk2(s[0 * 33], s[1 * 33]); o.y = pk2(s[2 * 33], s[3 * 33]); o.z = pk2(s[4 * 33], s[5 * 33]); o.w = pk2(s[6 * 33], s[7 * 33]);
        *(GAS v4u*)(WT + (size_t)(radd + n0 + n) * K + k0 + 8 * c) = o; }
    LDS_WAIT(); asm volatile("" ::: "memory");
}
__device__ __forceinline__ void p0_prologue(Frame& F, const Args& A) {
    LAS float* scr = (LAS float*)(F.lds + RING_OFF + F.wave * 16384);
    const int gw = blockIdx.x * NWAVES + F.wave, NGW = F.G * NWAVES;
    constexpr int I_IN = (DM / 64) * (NIN / 32), I_OA = (RW / 64) * (DM / 32), I_OUT = (DM / 64) * (DM / 32);
    constexpr int I_LR = (RW / 32);
    constexpr int NITEMS = I_IN + 2 * I_OA + I_OUT + 2 * I_LR;
    for (int it = gw; it < NITEMS; it += NGW) {
        int r = it;
        if (r < I_IN) { p0_transpose_item(W_IN_(A), DM, NIN, WSB_(A, WS_WIN), SHIFTC, 128, scr, r, F.lane); continue; } r -= I_IN;
        if (r < I_OA) { p0_transpose_item(W_OA_(A), RW, DM, WSB_(A, WS_WOA), 1 << 30, 0, scr, r, F.lane); continue; } r -= I_OA;
        if (r < I_OA) { p0_transpose_item(W_OB_(A), RW, DM, WSB_(A, WS_WOB), 1 << 30, 0, scr, r, F.lane); continue; } r -= I_OA;
        if (r < I_OUT) { p0_transpose_item(W_OUT_(A), DM, DM, WSB_(A, WS_WOUT), 1 << 30, 0, scr, r, F.lane); continue; } r -= I_OUT;
        if (r < I_LR) { p0_transpose_item(W_W2_(A), 64, RW, WSB_(A, WS_W2T), 1 << 30, 0, scr, r, F.lane); continue; } r -= I_LR;
        p0_transpose_item(W_A2_(A), 64, RW, WSB_(A, WS_A2T), 1 << 30, 0, scr, r, F.lane);
    }
    const size_t gt = (size_t)blockIdx.x * 512 + F.tid, GT = (size_t)F.G * 512;
    for (size_t i = gt; i < (size_t)128 * DM / 8; i += GT) *(GAS v4u*)(WSB_(A, WS_WIN) + (size_t)SHIFTC * DM + i * 8) = (v4u){0u, 0u, 0u, 0u};
    for (size_t i = gt; i < (size_t)M * DM / 8; i += GT) {
        const size_t e = i * 8; const float* src = e < (size_t)MP * DM ? XP_(A) + e : XS_(A) + (e - (size_t)MP * DM);
        const f32x4 a = *(const GAS f32x4*)src, b = *(const GAS f32x4*)(src + 4);
        v4u o; o.x = pk2(a.x, a.y); o.y = pk2(a.z, a.w); o.z = pk2(b.x, b.y); o.w = pk2(b.z, b.w);
        *(GAS v4u*)(WSB_(A, WS_XB) + e) = o;
    }
}

__device__ __forceinline__ void ld8bf(const bf16* p, float (&v)[8]) {
    const v4u w = *(const GAS v4u*)p;
    v[0] = bf2f(w.x & 0xffffu); v[1] = bf2f(w.x >> 16); v[2] = bf2f(w.y & 0xffffu); v[3] = bf2f(w.y >> 16);
    v[4] = bf2f(w.z & 0xffffu); v[5] = bf2f(w.z >> 16); v[6] = bf2f(w.w & 0xffffu); v[7] = bf2f(w.w >> 16);
}
__device__ __forceinline__ void ld8f(const float* p, float (&v)[8]) {
    const f32x4 a = *(const GAS f32x4*)p, b = *(const GAS f32x4*)(p + 4);
    v[0] = a.x; v[1] = a.y; v[2] = a.z; v[3] = a.w; v[4] = b.x; v[5] = b.y; v[6] = b.z; v[7] = b.w;
}
__device__ __forceinline__ void st8f(float* p, const float (&v)[8]) {
    *(GAS f32x4*)p = (f32x4){v[0], v[1], v[2], v[3]}; *(GAS f32x4*)(p + 4) = (f32x4){v[4], v[5], v[6], v[7]};
}
__device__ __forceinline__ void mixed8(Frame& F, const Args& A, int m, int c0, float (&z)[8]) {
    ld8bf(WSB_(A, WS_H) + (size_t)m * NH + c0, z);
    float p[8], mu[8];
    bool first; int sb = 0;
    if (m < MP) first = (m & (SEQ - 1)) == 0; else { first = ((m - MP) & 3) == 0; sb = (m - MP) >> 2; }
    if (!first) ld8bf(WSB_(A, WS_H) + (size_t)(m - 1) * NH + c0, p);
    else if (m < MP) {
#pragma unroll
        for (int j = 0; j < 8; ++j) p[j] = 0.f;
    } else ld8f(SHIFT0_(A) + (size_t)sb * SHIFTC + c0, p);
    ld8f(MU_(A) + c0, mu);
#pragma unroll
    for (int j = 0; j < 8; ++j) z[j] = z[j] + mu[j] * (p[j] - z[j]);
}
__device__ __forceinline__ void rwkv_prep_row(Frame& F, const Args& A, int m) {
    const int lane = F.lane, c0 = lane * 8;
    float r[8], k[8], v[8];
    mixed8(F, A, m, C_R + c0, r); mixed8(F, A, m, C_K + c0, k); mixed8(F, A, m, C_V + c0, v);
    float wa8[8];
#pragma unroll
    for (int j = 0; j < 8; ++j) wa8[j] = 0.f;
    if (lane < 16) mixed8(F, A, m, C_WD + c0, wa8);
    float wdl = 0.f, adl = 0.f;
#pragma unroll
    for (int j = 0; j < 8; ++j) { const float a = __shfl(wa8[j], lane >> 3), b = __shfl(wa8[j], 8 + (lane >> 3)); if ((lane & 7) == j) { wdl = a; adl = b; } }
    wdl = tanhf(wdl);
    float wp[8], ap[8];
#pragma unroll
    for (int j = 0; j < 8; ++j) { wp[j] = 0.f; ap[j] = 0.f; }
    for (int j = 0; j < 64; ++j) {
        const float tw = __shfl(wdl, j), ta = __shfl(adl, j);
        float w2[8], a2[8]; ld8f(W_W2_(A) + (size_t)j * RW + c0, w2); ld8f(W_A2_(A) + (size_t)j * RW + c0, a2);
#pragma unroll
        for (int q = 0; q < 8; ++q) { wp[q] += tw * w2[q]; ap[q] += ta * a2[q]; }
    }
    float w0[8], a0[8], kkc[8], kac[8];
    ld8f(W0_(A) + c0, w0); ld8f(A0_(A) + c0, a0); ld8f(K_K_(A) + c0, kkc); ld8f(K_A_(A) + c0, kac);
    float dec[8], kk[8], ka[8], k2[8]; float ss = 0.f;
#pragma unroll
    for (int j = 0; j < 8; ++j) {
        const float x = -(w0[j] + wp[j]);
        const float sp = fmaxf(x, 0.f) + log1pf(__expf(-fabsf(x)));
        const float w = -sp - 0.5f;
        dec[j] = __expf(-__expf(w));
        const float a = sigmoidf_(a0[j] + ap[j]);
        kk[j] = k[j] * kkc[j]; ss += kk[j] * kk[j];
        k2[j] = k[j] * (1.0f + (a - 1.0f) * kac[j]);
        ka[j] = a;
    }
    ss += __shfl_xor(ss, 1); ss += __shfl_xor(ss, 2); ss += __shfl_xor(ss, 4);
    const float inv = 1.0f / fmaxf(sqrtf(ss), 1e-12f);
#pragma unroll
    for (int j = 0; j < 8; ++j) { kk[j] *= inv; ka[j] *= kk[j]; }
    const size_t o = (size_t)m * RW + c0;
    st8f(WSF_(A, WS_RR) + o, r); st8f(WSF_(A, WS_DEC) + o, dec); st8f(WSF_(A, WS_K2) + o, k2); st8f(WSF_(A, WS_VV) + o, v); st8f(WSF_(A, WS_KK) + o, kk); st8f(WSF_(A, WS_KA) + o, ka);
}

template <bool PROMPT>
__device__ __forceinline__ void attn_item(Frame& F, const Args& A, int m, int h, LAS float* sq, LAS float* sp) {
    const int lane = F.lane;
    int b, t; if (PROMPT) { b = m >> 13; t = m & (SEQ - 1); } else { b = (m - MP) >> 2; t = (m - MP) & 3; }
    float og[3][2], lse[3];
#pragma unroll
    for (int g = 0; g < 3; ++g) {
        const int d = 1 << (2 * g), Wb = 128 << (2 * g);
        const float* cache = g == 0 ? C1_(A) : (g == 1 ? C2_(A) : C3_(A));
        const int hoff = g * 512 + h * 128;
        { const unsigned qq = *(const GAS unsigned*)(WSB_(A, WS_H) + (size_t)m * NH + C_AQ + hoff + 2 * lane); sq[2 * lane] = bf2f(qq & 0xffffu); sq[2 * lane + 1] = bf2f(qq >> 16); }
        LDS_WAIT(); asm volatile("" ::: "memory");
        float s[3];
#pragma unroll
        for (int kx = 0; kx < 3; ++kx) {
            const int j = lane + 64 * kx; float sc = -1e30f;
            if (kx < 2 || lane == 0) {
                const bf16* kr = nullptr; const float* kf = nullptr;
                if (PROMPT) { const int tk = t - j * d; if (tk >= 0) kr = WSB_(A, WS_H) + (size_t)(b * SEQ + tk) * NH + C_AK + hoff; }
                else { const int idx = Wb + t - j * d; if (idx >= Wb) kr = WSB_(A, WS_H) + (size_t)(MP + b * DSEQ + idx - Wb) * NH + C_AK + hoff; else kf = cache + ((size_t)(b * Wb + idx) * 2 + 0) * 512 + h * 128; }
                if (kr) { float a = 0.f;
                    for (int e = 0; e < 128; e += 8) { float kv[8]; ld8bf(kr + e, kv);
#pragma unroll
                        for (int q = 0; q < 8; ++q) a += sq[e + q] * kv[q]; }
                    sc = a * ATT_SCALE; }
                else if (kf) { float a = 0.f;
                    for (int e = 0; e < 128; e += 8) { float kv[8]; ld8f(kf + e, kv);
#pragma unroll
                        for (int q = 0; q < 8; ++q) a += sq[e + q] * kv[q]; }
                    sc = a * ATT_SCALE; }
            }
            s[kx] = sc;
        }
        const float mx = wave_max(fmaxf(fmaxf(s[0], s[1]), s[2]));
        float p[3]; float ls = 0.f;
#pragma unroll
        for (int kx = 0; kx < 3; ++kx) { p[kx] = s[kx] > -1e29f ? __expf(s[kx] - mx) : 0.f; ls += p[kx]; }
        const float l = wave_sum(ls);
        sp[lane] = p[0]; sp[lane + 64] = p[1]; if (lane == 0) sp[128] = p[2];
        LDS_WAIT(); asm volatile("" ::: "memory");
        float a0 = 0.f, a1 = 0.f;
        for (int j = 0; j < 129; ++j) {
            const float pj = sp[j];
            if (PROMPT) { const int tk = t - j * d; if (tk >= 0) { const unsigned vv = *(const GAS unsigned*)(WSB_(A, WS_H) + (size_t)(b * SEQ + tk) * NH + C_AV + hoff + 2 * lane); a0 += pj * bf2f(vv & 0xffffu); a1 += pj * bf2f(vv >> 16); } }
            else { const int idx = Wb + t - j * d;
                if (idx >= Wb) { const unsigned vv = *(const GAS unsigned*)(WSB_(A, WS_H) + (size_t)(MP + b * DSEQ + idx - Wb) * NH + C_AV + hoff + 2 * lane); a0 += pj * bf2f(vv & 0xffffu); a1 += pj * bf2f(vv >> 16); }
                else { const float* vf = cache + ((size_t)(b * Wb + idx) * 2 + 1) * 512 + h * 128 + 2 * lane; a0 += pj * vf[0]; a1 += pj * vf[1]; } }
        }
        const float il = 1.0f / l;
        og[g][0] = a0 * il; og[g][1] = a1 * il; lse[g] = mx + __logf(l);
        LDS_WAIT(); asm volatile("" ::: "memory");
    }
    const float ml = fmaxf(fmaxf(lse[0], lse[1]), lse[2]);
    const float w0 = __expf(lse[0] - ml), w1 = __expf(lse[1] - ml), w2 = __expf(lse[2] - ml), iw = 1.0f / (w0 + w1 + w2);
    const unsigned zz = *(const GAS unsigned*)(WSB_(A, WS_H) + (size_t)m * NH + C_ZA + h * 128 + 2 * lane);
    const float y0 = (w0 * og[0][0] + w1 * og[1][0] + w2 * og[2][0]) * iw * bf2f(zz & 0xffffu);
    const float y1 = (w0 * og[0][1] + w1 * og[1][1] + w2 * og[2][1]) * iw * bf2f(zz >> 16);
    *(GAS unsigned*)(WSB_(A, WS_YA) + (size_t)m * RW + h * 128 + 2 * lane) = pk2(y0, y1);
}

__device__ __forceinline__ void scan_item(Frame& F, const Args& A, int item) {
    const int lane = F.lane;
    int T, row0, h; float* sout; const float* s0 = nullptr;
    if (item < 16) { const int b = item >> 3; h = item & 7; T = SEQ; row0 = b * SEQ; sout = A.out + O_WKVP + ((size_t)(b * 8 + h) * 64 + lane) * 64; }
    else { const int s = item - 16, b = s >> 3; h = s & 7; T = DSEQ; row0 = MP + b * DSEQ; sout = A.out + O_WKVS + ((size_t)(b * 8 + h) * 64 + lane) * 64; s0 = WKV0_(A) + ((size_t)(b * 8 + h) * 64 + lane) * 64; }
    float S[64];
#pragma unroll
    for (int k = 0; k < 64; k += 4) { f32x4 v = s0 ? *(const GAS f32x4*)(s0 + k) : (f32x4){0.f, 0.f, 0.f, 0.f}; S[k] = v.x; S[k + 1] = v.y; S[k + 2] = v.z; S[k + 3] = v.w; }
    for (int t = 0; t < T; ++t) {
        const size_t base = (size_t)(row0 + t) * RW + h * 64;
        const float vi = WSF_(A, WS_VV)[base + lane];
        float sa = 0.f;
#pragma unroll
        for (int k = 0; k < 64; k += 4) { const f32x4 q = *(const GAS f32x4*)(WSF_(A, WS_KK) + base + k); sa -= S[k] * q.x; sa -= S[k + 1] * q.y; sa -= S[k + 2] * q.z; sa -= S[k + 3] * q.w; if ((k & 15) == 12) asm volatile("" ::: "memory"); }
        float o = 0.f;
#pragma unroll
        for (int k = 0; k < 64; k += 4) {
            const f32x4 dc = *(const GAS f32x4*)(WSF_(A, WS_DEC) + base + k), ka = *(const GAS f32x4*)(WSF_(A, WS_KA) + base + k), k2 = *(const GAS f32x4*)(WSF_(A, WS_K2) + base + k), rr = *(const GAS f32x4*)(WSF_(A, WS_RR) + base + k);
            S[k] = S[k] * dc.x + sa * ka.x + vi * k2.x; S[k + 1] = S[k + 1] * dc.y + sa * ka.y + vi * k2.y; S[k + 2] = S[k + 2] * dc.z + sa * ka.z + vi * k2.z; S[k + 3] = S[k + 3] * dc.w + sa * ka.w + vi * k2.w;
            o += S[k] * rr.x; o += S[k + 1] * rr.y; o += S[k + 2] * rr.z; o += S[k + 3] * rr.w;
            if ((k & 7) == 4) asm volatile("" ::: "memory");
        }
        WSF_(A, WS_OO)[base + lane] = o;
    }
#pragma unroll
    for (int k = 0; k < 64; k += 4) *(GAS f32x4*)(sout + k) = (f32x4){S[k], S[k + 1], S[k + 2], S[k + 3]};
}

__device__ __forceinline__ void rwkv_post_row(Frame& F, const Args& A, int m) {
    const int lane = F.lane, c0 = lane * 8; const size_t o = (size_t)m * RW + c0;
    float ov[8], r[8], k2[8], v[8], rk[8], g[8], bb[8], z[8];
    ld8f(WSF_(A, WS_OO) + o, ov); ld8f(WSF_(A, WS_RR) + o, r); ld8f(WSF_(A, WS_K2) + o, k2); ld8f(WSF_(A, WS_VV) + o, v); ld8f(R_K_(A) + c0, rk); ld8f(LNX_G_(A) + c0, g); ld8f(LNX_B_(A) + c0, bb);
    ld8bf(WSB_(A, WS_H) + (size_t)m * NH + C_ZR + c0, z);
    float s = 0.f, bs = 0.f;
#pragma unroll
    for (int j = 0; j < 8; ++j) { s += ov[j]; bs += r[j] * k2[j] * rk[j]; }
    s += __shfl_xor(s, 1); s += __shfl_xor(s, 2); s += __shfl_xor(s, 4);
    bs += __shfl_xor(bs, 1); bs += __shfl_xor(bs, 2); bs += __shfl_xor(bs, 4);
    const float mean = s * (1.0f / 64.0f); float q = 0.f;
#pragma unroll
    for (int j = 0; j < 8; ++j) { const float dlt = ov[j] - mean; q += dlt * dlt; }
    q += __shfl_xor(q, 1); q += __shfl_xor(q, 2); q += __shfl_xor(q, 4);
    const float rstd = 1.0f / sqrtf(q * (1.0f / 64.0f) + GN_EPS);
    float y[8];
#pragma unroll
    for (int j = 0; j < 8; ++j) y[j] = ((ov[j] - mean) * rstd * g[j] + bb[j] + bs * v[j]) * z[j];
    v4u w; w.x = pk2(y[0], y[1]); w.y = pk2(y[2], y[3]); w.z = pk2(y[4], y[5]); w.w = pk2(y[6], y[7]);
    *(GAS v4u*)(WSB_(A, WS_YR) + o) = w;
}

typedef short s16x4 __attribute__((ext_vector_type(4)));
typedef short v4i16_t __attribute__((ext_vector_type(4)));
constexpr int LDP = 72;
constexpr int ARRB = 64 * LDP * 2;
enum { A_AT = 0, A_BH, A_KH, A_RT, A_VQ, A_XA, A_XB, A_TA, A_TB, A_MAK, A_MRB, A_MRK, A_NARR };
constexpr int A_SMALL = A_NARR * ARRB;
static_assert(A_SMALL + 4096 <= RING_BYTES, "phase A LDS");
constexpr int NUNITS = 16 * 128;

__device__ __forceinline__ f32x4 mfma16(bf16x8 a, bf16x8 b, f32x4 c) { return __builtin_amdgcn_mfma_f32_16x16x32_bf16(a, b, c, 0, 0, 0); }
__device__ __forceinline__ bf16x8 frag_rows(const LAS bf16* X, int row0, int k0, int lane) { return *(const LAS bf16x8*)(X + (row0 + (lane & 15)) * LDP + k0 + 8 * (lane >> 4)); }
__device__ __forceinline__ bf16x8 frag_tr(const LAS bf16* X, int k0, int col0, int lane) {
    const int g = lane >> 4, i = lane & 15;
    const LAS bf16* a0 = X + (k0 + 8 * g + (i >> 2)) * LDP + col0 + 4 * (i & 3);
    const s16x4 lo = __builtin_bit_cast(s16x4, __builtin_amdgcn_ds_read_tr16_b64_v4i16((LAS v4i16_t*)a0));
    const s16x4 hi = __builtin_bit_cast(s16x4, __builtin_amdgcn_ds_read_tr16_b64_v4i16((LAS v4i16_t*)(a0 + 4 * LDP)));
    return __builtin_shufflevector(lo, hi, 0, 1, 2, 3, 4, 5, 6, 7);
}
__device__ __forceinline__ u32x2 pk4(f32x4 v) { u32x2 w; w.x = pk2(v[0], v[1]); w.y = pk2(v[2], v[3]); return w; }
__device__ __forceinline__ f32x4 up4(u32x2 w) { return (f32x4){bf2f(w.x & 0xffffu), bf2f(w.x >> 16), bf2f(w.y & 0xffffu), bf2f(w.y >> 16)}; }
__device__ __forceinline__ void st4(LAS bf16* X, int row, int col, f32x4 v) { *(LAS u32x2*)(X + row * LDP + col) = pk4(v); }
__device__ __forceinline__ f32x4 ld4(const LAS bf16* X, int row, int col) { return up4(*(const LAS u32x2*)(X + row * LDP + col)); }
__device__ __forceinline__ float dpp_shr(float x, int n) {
    const int iv = __builtin_bit_cast(int, x); int r;
    switch (n) { case 1: r = __builtin_amdgcn_update_dpp(0, iv, 0x111, 0xf, 0xf, true); break; case 2: r = __builtin_amdgcn_update_dpp(0, iv, 0x112, 0xf, 0xf, true); break;
                 case 4: r = __builtin_amdgcn_update_dpp(0, iv, 0x114, 0xf, 0xf, true); break; default: r = __builtin_amdgcn_update_dpp(0, iv, 0x118, 0xf, 0xf, true); break; }
    return __builtin_bit_cast(float, r);
}
__device__ __forceinline__ float row_scan(float x) { x += dpp_shr(x, 1); x += dpp_shr(x, 2); x += dpp_shr(x, 4); x += dpp_shr(x, 8); return x; }
__device__ __forceinline__ f32x4 mixed4(const bf16* H, const float* mu, int m, int col, bool first) {
    const f32x4 z = up4(*(const GAS u32x2*)(H + (size_t)m * NH + col));
    f32x4 p = {0.f, 0.f, 0.f, 0.f};
    if (!first) p = up4(*(const GAS u32x2*)(H + (size_t)(m - 1) * NH + col));
    const f32x4 mv = *(const GAS f32x4*)(mu + col);
    return z + mv * (p - z);
}
__device__ __forceinline__ void pq2(const LAS bf16* P, const LAS bf16* Q, int tt, int hf, int lane, f32x4 (&acc)[2]) {
#pragma unroll
    for (int ks = 0; ks < 2; ++ks) { const bf16x8 bp = frag_rows(P, 16 * tt, 32 * ks, lane);
#pragma unroll
        for (int j = 0; j < 2; ++j) acc[j] = mfma16(frag_tr(Q, 32 * ks, 16 * (2 * hf + j), lane), bp, acc[j]); }
}
#define WG_BAR() do { asm volatile("s_waitcnt vmcnt(0) lgkmcnt(0)" ::: "memory"); __builtin_amdgcn_s_barrier(); asm volatile("" ::: "memory"); } while (0)

#define LBAR() do { asm volatile("s_waitcnt lgkmcnt(0)" ::: "memory"); __builtin_amdgcn_s_barrier(); asm volatile("" ::: "memory"); } while (0)
__device__ __forceinline__ float fast_rcp(float x) { return __builtin_amdgcn_rcpf(x); }
__device__ __forceinline__ float fast_sigmoid(float x) { return fast_rcp(1.0f + __expf(-x)); }
__device__ __forceinline__ float fast_tanh(float x) { return 1.0f - 2.0f * fast_rcp(1.0f + __expf(2.0f * x)); }
struct RawRow { u32x2 z[2][5], p[2][3]; };
__device__ __forceinline__ void rwkvA_loadraw(const bf16* H, int b, int c, int h, int tt, int hf, int i, int g, RawRow& R) {
    const int t = 16 * tt + i, m = b * SEQ + c * 64 + t; const bool first = (c == 0) && (t == 0);
#pragma unroll
    for (int j = 0; j < 2; ++j) { const int cb = 16 * (2 * hf + j) + 4 * g;
        const int cols[5] = {C_R + h * 64 + cb, C_K + h * 64 + cb, C_V + h * 64 + cb, C_WD + cb, C_AD + cb};
#pragma unroll
        for (int q = 0; q < 5; ++q) { R.z[j][q] = *(const GAS u32x2*)(H + (size_t)m * NH + cols[q]); if (q < 3) R.p[j][q] = first ? (u32x2){0u, 0u} : *(const GAS u32x2*)(H + (size_t)(first ? m : m - 1) * NH + cols[q]); } }
}
__device__ __forceinline__ void rwkvA_phase(Frame& F, const Args& A) {
    const int lane = F.lane, w = F.wave, tt = w & 3, hf = w >> 2, i = lane & 15, g = lane >> 4;
    const int t = 16 * tt + i;
    LAS unsigned char* L = F.lds + RING_OFF;
#define ARR(k) ((LAS bf16*)(L + (k) * ARRB))
    LAS float* tot = (LAS float*)(L + A_SMALL); LAS float* gcl = tot + 256; LAS float* pss = gcl + 64; LAS float* pbn = pss + 128;
    const bf16* H = WSB_(A, WS_H);
    if (F.G % 8 != 0) return;
    const int h = blockIdx.x & 7, slot = blockIdx.x >> 3, nslot = F.G >> 3;
    RawRow R;
    if (slot < 256) rwkvA_loadraw(H, slot >> 7, slot & 127, h, tt, hf, i, g, R);
#pragma unroll 1
    for (int jj = slot; jj < 256; jj += nslot) {
    const int b = jj >> 7, c = jj & 127, unit = (b * 8 + h) * 128 + c, m = b * SEQ + c * 64 + t;
    f32x4 rv[2], kv[2], vv[2];
#pragma unroll
    for (int j = 0; j < 2; ++j) { const int cb = 16 * (2 * hf + j) + 4 * g, hc = h * 64 + cb;
        f32x4 mx[5];
        const int mcol[5] = {C_R + hc, C_K + hc, C_V + hc, C_WD + cb, C_AD + cb};
#pragma unroll
        for (int q = 0; q < 5; ++q) { const f32x4 z = up4(R.z[j][q]);
            const f32x4 p = (q < 3) ? up4(R.p[j][q < 3 ? q : 0]) : (((c == 0) && (t == 0)) ? (f32x4){0.f, 0.f, 0.f, 0.f} : up4(*(const GAS u32x2*)(H + (size_t)(((c == 0) && (t == 0)) ? m : m - 1) * NH + mcol[q])));
            mx[q] = z + *(const GAS f32x4*)(MU_(A) + mcol[q]) * (p - z); }
        rv[j] = mx[0]; kv[j] = mx[1]; vv[j] = mx[2];
#pragma unroll
        for (int r = 0; r < 4; ++r) mx[3][r] = fast_tanh(mx[3][r]);
        st4(ARR(A_XA), t, cb, mx[3]); st4(ARR(A_XB), t, cb, mx[4]); }
    if (jj + nslot < 256) rwkvA_loadraw(H, (jj + nslot) >> 7, (jj + nslot) & 127, h, tt, hf, i, g, R);
    LBAR();
    f32x4 aw[2] = {{0.f, 0.f, 0.f, 0.f}, {0.f, 0.f, 0.f, 0.f}}, aa[2] = {{0.f, 0.f, 0.f, 0.f}, {0.f, 0.f, 0.f, 0.f}};
#pragma unroll
    for (int ks = 0; ks < 2; ++ks) { const bf16x8 btw = frag_rows(ARR(A_XA), 16 * tt, 32 * ks, lane), bad = frag_rows(ARR(A_XB), 16 * tt, 32 * ks, lane);
#pragma unroll
        for (int j = 0; j < 2; ++j) { const size_t wo = (size_t)(h * 64 + 16 * (2 * hf + j) + i) * 64 + 32 * ks + 8 * g;
            aw[j] = mfma16(*(const GAS bf16x8*)(WSB_(A, WS_W2T) + wo), btw, aw[j]); aa[j] = mfma16(*(const GAS bf16x8*)(WSB_(A, WS_A2T) + wo), bad, aa[j]); } }
    f32x4 ld[2], av[2], kkr[2], k2[2], cum[2]; float ssq = 0.f, bon = 0.f;
    f32x4 rkc[2];
#pragma unroll
    for (int j = 0; j < 2; ++j) { const int hc = h * 64 + 16 * (2 * hf + j) + 4 * g;
        f32x4 w0v[2], a0v[2], kkc[2], kac[2];
        w0v[j] = *(const GAS f32x4*)(W0_(A) + hc); a0v[j] = *(const GAS f32x4*)(A0_(A) + hc); kkc[j] = *(const GAS f32x4*)(K_K_(A) + hc); kac[j] = *(const GAS f32x4*)(K_A_(A) + hc); rkc[j] = *(const GAS f32x4*)(R_K_(A) + hc);
#pragma unroll
        for (int r = 0; r < 4; ++r) {
            const float x = -(w0v[j][r] + aw[j][r]); const float sp = fmaxf(x, 0.f) + __logf(1.0f + __expf(-fabsf(x)));
            ld[j][r] = -__expf(-sp - 0.5f);
            const float a = fast_sigmoid(a0v[j][r] + aa[j][r]); av[j][r] = a;
            kkr[j][r] = kv[j][r] * kkc[j][r]; ssq += kkr[j][r] * kkr[j][r];
            k2[j][r] = kv[j][r] * (1.0f + (a - 1.0f) * kac[j][r]);
            bon += rv[j][r] * k2[j][r] * rkc[j][r];
            cum[j][r] = row_scan(ld[j][r]);
        }
        if (i == 15) *(LAS f32x4*)(tot + tt * 64 + 16 * (2 * hf + j) + 4 * g) = cum[j]; }
    ssq += __shfl_xor(ssq, 16); ssq += __shfl_xor(ssq, 32); bon += __shfl_xor(bon, 16); bon += __shfl_xor(bon, 32);
    if (g == 0) { pss[w * 16 + i] = ssq; pbn[w * 16 + i] = bon; }
    LBAR();
    ssq = pss[w * 16 + i] + pss[(w ^ 4) * 16 + i]; bon = pbn[w * 16 + i] + pbn[(w ^ 4) * 16 + i];
    const float inv = fminf(__builtin_amdgcn_rsqf(ssq), 1e12f);
#pragma unroll
    for (int j = 0; j < 2; ++j) { const int cb = 16 * (2 * hf + j) + 4 * g;
        f32x4 off = {0.f, 0.f, 0.f, 0.f}, all = {0.f, 0.f, 0.f, 0.f};
#pragma unroll
        for (int q = 0; q < 4; ++q) { const f32x4 tq = *(const LAS f32x4*)(tot + q * 64 + cb); all = all + tq; if (q < tt) off = off + tq; }
        f32x4 at, bhv, khv, rt;
#pragma unroll
        for (int r = 0; r < 4; ++r) { const float cm = cum[j][r] + off[r]; const float ep = __expf(cm), em = fast_rcp(ep), epv = __expf(cm - ld[j][r]); const float kk = kkr[j][r] * inv;
            at[r] = -kk * epv; bhv[r] = kk * av[j][r] * em; khv[r] = k2[j][r] * em; rt[r] = rv[j][r] * ep; }
        st4(ARR(A_AT), t, cb, at); st4(ARR(A_BH), t, cb, bhv); st4(ARR(A_KH), t, cb, khv); st4(ARR(A_RT), t, cb, rt); st4(ARR(A_VQ), t, cb, vv[j]);
        *(GAS u32x2*)(WSB_(A, WS_VMX) + (size_t)m * RW + h * 64 + cb) = pk4(vv[j]);
        if (tt == 0 && i == 0) { f32x4 gc; for (int r = 0; r < 4; ++r) gc[r] = __expf(all[r]); *(LAS f32x4*)(gcl + cb) = gc; } }
    if (hf == 0 && g == 0) WSF_(A, WS_BON)[(size_t)m * 8 + h] = bon;
    LBAR();
#pragma unroll
    for (int j = 0; j < 2; ++j) { const int mt = 2 * hf + j;
        f32x4 ab = {0.f, 0.f, 0.f, 0.f}, ak = ab, rb = ab, rk = ab;
        if (mt <= tt) {
#pragma unroll
            for (int ks = 0; ks < 2; ++ks) { const bf16x8 abh = frag_rows(ARR(A_BH), 16 * mt, 32 * ks, lane), akh = frag_rows(ARR(A_KH), 16 * mt, 32 * ks, lane), bat = frag_rows(ARR(A_AT), 16 * tt, 32 * ks, lane), brt = frag_rows(ARR(A_RT), 16 * tt, 32 * ks, lane);
                ab = mfma16(abh, bat, ab); ak = mfma16(akh, bat, ak); rb = mfma16(abh, brt, rb); rk = mfma16(akh, brt, rk); } }
        f32x4 t1;
#pragma unroll
        for (int r = 0; r < 4; ++r) { const int s = 16 * mt + 4 * g + r; const bool lt = s < t, le = s <= t;
            ab[r] = lt ? ab[r] : 0.f; ak[r] = lt ? ak[r] : 0.f; rb[r] = le ? rb[r] : 0.f; rk[r] = le ? rk[r] : 0.f; t1[r] = ab[r] + (s == t ? 1.0f : 0.f); }
        const int cb = 16 * mt + 4 * g;
        st4(ARR(A_XA), t, cb, ab); st4(ARR(A_TA), t, cb, t1); st4(ARR(A_MAK), t, cb, ak); st4(ARR(A_MRB), t, cb, rb); st4(ARR(A_MRK), t, cb, rk); }
    LBAR();
    const int cb0 = 16 * (2 * hf) + 4 * g, cb1 = cb0 + 16;
#define SQ_STAGE(XC, XN) do { f32x4 z[2] = {{0.f, 0.f, 0.f, 0.f}, {0.f, 0.f, 0.f, 0.f}}; pq2(ARR(XC), ARR(XC), tt, hf, lane, z); st4(ARR(XN), t, cb0, z[0]); st4(ARR(XN), t, cb1, z[1]); } while (0)
#define T_STAGE(TC, TN, XC) do { f32x4 z[2]; z[0] = ld4(ARR(TC), t, cb0); z[1] = ld4(ARR(TC), t, cb1); pq2(ARR(TC), ARR(XC), tt, hf, lane, z); st4(ARR(TN), t, cb0, z[0]); st4(ARR(TN), t, cb1, z[1]); } while (0)
    SQ_STAGE(A_XA, A_XB); LBAR();
    SQ_STAGE(A_XB, A_XA); T_STAGE(A_TA, A_TB, A_XB); LBAR();
    SQ_STAGE(A_XA, A_XB); T_STAGE(A_TB, A_TA, A_XA); LBAR();
    SQ_STAGE(A_XB, A_XA); T_STAGE(A_TA, A_TB, A_XB); LBAR();
    SQ_STAGE(A_XA, A_XB); T_STAGE(A_TB, A_TA, A_XA); LBAR();
    T_STAGE(A_TA, A_TB, A_XB); LBAR();
    { f32x4 z[2] = {{0.f, 0.f, 0.f, 0.f}, {0.f, 0.f, 0.f, 0.f}}; pq2(ARR(A_TB), ARR(A_AT), tt, hf, lane, z); st4(ARR(A_XA), t, cb0, z[0]); st4(ARR(A_XA), t, cb1, z[1]); }
    { f32x4 z[2] = {{0.f, 0.f, 0.f, 0.f}, {0.f, 0.f, 0.f, 0.f}}; pq2(ARR(A_MAK), ARR(A_VQ), tt, hf, lane, z); st4(ARR(A_TA), t, cb0, z[0]); st4(ARR(A_TA), t, cb1, z[1]); }
    LBAR();
    { f32x4 z[2] = {{0.f, 0.f, 0.f, 0.f}, {0.f, 0.f, 0.f, 0.f}}; pq2(ARR(A_TB), ARR(A_TA), tt, hf, lane, z); st4(ARR(A_XB), t, cb0, z[0]); st4(ARR(A_XB), t, cb1, z[1]); }
    LBAR();
    { f32x4 z[2]; z[0] = ld4(ARR(A_RT), t, cb0); z[1] = ld4(ARR(A_RT), t, cb1); pq2(ARR(A_MRB), ARR(A_XA), tt, hf, lane, z);
      bf16* qe = WSB_(A, WS_QE) + ((size_t)unit * 64 + t) * 64; *(GAS u32x2*)(qe + cb0) = pk4(z[0]); *(GAS u32x2*)(qe + cb1) = pk4(z[1]); }
    { f32x4 z[2] = {{0.f, 0.f, 0.f, 0.f}, {0.f, 0.f, 0.f, 0.f}}; pq2(ARR(A_MRB), ARR(A_XB), tt, hf, lane, z); pq2(ARR(A_MRK), ARR(A_VQ), tt, hf, lane, z);
      float* ol = WSF_(A, WS_OL) + ((size_t)unit * 64 + t) * 64; *(GAS f32x4*)(ol + cb0) = z[0]; *(GAS f32x4*)(ol + cb1) = z[1]; }
    {
      unsigned char* rec = A.ws + WS_REC + (size_t)unit * 24576;
      f32x4 p[2] = {{0.f, 0.f, 0.f, 0.f}, {0.f, 0.f, 0.f, 0.f}};
#pragma unroll
      for (int ks = 0; ks < 2; ++ks) { const bf16x8 bbh = frag_tr(ARR(A_BH), 32 * ks, 16 * tt, lane);
#pragma unroll
          for (int j = 0; j < 2; ++j) p[j] = mfma16(frag_tr(ARR(A_XA), 32 * ks, 16 * (2 * hf + j), lane), bbh, p[j]); }
      const float gkp = gcl[16 * tt + i];
#pragma unroll
      for (int j = 0; j < 2; ++j) { const int mt = 2 * hf + j, cb = 16 * mt + 4 * g;
#pragma unroll
          for (int r = 0; r < 4; ++r) p[j][r] = gkp * (p[j][r] + ((cb + r) == (16 * tt + i) ? 1.0f : 0.f));
          *(GAS u32x2*)(rec + (((tt * 2 + (mt >> 1)) * 64 + g * 16 + i) * 16 + (mt & 1) * 8)) = pk4(p[j]); }
      asm volatile("" ::: "memory");
      f32x4 s2[2] = {{0.f, 0.f, 0.f, 0.f}, {0.f, 0.f, 0.f, 0.f}};
#pragma unroll
      for (int ks = 0; ks < 2; ++ks) { const bf16x8 bul = frag_tr(ARR(A_XB), 32 * ks, 16 * tt, lane), bvq = frag_tr(ARR(A_VQ), 32 * ks, 16 * tt, lane);
#pragma unroll
          for (int j = 0; j < 2; ++j) { const int mt = 2 * hf + j;
              s2[j] = mfma16(frag_tr(ARR(A_BH), 32 * ks, 16 * mt, lane), bul, s2[j]);
              s2[j] = mfma16(frag_tr(ARR(A_KH), 32 * ks, 16 * mt, lane), bvq, s2[j]); } }
#pragma unroll
      for (int j = 0; j < 2; ++j) { const int mt = 2 * hf + j, cb = 16 * mt + 4 * g; const f32x4 gq = *(const LAS f32x4*)(gcl + cb);
          *(GAS f32x4*)(rec + 8192 + ((tt * 4 + mt) * 64 + g * 16 + i) * 16) = s2[j] * gq; } }
    LBAR();
    }
#undef SQ_STAGE
#undef T_STAGE
#undef ARR
}

__device__ __forceinline__ void rwkv_carry(Frame& F, const Args& A, int bh) {
    const int lane = F.lane, w = F.wave, i = lane & 15, g = lane >> 4;
    LAS unsigned char* L = F.lds + RING_OFF;
    const unsigned char* REC = A.ws + WS_REC + (size_t)bh * 128 * 24576;
    bf16* S0B = WSB_(A, WS_S0B) + (size_t)bh * 128 * 4096;
    const int v = 16 * (w & 3) + i;
    f32x4 acc[4];
#pragma unroll
    for (int mt = 0; mt < 4; ++mt) acc[mt] = (f32x4){0.f, 0.f, 0.f, 0.f};
#define CARRY_ISSUE(cc) do { const unsigned char* src = REC + (size_t)(cc) * 24576 + (w - 4) * 6144 + lane * 16; LAS unsigned char* dst = L + ((cc) % 5) * 24576 + (w - 4) * 6144; \
        _Pragma("unroll") for (int k = 0; k < 6; ++k) __builtin_amdgcn_global_load_lds((const unsigned*)(src + k * 1024), (LAS unsigned*)(dst + k * 1024), 16, 0, 0); } while (0)
    if (w >= 4) { CARRY_ISSUE(0); CARRY_ISSUE(1); CARRY_ISSUE(2); CARRY_ISSUE(3); asm volatile("s_waitcnt vmcnt(18)" ::: "memory"); }
    __builtin_amdgcn_s_barrier(); asm volatile("" ::: "memory");
#pragma unroll 1
    for (int c = 0; c < 128; ++c) {
        if (w >= 4) {
            if (c + 4 < 128) { CARRY_ISSUE(c + 4); asm volatile("s_waitcnt vmcnt(18)" ::: "memory"); }
            else asm volatile("s_waitcnt vmcnt(0)" ::: "memory");
        } else {
            const LAS unsigned char* sb = L + (c % 5) * 24576;
            f32x4 sc[4]; bf16x8 pa[4][2];
#pragma unroll
            for (int mt = 0; mt < 4; ++mt) { sc[mt] = *(const LAS f32x4*)(sb + 8192 + ((w * 4 + mt) * 64 + lane) * 16);
#pragma unroll
                for (int ks = 0; ks < 2; ++ks) pa[mt][ks] = *(const LAS bf16x8*)(sb + ((mt * 2 + ks) * 64 + lane) * 16); }
            bf16* s0 = S0B + (size_t)c * 4096 + v * 64 + 4 * g;
            u32x2 pk[4];
#pragma unroll
            for (int mt = 0; mt < 4; ++mt) { pk[mt] = pk4(acc[mt]); *(GAS u32x2*)(s0 + 16 * mt) = pk[mt]; }
#pragma unroll
            for (int ks = 0; ks < 2; ++ks) { const v4u bw = {pk[2 * ks].x, pk[2 * ks].y, pk[2 * ks + 1].x, pk[2 * ks + 1].y}; const bf16x8 bf = __builtin_bit_cast(bf16x8, bw);
#pragma unroll
                for (int mt = 0; mt < 4; ++mt) sc[mt] = mfma16(pa[mt][ks], bf, sc[mt]); }
#pragma unroll
            for (int mt = 0; mt < 4; ++mt) acc[mt] = sc[mt];
            asm volatile("s_waitcnt lgkmcnt(0)" ::: "memory");
        }
        __builtin_amdgcn_s_barrier(); asm volatile("" ::: "memory");
    }
#undef CARRY_ISSUE
    if (w < 4) { float* so = A.out + O_WKVP + ((size_t)bh * 64 + v) * 64 + 4 * g;
#pragma unroll
        for (int mt = 0; mt < 4; ++mt) *(GAS f32x4*)(so + 16 * mt) = acc[mt]; }
}

__device__ __forceinline__ void rwkvC_unit(Frame& F, const Args& A, int unit) {
    const int lane = F.lane, tt = F.wave & 3, i = lane & 15, g = lane >> 4;
    const int bh = unit >> 7, c = unit & 127, b = bh >> 3, h = bh & 7;
    const int t = 16 * tt + i, m = b * SEQ + c * 64 + t;
    const bf16* QE = WSB_(A, WS_QE) + (size_t)unit * 4096; const bf16* S0 = WSB_(A, WS_S0B) + (size_t)unit * 4096; const float* OL = WSF_(A, WS_OL) + (size_t)unit * 4096;
    f32x4 acc[4];
#pragma unroll
    for (int mt = 0; mt < 4; ++mt) acc[mt] = *(const GAS f32x4*)(OL + t * 64 + 16 * mt + 4 * g);
#pragma unroll
    for (int ks = 0; ks < 2; ++ks) { const bf16x8 bq = *(const GAS bf16x8*)(QE + t * 64 + 32 * ks + 8 * g);
#pragma unroll
        for (int mt = 0; mt < 4; ++mt) acc[mt] = mfma16(*(const GAS bf16x8*)(S0 + (16 * mt + i) * 64 + 32 * ks + 8 * g), bq, acc[mt]); }
    float s = 0.f;
#pragma unroll
    for (int mt = 0; mt < 4; ++mt) s += (acc[mt][0] + acc[mt][1]) + (acc[mt][2] + acc[mt][3]);
    s += __shfl_xor(s, 16); s += __shfl_xor(s, 32);
    const float mean = s * (1.0f / 64.0f); float q = 0.f;
#pragma unroll
    for (int mt = 0; mt < 4; ++mt)
#pragma unroll
        for (int r = 0; r < 4; ++r) { const float d = acc[mt][r] - mean; q += d * d; }
    q += __shfl_xor(q, 16); q += __shfl_xor(q, 32);
    const float rstd = 1.0f / sqrtf(q * (1.0f / 64.0f) + GN_EPS);
    const float bon = WSF_(A, WS_BON)[(size_t)m * 8 + h];
#pragma unroll
    for (int mt = 0; mt < 4; ++mt) { const int hc = h * 64 + 16 * mt + 4 * g;
        const f32x4 gg = *(const GAS f32x4*)(LNX_G_(A) + hc), bb = *(const GAS f32x4*)(LNX_B_(A) + hc);
        const f32x4 vm = up4(*(const GAS u32x2*)(WSB_(A, WS_VMX) + (size_t)m * RW + hc)), zr = up4(*(const GAS u32x2*)(WSB_(A, WS_H) + (size_t)m * NH + C_ZR + hc));
        f32x4 y;
#pragma unroll
        for (int r = 0; r < 4; ++r) y[r] = ((acc[mt][r] - mean) * rstd * gg[r] + bb[r] + bon * vm[r]) * zr[r];
        *(GAS u32x2*)(WSB_(A, WS_YR) + (size_t)m * RW + hc) = pk4(y); }
}

constexpr int AT_K = 0, AT_V = 65536, AT_VROWS = 272;
constexpr int NATT_UNITS = 3 * 512;
__device__ __forceinline__ int at_off(int row, int e) { return row * 256 + ((((e) >> 3) ^ (row & 15)) << 4) + ((e) & 7) * 2; }
__device__ __forceinline__ void attnP_unit(Frame& F, const Args& A, int unit) {
    const int lane = F.lane, qt = F.wave, i = lane & 15, gq = lane >> 4, tid = F.tid;
    const int g = unit >> 9, r0 = unit & 511, sh = 2 * g, d = 1 << sh, nblk = 64 >> sh;
    const int n = r0 % nblk, x = r0 / nblk, rho = x & (d - 1), y = x >> sh, h = y & 3, b = y >> 2;
    LAS unsigned char* L = F.lds + RING_OFF;
    const bf16* H = WSB_(A, WS_H);
    const int hoff = g * 512 + h * 128;
    for (int idx = tid; idx < 256 * 16; idx += 512) {
        const int kl = idx >> 4, ch = idx & 15, pos = 128 * (n - 1) + kl;
        v4u kq = {0u, 0u, 0u, 0u}, vq = {0u, 0u, 0u, 0u};
        if (pos >= 0) { const bf16* rp = H + (size_t)(b * SEQ + rho + d * pos) * NH + hoff + ch * 8; kq = *(const GAS v4u*)(rp + C_AK); vq = *(const GAS v4u*)(rp + C_AV); }
        const int o = kl * 256 + ((ch ^ (kl & 15)) << 4);
        *(LAS v4u*)(L + AT_K + o) = kq; *(LAS v4u*)(L + AT_V + o) = vq;
    }
    if (tid < 256) { const int kl = 256 + (tid >> 4), ch = tid & 15; *(LAS v4u*)(L + AT_V + kl * 256 + ((ch ^ (kl & 15)) << 4)) = (v4u){0u, 0u, 0u, 0u}; }
    const int ql = 16 * qt + i;
    const size_t qrow = (size_t)(b * SEQ + rho + d * (128 * n + ql));
    bf16x8 qf[4];
#pragma unroll
    for (int ks = 0; ks < 4; ++ks) qf[ks] = *(const GAS bf16x8*)(H + qrow * NH + C_AQ + hoff + 32 * ks + 8 * gq);
    WG_BAR();
    f32x4 sc[9];
#pragma unroll
    for (int kk = 0; kk < 9; ++kk) { const int krow = 16 * (qt + kk) + i; f32x4 acc = {0.f, 0.f, 0.f, 0.f};
#pragma unroll
        for (int ks = 0; ks < 4; ++ks) acc = mfma16(*(const LAS bf16x8*)(L + AT_K + krow * 256 + (((4 * ks + gq) ^ (krow & 15)) << 4)), qf[ks], acc);
        sc[kk] = acc; }
    const float NEG = -__builtin_inff();
    const bool nofirst = n > 0;
#pragma unroll
    for (int r = 0; r < 4; ++r) { if (4 * gq + r < i) sc[0][r] = NEG; if (4 * gq + r > i) sc[8][r] = NEG; }
    if (!nofirst) {
#pragma unroll
        for (int kk = 0; kk < 9; ++kk) { if (16 * (qt + kk) < 128) sc[kk] = (f32x4){NEG, NEG, NEG, NEG}; }
    }
    float mx = -1e30f;
#pragma unroll
    for (int kk = 0; kk < 9; ++kk) mx = fmaxf(mx, fmaxf(fmaxf(sc[kk][0], sc[kk][1]), fmaxf(sc[kk][2], sc[kk][3])));
    mx = fmaxf(mx, __shfl_xor(mx, 16)); mx = fmaxf(mx, __shfl_xor(mx, 32));
    constexpr float C2 = ATT_SCALE * 1.4426950408889634f;
    float l = 0.f;
#pragma unroll
    for (int kk = 0; kk < 9; ++kk)
#pragma unroll
        for (int r = 0; r < 4; ++r) { const float p = __builtin_amdgcn_exp2f((sc[kk][r] - mx) * C2); sc[kk][r] = p; l += p; }
    l += __shfl_xor(l, 16); l += __shfl_xor(l, 32);
    f32x4 oa[8];
#pragma unroll
    for (int et = 0; et < 8; ++et) oa[et] = (f32x4){0.f, 0.f, 0.f, 0.f};
#pragma unroll
    for (int s = 0; s < 5; ++s) {
        const u32x2 plo = pk4(sc[2 * s]); const u32x2 phi = (2 * s + 1 < 9) ? pk4(sc[(2 * s + 1 < 9) ? 2 * s + 1 : 8]) : (u32x2){0u, 0u};
        const v4u pw = {plo.x, plo.y, phi.x, phi.y}; const bf16x8 pf = __builtin_bit_cast(bf16x8, pw);
        const int rlo = 16 * (qt + 2 * s) + 4 * gq + (i >> 2), rhi = rlo + 16;
#pragma unroll
        for (int et = 0; et < 8; ++et) { const int e = 16 * et + 4 * (i & 3);
            const s16x4 lo = __builtin_bit_cast(s16x4, __builtin_amdgcn_ds_read_tr16_b64_v4i16((LAS v4i16_t*)(L + AT_V + at_off(rlo, e))));
            const s16x4 hi = __builtin_bit_cast(s16x4, __builtin_amdgcn_ds_read_tr16_b64_v4i16((LAS v4i16_t*)(L + AT_V + at_off(rhi, e))));
            oa[et] = mfma16(__builtin_shufflevector(lo, hi, 0, 1, 2, 3, 4, 5, 6, 7), pf, oa[et]); }
    }
    const float il = 1.0f / l;
    bf16* ao = WSB_(A, WS_AO) + ((size_t)g * M + qrow) * RW + h * 128 + 4 * gq;
#pragma unroll
    for (int et = 0; et < 8; ++et) *(GAS u32x2*)(ao + 16 * et) = pk4(oa[et] * il);
    if (gq == 0) WSF_(A, WS_LSE)[((size_t)g * M + qrow) * 4 + h] = mx * ATT_SCALE + __logf(l);
    WG_BAR();
}
__device__ __forceinline__ float row_sum16(float x) { return row_scan(x); }
__device__ __forceinline__ void attnS_item(Frame& F, const Args& A, int b, int g, int t, int h) {
    const int lane = F.lane, i = lane & 15, gq = lane >> 4;
    const int sh = 2 * g, d = 1 << sh, Wb = 128 << sh;
    const float* cache = (g == 0 ? C1_(A) : (g == 1 ? C2_(A) : C3_(A))) + (size_t)b * Wb * 1024 + h * 128 + 8 * gq;
    const bf16* H = WSB_(A, WS_H);
    const int ms = MP + b * DSEQ;
    const int hoff = g * 512 + h * 128 + 8 * gq;
    float q[4][8];
#pragma unroll
    for (int ks = 0; ks < 4; ++ks) ld8bf(H + (size_t)(ms + t) * NH + C_AQ + hoff + 32 * ks, q[ks]);
    float sc[9];
#pragma unroll
    for (int x = 0; x < 9; ++x) sc[x] = -__builtin_inff();
#pragma unroll 1
    for (int tile = 0; tile < 8; tile += 2) {
        float pr[2];
#pragma unroll
        for (int u = 0; u < 2; ++u) {
            const int kk = 16 * (tile + u) + i, idx = (g == 0) ? kk : t + d * kk;
            const float* kr = cache + (size_t)idx * 1024;
            float part = 0.f;
#pragma unroll
            for (int ks = 0; ks < 4; ++ks) { const f32x4 k0 = *(const GAS f32x4*)(kr + 32 * ks), k1 = *(const GAS f32x4*)(kr + 32 * ks + 4);
                part += q[ks][0] * k0.x + q[ks][1] * k0.y + q[ks][2] * k0.z + q[ks][3] * k0.w + q[ks][4] * k1.x + q[ks][5] * k1.y + q[ks][6] * k1.z + q[ks][7] * k1.w; }
            part += __shfl_xor(part, 16); part += __shfl_xor(part, 32);
            const bool valid = (g == 0) ? (kk >= t) : true;
            pr[u] = valid ? part * ATT_SCALE : -__builtin_inff();
        }
#pragma unroll
        for (int x = 0; x < 8; x += 2) { if (tile == x) { sc[x] = pr[0]; sc[x + 1] = pr[1]; } }
    }
    {
        const int tn = (g == 0) ? (i & 3) : t; const bool valid = (g == 0) ? (i <= t && i < 4) : (i == 0);
        float part = 0.f;
#pragma unroll
        for (int ks = 0; ks < 4; ++ks) { float kv[8]; ld8bf(H + (size_t)(ms + tn) * NH + C_AK + hoff + 32 * ks, kv);
#pragma unroll
            for (int j = 0; j < 8; ++j) part += q[ks][j] * kv[j]; }
        part += __shfl_xor(part, 16); part += __shfl_xor(part, 32);
        sc[8] = valid ? part * ATT_SCALE : -__builtin_inff();
    }
    float mx = sc[0];
#pragma unroll
    for (int x = 1; x < 9; ++x) mx = fmaxf(mx, sc[x]);
    mx = fmaxf(mx, __shfl_xor(mx, 1)); mx = fmaxf(mx, __shfl_xor(mx, 2)); mx = fmaxf(mx, __shfl_xor(mx, 4)); mx = fmaxf(mx, __shfl_xor(mx, 8));
    float l = 0.f;
#pragma unroll
    for (int x = 0; x < 9; ++x) { sc[x] = __expf(sc[x] - mx); l += sc[x]; }
    float acc[4][8];
#pragma unroll
    for (int ks = 0; ks < 4; ++ks)
#pragma unroll
        for (int j = 0; j < 8; ++j) acc[ks][j] = 0.f;
#pragma unroll 1
    for (int tile = 0; tile < 8; tile += 2) {
        float pp[2] = {0.f, 0.f};
#pragma unroll
        for (int x = 0; x < 8; x += 2) { if (tile == x) { pp[0] = sc[x]; pp[1] = sc[x + 1]; } }
#pragma unroll
        for (int u = 0; u < 2; ++u) {
            const int kk = 16 * (tile + u) + i, idx = (g == 0) ? kk : t + d * kk;
            const float* vr = cache + (size_t)idx * 1024 + 512;
            const float p = pp[u];
#pragma unroll
            for (int ks = 0; ks < 4; ++ks) { const f32x4 v0 = *(const GAS f32x4*)(vr + 32 * ks), v1 = *(const GAS f32x4*)(vr + 32 * ks + 4);
                acc[ks][0] += p * v0.x; acc[ks][1] += p * v0.y; acc[ks][2] += p * v0.z; acc[ks][3] += p * v0.w; acc[ks][4] += p * v1.x; acc[ks][5] += p * v1.y; acc[ks][6] += p * v1.z; acc[ks][7] += p * v1.w; }
        }
    }
    {
        const int tn = (g == 0) ? (i & 3) : t; const float p = sc[8];
#pragma unroll
        for (int ks = 0; ks < 4; ++ks) { float vv[8]; ld8bf(H + (size_t)(ms + tn) * NH + C_AV + hoff + 32 * ks, vv);
#pragma unroll
            for (int j = 0; j < 8; ++j) acc[ks][j] += p * vv[j]; }
    }
    l = row_sum16(l);
#pragma unroll
    for (int ks = 0; ks < 4; ++ks)
#pragma unroll
        for (int j = 0; j < 8; ++j) acc[ks][j] = row_sum16(acc[ks][j]);
    if (i == 15) {
        const float il = 1.0f / l;
        bf16* ao = WSB_(A, WS_AO) + ((size_t)g * M + ms + t) * RW + h * 128 + 8 * gq;
#pragma unroll
        for (int ks = 0; ks < 4; ++ks) { v4u w; w.x = pk2(acc[ks][0] * il, acc[ks][1] * il); w.y = pk2(acc[ks][2] * il, acc[ks][3] * il); w.z = pk2(acc[ks][4] * il, acc[ks][5] * il); w.w = pk2(acc[ks][6] * il, acc[ks][7] * il);
            *(GAS v4u*)(ao + 32 * ks) = w; }
        if (gq == 0) WSF_(A, WS_LSE)[((size_t)g * M + ms + t) * 4 + h] = mx + __logf(l);
    }
}

__device__ __forceinline__ void attn_combine_row(Frame& F, const Args& A, int m) {
    const int lane = F.lane, c0 = lane * 8, h = lane >> 4;
    float o[3][8], ls[3];
#pragma unroll
    for (int g = 0; g < 3; ++g) { ld8bf(WSB_(A, WS_AO) + ((size_t)g * M + m) * RW + c0, o[g]); ls[g] = WSF_(A, WS_LSE)[((size_t)g * M + m) * 4 + h]; }
    const float ml = fmaxf(fmaxf(ls[0], ls[1]), ls[2]);
    const float w0 = __expf(ls[0] - ml), w1 = __expf(ls[1] - ml), w2 = __expf(ls[2] - ml), iw = 1.0f / (w0 + w1 + w2);
    float z[8]; ld8bf(WSB_(A, WS_H) + (size_t)m * NH + C_ZA + c0, z);
    float yv[8];
#pragma unroll
    for (int j = 0; j < 8; ++j) yv[j] = (w0 * o[0][j] + w1 * o[1][j] + w2 * o[2][j]) * iw * z[j];
    v4u w; w.x = pk2(yv[0], yv[1]); w.y = pk2(yv[2], yv[3]); w.z = pk2(yv[4], yv[5]); w.w = pk2(yv[6], yv[7]);
    *(GAS v4u*)(WSB_(A, WS_YA) + (size_t)m * RW + c0) = w;
}

__device__ __forceinline__ float rdl(float x, int l) { return __builtin_bit_cast(float, __builtin_amdgcn_readlane(__builtin_bit_cast(int, x), l)); }
__device__ __forceinline__ float ldbf1(const bf16* p) { return bf2f((unsigned)*(const GAS unsigned short*)p); }
__device__ __forceinline__ void rwkvS_item(Frame& F, const Args& A, int b, int h) {
    const int lane = F.lane, hc = h * 64 + lane, ms = MP + b * DSEQ;
    const bf16* H = WSB_(A, WS_H);
    v4u w2p[8], a2p[8];
#pragma unroll
    for (int q = 0; q < 8; ++q) { w2p[q] = *(const GAS v4u*)(WSB_(A, WS_W2T) + (size_t)hc * 64 + 8 * q); a2p[q] = *(const GAS v4u*)(WSB_(A, WS_A2T) + (size_t)hc * 64 + 8 * q); }
    const float w0 = W0_(A)[hc], a0 = A0_(A)[hc], kkc = K_K_(A)[hc], kac = K_A_(A)[hc], rkc = R_K_(A)[hc], lg = LNX_G_(A)[hc], lb = LNX_B_(A)[hc];
    const float mu_r = MU_(A)[C_R + hc], mu_k = MU_(A)[C_K + hc], mu_v = MU_(A)[C_V + hc], mu_wd = MU_(A)[C_WD + lane], mu_ad = MU_(A)[C_AD + lane];
    const float* sh = SHIFT0_(A) + (size_t)b * SHIFTC;
    float pr = sh[C_R + hc], pk = sh[C_K + hc], pv = sh[C_V + hc], pwd = sh[C_WD + lane], pad = sh[C_AD + lane];
    float S[64];
    { const float* s0 = WKV0_(A) + ((size_t)(b * 8 + h) * 64 + lane) * 64;
#pragma unroll
      for (int k = 0; k < 64; k += 4) { const f32x4 v = *(const GAS f32x4*)(s0 + k); S[k] = v.x; S[k + 1] = v.y; S[k + 2] = v.z; S[k + 3] = v.w; } }
#pragma unroll 1
    for (int t = 0; t < DSEQ; ++t) {
        const bf16* hr = H + (size_t)(ms + t) * NH;
        const float zr = ldbf1(hr + C_R + hc), zk = ldbf1(hr + C_K + hc), zv = ldbf1(hr + C_V + hc), zwd = ldbf1(hr + C_WD + lane), zad = ldbf1(hr + C_AD + lane), gate = ldbf1(hr + C_ZR + hc);
        const float r = zr + mu_r * (pr - zr), k = zk + mu_k * (pk - zk), v = zv + mu_v * (pv - zv), tw = fast_tanh(zwd + mu_wd * (pwd - zwd)), ad = zad + mu_ad * (pad - zad);
        pr = zr; pk = zk; pv = zv; pwd = zwd; pad = zad;
        float wp = 0.f, ap = 0.f;
#pragma unroll
        for (int q = 0; q < 8; ++q) { const unsigned ww[4] = {w2p[q].x, w2p[q].y, w2p[q].z, w2p[q].w}, aw[4] = {a2p[q].x, a2p[q].y, a2p[q].z, a2p[q].w};
#pragma unroll
            for (int e = 0; e < 4; ++e) { const int j = 8 * q + 2 * e;
                wp += rdl(tw, j) * bf2f(ww[e] & 0xffffu) + rdl(tw, j + 1) * bf2f(ww[e] >> 16);
                ap += rdl(ad, j) * bf2f(aw[e] & 0xffffu) + rdl(ad, j + 1) * bf2f(aw[e] >> 16); }
            __builtin_amdgcn_sched_barrier(0); }
        const float x = -(w0 + wp), sp = fmaxf(x, 0.f) + __logf(1.0f + __expf(-fabsf(x)));
        const float dec = __expf(-__expf(-sp - 0.5f)), a = fast_sigmoid(a0 + ap);
        const float kkr = k * kkc, inv = fminf(__builtin_amdgcn_rsqf(wave_sum(kkr * kkr)), 1e12f), kk = kkr * inv, k2 = k * (1.0f + (a - 1.0f) * kac), ka = kk * a;
        const float bon = wave_sum(r * k2 * rkc);
        float sa = 0.f;
#pragma unroll
        for (int q = 0; q < 64; ++q) { sa -= S[q] * rdl(kk, q); if ((q & 7) == 7) __builtin_amdgcn_sched_barrier(0); }
        float o = 0.f;
#pragma unroll
        for (int q = 0; q < 64; ++q) { S[q] = S[q] * rdl(dec, q) + sa * rdl(ka, q) + v * rdl(k2, q); o += S[q] * rdl(r, q); if ((q & 3) == 3) __builtin_amdgcn_sched_barrier(0); }
        const float mean = wave_sum(o) * (1.0f / 64.0f), dlt = o - mean, rstd = 1.0f / sqrtf(wave_sum(dlt * dlt) * (1.0f / 64.0f) + GN_EPS);
        const float y = (dlt * rstd * lg + lb + bon * v) * gate;
        *(GAS unsigned short*)(WSB_(A, WS_YR) + (size_t)(ms + t) * RW + hc) = (unsigned short)f2bf(y);
    }
    float* so = A.out + O_WKVS + ((size_t)(b * 8 + h) * 64 + lane) * 64;
#pragma unroll
    for (int k = 0; k < 64; k += 4) *(GAS f32x4*)(so + k) = (f32x4){S[k], S[k + 1], S[k + 2], S[k + 3]};
}

__device__ __forceinline__ void ln_row(Frame& F, const Args& A, int m) {
    const GAS f32x4* xr = (const GAS f32x4*)(WSF_(A, WS_PRE) + (size_t)m * DM) + F.lane;
    f32x4 v[4]; float s = 0.f;
#pragma unroll
    for (int j = 0; j < 4; ++j) { v[j] = xr[64 * j]; s += (v[j].x + v[j].y) + (v[j].z + v[j].w); }
    const float mean = wave_sum(s) * (1.f / DM); float s2 = 0.f;
#pragma unroll
    for (int j = 0; j < 4; ++j) { v[j] = v[j] - mean; s2 += (v[j].x * v[j].x + v[j].y * v[j].y) + (v[j].z * v[j].z + v[j].w * v[j].w); }
    const float rstd = 1.f / sqrtf(wave_sum(s2) * (1.f / DM) + LN_EPS);
    GAS f32x4* o = (GAS f32x4*)(A.out + (size_t)m * DM) + F.lane;
#pragma unroll
    for (int j = 0; j < 4; ++j) { const f32x4 g = *((const GAS f32x4*)LN_G_(A) + F.lane + 64 * j), bta = *((const GAS f32x4*)LN_B_(A) + F.lane + 64 * j); o[64 * j] = v[j] * rstd * g + bta; }
}

__global__ void __launch_bounds__(NWAVES * 64, 2) mega_fwd(Args args) {
    extern __shared__ __attribute__((aligned(16))) unsigned char lds[];
    Frame F;
    F.lds = (LAS unsigned char*)lds;
    F.MISC = (volatile LAS unsigned*)(F.lds + MISC_OFF);
    F.tid = threadIdx.x; F.lane = F.tid & 63; F.wave = __builtin_amdgcn_readfirstlane(F.tid >> 6);
    F.G = gridDim.x;
    F.ctl = (gu32*)(args.ws + WS_CTL);
    for (int u = F.tid; u < (LDS_BYTES - LDSCTL_OFF) / 4; u += NWAVES * 64) ((LAS unsigned*)(F.lds + LDSCTL_OFF))[u] = 0u;
    __syncthreads();
    XcdBarrier bar; bar.bar = (unsigned*)(F.ctl + CW_BAR); bar.x = 0; bar.st = nullptr;
    if (N_LAUNCHES == 1) bar = xcd_barrier_post((unsigned*)(F.ctl + CW_BAR), F.MISC + 8);
#define GRID_BAR() do { if (N_LAUNCHES == 1) xcd_barrier(bar); } while (0)
    const int lo = args.ph_lo, hi = args.ph_hi;
#ifndef PH_MASK
#define PH_MASK 0xFFFF
#endif
#define IN(k) ((((PH_MASK) >> (k)) & 1) && lo <= (k) && (k) < hi)
#define BOTH(k) (IN(k) && IN((k) + 1))
    const int gw = blockIdx.x * NWAVES + F.wave, NGW = F.G * NWAVES;

    if (IN(0)) { p0_prologue(F, args); if (BOTH(0)) GRID_BAR(); }
    if (IN(1)) {
        pg8::Gemm g{WSB_(args, WS_XB), WSB_(args, WS_WIN), M, NH, DM}; pg8::StaticOrder S; S.init(M, NH, F.G, (int)blockIdx.x);
        pg8::EpiH E{WSB_(args, WS_H), B_GATE_(args), args.out};
        pg8::gemm_phase<pg8::EpiH, pg8::StaticOrder, PG8_ALIGN, PG8_SP2>(F.lds + RING_OFF, g, S, E);
        if (BOTH(1)) GRID_BAR();
    }
    if (IN(2)) {
        rwkvA_phase(F, args);
        if (BOTH(2)) GRID_BAR();
    }
    if (IN(3)) {
#ifndef PROBE_NO_CARRY
        if (blockIdx.x < 16) rwkv_carry(F, args, (int)blockIdx.x);
#endif
        {
            volatile LAS int* qslot = (volatile LAS int*)(F.lds + LDSCTL_OFF);
            for (;;) {
                if (F.tid == 0) qslot[0] = (int)__hip_atomic_fetch_add((unsigned*)(F.ctl + CW_Q), 1u, __ATOMIC_RELAXED, __HIP_MEMORY_SCOPE_AGENT);
                WG_BAR();
                const int u = qslot[0];
                WG_BAR();
                if (u >= NATT_UNITS + 768) break;
                const int u3 = u / 3, um = u - 3 * u3;
                if (um == 0) {
#ifndef PROBE_NO_ATTS
                    const int tp = u3 & 1, bg = u3 >> 1, b = bg / 3, g = bg - 3 * b; attnS_item(F, args, b, g, 2 * tp + (F.wave >> 2), F.wave & 3);
#endif
                } else {
#ifndef PROBE_NO_ATTP
                    attnP_unit(F, args, 2 * u3 + um - 1);
#endif
                }
            }
        }
        for (int it = F.wave * F.G + blockIdx.x; it < DBATCH * 8; it += NGW) rwkvS_item(F, args, it >> 3, it & 7);
        if (BOTH(3)) GRID_BAR();
    }
    if (IN(4)) {
        for (int u2 = blockIdx.x; u2 < NUNITS / 2; u2 += F.G) rwkvC_unit(F, args, 2 * u2 + (F.wave >> 2));
        for (int m = gw; m < M; m += NGW) attn_combine_row(F, args, m);
        if (BOTH(4)) GRID_BAR();
    }
    if (IN(5)) {
        pg8::Gemm g{WSB_(args, WS_YR), WSB_(args, WS_WOA), M, DM, RW}; pg8::StaticOrder S; S.init(M, DM, F.G, (int)blockIdx.x);
        pg8::EpiMixA E{WSB_(args, WS_H), WSF_(args, WS_MIXF)};
        pg8::gemm_phase<pg8::EpiMixA, pg8::StaticOrder, PG8_ALIGN, PG8_SP2>(F.lds + RING_OFF, g, S, E);
        if (BOTH(5)) GRID_BAR();
    }
    if (IN(6)) {
        pg8::Gemm g{WSB_(args, WS_YA), WSB_(args, WS_WOB), M, DM, RW}; pg8::StaticOrder S; S.init(M, DM, F.G, (int)blockIdx.x);
        pg8::EpiMixB E{WSB_(args, WS_H), WSF_(args, WS_MIXF), WSB_(args, WS_MIX)};
        pg8::gemm_phase<pg8::EpiMixB, pg8::StaticOrder, PG8_ALIGN, PG8_SP2>(F.lds + RING_OFF, g, S, E);
        if (BOTH(6)) GRID_BAR();
    }
    if (IN(7)) {
        pg8::Gemm g{WSB_(args, WS_MIX), WSB_(args, WS_WOUT), M, DM, DM}; pg8::StaticOrder S; S.init(M, DM, F.G, (int)blockIdx.x);
        pg8::EpiPre E{XP_(args), XS_(args), WSF_(args, WS_PRE)};
        pg8::gemm_phase<pg8::EpiPre, pg8::StaticOrder, PG8_ALIGN, PG8_SP2>(F.lds + RING_OFF, g, S, E);
        if (BOTH(7)) GRID_BAR();
    }
    if (IN(8)) {
        for (int m = gw; m < M; m += NGW) ln_row(F, args, m);
    }
#undef IN
#undef BOTH
}

extern "C" void kernel_launch(void* const* d_in, const int* in_sizes, int n_in, void* d_out, int out_size, void* d_ws, size_t ws_size, hipStream_t stream) {
    static int grid = 0;
    if (grid == 0) {
        if (n_in != 24 || in_sizes[0] != MP * DM || (size_t)out_size != O_END || ws_size < WS_END) { fprintf(stderr, "kernel_launch: unexpected shapes (n_in %d, in0 %d, out %d, ws %zu); nothing launched\n", n_in, n_in > 0 ? in_sizes[0] : -1, out_size, ws_size); grid = -1; return; }
        int dev = 0, cus = 0, per_cu = 0;
        if (hipGetDevice(&dev) != hipSuccess || hipDeviceGetAttribute(&cus, hipDeviceAttributeMultiprocessorCount, dev) != hipSuccess) { grid = -1; return; }
        if (hipFuncSetAttribute((const void*)mega_fwd, hipFuncAttributeMaxDynamicSharedMemorySize, LDS_BYTES) != hipSuccess) { fprintf(stderr, "kernel_launch: hipFuncSetAttribute failed\n"); grid = -1; return; }
        if (hipOccupancyMaxActiveBlocksPerMultiprocessor(&per_cu, (const void*)mega_fwd, NWAVES * 64, LDS_BYTES) != hipSuccess || per_cu < 1) fprintf(stderr, "kernel_launch: occupancy query reports %d\n", per_cu);
        (void)hipGetLastError();
        grid = cus;
    }
    if (grid < 0) return;
    if (hipMemsetAsync((char*)d_ws + WS_CTL, 0, CTL_ZERO_BYTES, stream) != hipSuccess) return;
    Args a{};
    for (int i = 0; i < 24; ++i) a.in[i] = (const float*)d_in[i];
    a.out = (float*)d_out; a.ws = (unsigned char*)d_ws;
    if (N_LAUNCHES == 1) { a.ph_lo = 0; a.ph_hi = N_PHASES; hipLaunchKernelGGL(mega_fwd, dim3(grid), dim3(NWAVES * 64), LDS_BYTES, stream, a); }
    else for (int li = 0; li < N_PHASES; ++li) { a.ph_lo = li; a.ph_hi = li + 1; hipLaunchKernelGGL(mega_fwd, dim3(grid), dim3(NWAVES * 64), LDS_BYTES, stream, a); }
}
```
